# Optimizing an MI355X kernel written in HIP

```python
import math
import jax, jax.numpy as jnp
from jax import lax
import numpy as np

D_MODEL = 1024
BATCH = 8
SEQ = 4096
DEPTH = 1

N_MEM = 256
SWA_HEADS = 8
SWA_KV_HEADS = 2
SWA_HEAD_DIM = 64
WINDOW = 128
FOX_HEADS = 8
FOX_HEAD_DIM = 64
MEM_HEADS = 4
MEM_HEAD_DIM = 128
N_BRANCHES = 3
D_FF = 4 * D_MODEL
REL_BUCKETS = 32
REL_MAX_DIST = 128
BLOCK = 128
EPS = 1e-6
NEG = -1e30

SWA_Q = SWA_HEADS * SWA_HEAD_DIM
SWA_KV = SWA_KV_HEADS * SWA_HEAD_DIM
FOX_W = FOX_HEADS * FOX_HEAD_DIM
MEM_W = MEM_HEADS * MEM_HEAD_DIM
GATE_W = N_BRANCHES * D_MODEL
SPLIT_POINTS = (
    SWA_Q,
    SWA_Q + SWA_KV,
    SWA_Q + 2 * SWA_KV,
    SWA_Q + 2 * SWA_KV + FOX_W,
    SWA_Q + 2 * SWA_KV + 2 * FOX_W,
    SWA_Q + 2 * SWA_KV + 3 * FOX_W,
    SWA_Q + 2 * SWA_KV + 3 * FOX_W + FOX_HEADS,
    SWA_Q + 2 * SWA_KV + 3 * FOX_W + FOX_HEADS + MEM_W,
)
IN_WIDTH = SWA_Q + 2 * SWA_KV + 3 * FOX_W + FOX_HEADS + MEM_W + GATE_W

kernel_name = "hybrid_swa_fox_memory_gated_block"


def rmsnorm(x, g):
    xf = x.astype(jnp.float32)
    y = xf * lax.rsqrt(jnp.mean(xf * xf, axis=-1, keepdims=True) + EPS)
    return (y * g.astype(jnp.float32)).astype(x.dtype)


def t5_causal_bucket(dist):
    max_exact = REL_BUCKETS // 2
    d = jnp.maximum(dist, 0)
    df = jnp.maximum(d, 1).astype(jnp.float32)
    large = max_exact + (jnp.log(df / max_exact) / math.log(REL_MAX_DIST / max_exact)
                         * (REL_BUCKETS - max_exact)).astype(jnp.int32)
    large = jnp.minimum(large, REL_BUCKETS - 1)
    return jnp.where(d < max_exact, d, large)


def swa_attention(q, k, v, sinks, rel_bias):
    B, S = q.shape[0], q.shape[1]
    nb = S // BLOCK
    G = SWA_HEADS // SWA_KV_HEADS
    qb = q.reshape(B, nb, BLOCK, SWA_KV_HEADS, G, SWA_HEAD_DIM)
    pad = ((0, 0), (BLOCK, 0), (0, 0), (0, 0))
    kp = jnp.pad(k, pad).reshape(B, nb + 1, BLOCK, SWA_KV_HEADS, SWA_HEAD_DIM)
    vp = jnp.pad(v, pad).reshape(B, nb + 1, BLOCK, SWA_KV_HEADS, SWA_HEAD_DIM)
    kb = jnp.concatenate([kp[:, :-1], kp[:, 1:]], axis=2)
    vb = jnp.concatenate([vp[:, :-1], vp[:, 1:]], axis=2)
    scale = SWA_HEAD_DIM ** -0.5
    s = jnp.einsum('bnqhgd,bnkhd->bnhgqk', qb, kb).astype(jnp.float32) * scale
    t_loc = jnp.arange(BLOCK)[:, None] + BLOCK
    s_loc = jnp.arange(2 * BLOCK)[None, :]
    dist = t_loc - s_loc
    bias = rel_bias[t5_causal_bucket(dist)]
    bias = bias.reshape(BLOCK, 2 * BLOCK, SWA_KV_HEADS, G).transpose(2, 3, 0, 1)
    s = s + bias.astype(jnp.float32)
    band = (dist >= 0) & (dist < WINDOW)
    key_pos = jnp.arange(nb)[:, None] * BLOCK + s_loc - BLOCK
    valid = band[None] & (key_pos >= 0)[:, None, :]
    s = jnp.where(valid[None, :, None, None], s, NEG)
    sink = sinks.astype(jnp.float32).reshape(1, 1, SWA_KV_HEADS, G, 1, 1)
    m = jnp.maximum(jnp.max(s, axis=-1, keepdims=True), sink)
    p = jnp.exp(s - m)
    denom = jnp.sum(p, axis=-1, keepdims=True) + jnp.exp(sink - m)
    p = (p / denom).astype(v.dtype)
    o = jnp.einsum('bnhgqk,bnkhd->bnqhgd', p, vb)
    return o.reshape(B, S, SWA_Q)


def forgetting_attention(q, k, v, log_f):
    B, S = q.shape[0], q.shape[1]
    nb = S // BLOCK
    scale = FOX_HEAD_DIM ** -0.5
    c = jnp.cumsum(log_f, axis=1)
    c_k = c.transpose(0, 2, 1)
    qb = q.reshape(B, nb, BLOCK, FOX_HEADS, FOX_HEAD_DIM).transpose(1, 0, 2, 3, 4)
    cqb = c.reshape(B, nb, BLOCK, FOX_HEADS).transpose(1, 0, 3, 2)
    key_pos = jnp.arange(S)

    def one_block(args):
        qi, cqi, i = args
        s = jnp.einsum('bqhd,bkhd->bhqk', qi, k).astype(jnp.float32) * scale
        s = s + cqi[..., None] - c_k[:, :, None, :]
        q_pos = i * BLOCK + jnp.arange(BLOCK)
        causal = key_pos[None, :] <= q_pos[:, None]
        s = jnp.where(causal, s, NEG)
        p = jax.nn.softmax(s, axis=-1).astype(v.dtype)
        return jnp.einsum('bhqk,bkhd->bqhd', p, v)

    o = lax.map(one_block, (qb, cqb, jnp.arange(nb)))
    return o.transpose(1, 0, 2, 3, 4).reshape(B, S, FOX_W)


def memory_attention(q, mk, mv):
    B, S = q.shape[0], q.shape[1]
    scale = MEM_HEAD_DIM ** -0.5
    s = jnp.einsum('bshd,bmhd->bhsm', q, mk).astype(jnp.float32) * scale
    p = jax.nn.softmax(s, axis=-1).astype(mv.dtype)
    o = jnp.einsum('bhsm,bmhd->bshd', p, mv)
    return o.reshape(B, S, MEM_W)


def setup_inputs(seed: int = 0) -> dict:
    key = jax.random.key(seed)
    ks = jax.random.split(key, 24)
    f32 = jnp.float32

    def w(k, shape, fan_in):
        return jax.random.normal(k, shape, f32) * fan_in ** -0.5

    def gain(k, shape):
        return 1.0 + 0.05 * jax.random.normal(k, shape, f32)

    return {
        "x": jax.random.normal(ks[0], (BATCH, SEQ, D_MODEL), f32),
        "mem": jax.random.normal(ks[1], (BATCH, N_MEM, D_MODEL), f32),
        "g_mix": gain(ks[2], (DEPTH, D_MODEL)),
        "w_in": w(ks[3], (DEPTH, D_MODEL, IN_WIDTH), D_MODEL),
        "b_gate": 0.02 * jax.random.normal(ks[4], (DEPTH, GATE_W), f32),
        "b_forget": 3.0 + 0.1 * jax.random.normal(ks[5], (DEPTH, FOX_HEADS), f32),
        "qn_swa": gain(ks[6], (DEPTH, SWA_HEAD_DIM)),
        "kn_swa": gain(ks[7], (DEPTH, SWA_HEAD_DIM)),
        "sink_swa": 0.5 * jax.random.normal(ks[8], (DEPTH, SWA_HEADS), f32),
        "rel_bias": 0.5 * jax.random.normal(ks[9], (REL_BUCKETS, SWA_HEADS), f32),
        "qn_fox": gain(ks[10], (DEPTH, FOX_HEAD_DIM)),
        "kn_fox": gain(ks[11], (DEPTH, FOX_HEAD_DIM)),
        "g_mem": gain(ks[12], (DEPTH, D_MODEL)),
        "w_mem_kv": w(ks[13], (DEPTH, D_MODEL, 2 * MEM_W), D_MODEL),
        "qn_mem": gain(ks[14], (DEPTH, MEM_HEAD_DIM)),
        "kn_mem": gain(ks[15], (DEPTH, MEM_HEAD_DIM)),
        "w_o_swa": w(ks[16], (DEPTH, SWA_Q, D_MODEL), SWA_Q),
        "w_o_fox": w(ks[17], (DEPTH, FOX_W, D_MODEL), FOX_W),
        "w_o_mem": w(ks[18], (DEPTH, MEM_W, D_MODEL), MEM_W),
        "w_out": w(ks[19], (DEPTH, D_MODEL, D_MODEL), D_MODEL),
        "g_mlp": gain(ks[20], (DEPTH, D_MODEL)),
        "w_mlp_up": w(ks[21], (DEPTH, D_MODEL, D_FF), D_MODEL),
        "w_mlp_down": w(ks[22], (DEPTH, D_FF, D_MODEL), D_FF),
    }


def reference(x, mem, g_mix, w_in, b_gate, b_forget, qn_swa, kn_swa, sink_swa, rel_bias,
              qn_fox, kn_fox, g_mem, w_mem_kv, qn_mem, kn_mem, w_o_swa, w_o_fox, w_o_mem,
              w_out, g_mlp, w_mlp_up, w_mlp_down):
    B, S = x.shape[0], x.shape[1]
    M = mem.shape[1]
    for layer in range(DEPTH):
        h = rmsnorm(x, g_mix[layer])
        proj = h @ w_in[layer]
        qa, ka, va, qf, kf, vf, fl, qm, gl = jnp.split(proj, SPLIT_POINTS, axis=-1)

        qa = rmsnorm(qa.reshape(B, S, SWA_HEADS, SWA_HEAD_DIM), qn_swa[layer])
        ka = rmsnorm(ka.reshape(B, S, SWA_KV_HEADS, SWA_HEAD_DIM), kn_swa[layer])
        va = va.reshape(B, S, SWA_KV_HEADS, SWA_HEAD_DIM)
        ya = swa_attention(qa, ka, va, sink_swa[layer], rel_bias) @ w_o_swa[layer]

        qf = rmsnorm(qf.reshape(B, S, FOX_HEADS, FOX_HEAD_DIM), qn_fox[layer])
        kf = rmsnorm(kf.reshape(B, S, FOX_HEADS, FOX_HEAD_DIM), kn_fox[layer])
        vf = vf.reshape(B, S, FOX_HEADS, FOX_HEAD_DIM)
        log_f = jax.nn.log_sigmoid(fl.astype(jnp.float32) + b_forget[layer].astype(jnp.float32))
        yf = forgetting_attention(qf, kf, vf, log_f) @ w_o_fox[layer]

        mem_n = rmsnorm(mem, g_mem[layer])
        mk, mv = jnp.split(mem_n @ w_mem_kv[layer], 2, axis=-1)
        mk = rmsnorm(mk.reshape(B, M, MEM_HEADS, MEM_HEAD_DIM), kn_mem[layer])
        mv = mv.reshape(B, M, MEM_HEADS, MEM_HEAD_DIM)
        qm = rmsnorm(qm.reshape(B, S, MEM_HEADS, MEM_HEAD_DIM), qn_mem[layer])
        ym = memory_attention(qm, mk, mv) @ w_o_mem[layer]

        gates = jax.nn.sigmoid((gl + b_gate[layer]).astype(jnp.float32)).astype(x.dtype)
        gates = gates.reshape(B, S, N_BRANCHES, D_MODEL)
        merged = gates[:, :, 0] * ya + gates[:, :, 1] * yf + gates[:, :, 2] * ym
        x = x + merged @ w_out[layer]

        hm = rmsnorm(x, g_mlp[layer])
        u = jnp.square(jax.nn.relu(hm @ w_mlp_up[layer]))
        x = x + u @ w_mlp_down[layer]
    return x
```

```cpp
#include <hip/hip_runtime.h>
#include <hip/hip_bf16.h>
#include <cstdio>
#include <cstdint>
#include <cmath>
#ifndef N_LAUNCHES
#define N_LAUNCHES 7
#endif
namespace pg8 {
#define PG8_LAS __attribute__((address_space(3)))
typedef unsigned short bf16_t;
typedef short bf16x8 __attribute__((ext_vector_type(8)));
typedef float f32x4 __attribute__((ext_vector_type(4)));
typedef unsigned u32x4 __attribute__((ext_vector_type(4)));
constexpr int BM = 256, BK = 64, HALF = 128, HTB = HALF * BK * 2  , STAGE_BYTES = 8 * HTB, NXCD = 8, WGM = 8;

__host__ __device__ __forceinline__ int lds_byte(int r, int c) { const int st = (r >> 4) * 2 + (c >> 5), rr = r & 15, cc = c & 31, ob = rr * 64 + cc * 2; return st * 1024 + (ob ^ (((ob >> 9) & 1) << 5)); }
__host__ __device__ __forceinline__ void stage_rc(int b, int& R, int& C) { const int st = b / 1024, sb = b % 1024, swz = sb ^ (((sb >> 9) & 1) << 5); R = (st >> 1) * 16 + swz / 64; C = (st & 1) * 32 + (swz % 64) / 2; }
__host__ __device__ __forceinline__ int perm32(int rho) { const int n = rho >> 4, i = rho & 15; return 8 * (i >> 2) + 4 * n + (i & 3); }

struct Unit { int pm, pn; };
typedef float f32x2_t __attribute__((ext_vector_type(2))); typedef __bf16 bf16x2_t __attribute__((ext_vector_type(2)));
__device__ __forceinline__ unsigned cvt_pk_bf16(float lo, float hi) { f32x2_t v = {lo, hi}; bf16x2_t b = __builtin_convertvector(v, bf16x2_t); return __builtin_bit_cast(unsigned, b); }
typedef unsigned u32x2 __attribute__((ext_vector_type(2)));

struct Sched {
    int nM, nN, nwg, G, c, nx, asel;
    const char *A0, *Bt, *Ax, *Bx; size_t tstep, astride;
    __device__ __forceinline__ void init(int M, int N, int K, int G_, int c_, const void* a0, const void* bt) {
        nM = M / BM; nN = N / BM; nwg = nM * nN; G = G_; c = c_; nx = 0; asel = 0; astride = 0; A0 = (const char*)a0; Bt = (const char*)bt; Ax = Bx = (const char*)a0; tstep = (size_t)BM * K * 2; }
    __device__ __forceinline__ bool next(int i, Unit& u) const {
        const long L = (long)i * G + c;
        if (L >= nwg) { const long e = L - nwg; if (e >= nx) return false; u.pm = nM + (int)(e >> 2); u.pn = (int)(e & 3); return true; }
        int wgid = (int)L; { const int q = nwg / NXCD, r = nwg % NXCD, xcd = wgid % NXCD, off = wgid / NXCD; wgid = (xcd < r ? xcd * (q + 1) : r * (q + 1) + (xcd - r) * q) + off; }
        const int nig = WGM * nN, gid = wgid / nig, fm = gid * WGM, gsz = (nM - fm) < WGM ? (nM - fm) : WGM;
        u.pm = fm + ((wgid % nig) % gsz); u.pn = (wgid % nig) / gsz; return true;
    }
    __device__ __forceinline__ const char* a_ptr(const Unit& u) const {
        if (u.pm >= nM) return Ax + (size_t)(u.pm - nM) * tstep;
        return A0 + (size_t)(asel ? (u.pn >> 2) : 0) * astride + (size_t)u.pm * tstep; }
    __device__ __forceinline__ const char* b_ptr(const Unit& u) const { return ((u.pm >= nM) ? Bx : Bt) + (size_t)u.pn * tstep; }
    __device__ __forceinline__ void a_ready(const Unit&) const {}
    __device__ __forceinline__ void done(const Unit&) const {}
};

__device__ __forceinline__ float dot4(const f32x4 a) { return (a[0] * a[0] + a[1] * a[1]) + (a[2] * a[2] + a[3] * a[3]); }
__device__ __forceinline__ u32x4 pack8(const f32x4 a, const f32x4 b) { u32x4 w; w.x = cvt_pk_bf16(a[0], a[1]); w.y = cvt_pk_bf16(a[2], a[3]); w.z = cvt_pk_bf16(b[0], b[1]); w.w = cvt_pk_bf16(b[2], b[3]); return w; }

constexpr float kLog2e = 1.4426950408889634f;
constexpr float kEps = 1e-6f;
constexpr float kC2_64 = 0.125f * 1.4426950408889634f;

struct EpiInProj {
    static constexpr bool PERM = true, AFTER_DRAIN = false;
    bf16_t *QA, *KA, *VA, *QF, *KF, *VF, *QM, *GT; float* MKV;
    const float *qn_swa, *kn_swa, *qn_fox, *kn_fox, *b_gate;
    __device__ __forceinline__ void operator()(const f32x4 (&acc)[2][2][4][2], const Unit& u, int wr, int wc, int fr, int fq) const {
        if (u.pm >= 128) {
            const int row0 = (u.pm - 128) * BM + wr * 64 + fr, col0 = u.pn * BM + wc * 32 + 8 * fq;
#pragma unroll
            for (int ai = 0; ai < 2; ++ai)
#pragma unroll
                for (int m = 0; m < 4; ++m) { float* rowp = MKV + (size_t)(row0 + ai * HALF + m * 16) * 1024 + col0;
#pragma unroll
                    for (int bj = 0; bj < 2; ++bj) { *(f32x4*)(rowp + bj * HALF) = acc[ai][bj][m][0]; *(f32x4*)(rowp + bj * HALF + 4) = acc[ai][bj][m][1]; } }
            return;
        }
        const int g = u.pn * 4 + wc;
        bf16_t* dst; int pitch, dcol, mode; const float* vecp = nullptr; float scale = 1.f;
        if (g < 8)       { dst = QA; pitch = 512;  dcol = 64 * g;        mode = 1; vecp = qn_swa; scale = kC2_64; }
        else if (g < 10) { dst = KA; pitch = 128;  dcol = 64 * (g - 8);  mode = 1; vecp = kn_swa; }
        else if (g < 12) { dst = VA; pitch = 128;  dcol = 64 * (g - 10); mode = 0; }
        else if (g < 20) { dst = QF; pitch = 512;  dcol = 64 * (g - 12); mode = 1; vecp = qn_fox; scale = kC2_64; }
        else if (g < 28) { dst = KF; pitch = 512;  dcol = 64 * (g - 20); mode = 1; vecp = kn_fox; }
        else if (g < 36) { dst = VF; pitch = 512;  dcol = 64 * (g - 28); mode = 0; }
        else if (g < 44) { dst = QM; pitch = 512;  dcol = 64 * (g - 36); mode = 0; }
        else             { dst = GT; pitch = 3072; dcol = 64 * (g - 44); mode = 2; vecp = b_gate + 64 * (g - 44); }
        const int row0 = u.pm * BM + wr * 64 + fr;
        bf16_t* base = dst + dcol + 8 * fq;
        f32x4 cv[2][2];
#pragma unroll
        for (int bj = 0; bj < 2; ++bj)
#pragma unroll
            for (int n = 0; n < 2; ++n) cv[bj][n] = (mode != 0) ? *(const f32x4*)(vecp + 32 * bj + 8 * fq + 4 * n) * scale : (f32x4){0.f, 0.f, 0.f, 0.f};
        if (mode == 1) {
#pragma unroll
            for (int ai = 0; ai < 2; ++ai)
#pragma unroll
                for (int m = 0; m < 4; ++m) { bf16_t* rowp = base + (size_t)(row0 + ai * HALF + m * 16) * pitch;
                    float ss = (dot4(acc[ai][0][m][0]) + dot4(acc[ai][0][m][1])) + (dot4(acc[ai][1][m][0]) + dot4(acc[ai][1][m][1]));
                    ss += __shfl_xor(ss, 16); ss += __shfl_xor(ss, 32);
                    const float r = 1.0f / sqrtf(ss * (1.0f / 64.0f) + kEps);
#pragma unroll
                    for (int bj = 0; bj < 2; ++bj) *(u32x4*)(rowp + 32 * bj) = pack8(acc[ai][bj][m][0] * r * cv[bj][0], acc[ai][bj][m][1] * r * cv[bj][1]); }
        } else if (mode == 2) {
#pragma unroll
            for (int ai = 0; ai < 2; ++ai)
#pragma unroll
                for (int m = 0; m < 4; ++m) { bf16_t* rowp = base + (size_t)(row0 + ai * HALF + m * 16) * pitch;
#pragma unroll
                    for (int bj = 0; bj < 2; ++bj) { f32x4 z0 = (acc[ai][bj][m][0] + cv[bj][0]) * (-kLog2e), z1 = (acc[ai][bj][m][1] + cv[bj][1]) * (-kLog2e);
#pragma unroll
                        for (int j = 0; j < 4; ++j) { z0[j] = __builtin_amdgcn_rcpf(1.0f + __builtin_amdgcn_exp2f(z0[j])); z1[j] = __builtin_amdgcn_rcpf(1.0f + __builtin_amdgcn_exp2f(z1[j])); }
                        *(u32x4*)(rowp + 32 * bj) = pack8(z0, z1); } }
        } else {
#pragma unroll
            for (int ai = 0; ai < 2; ++ai)
#pragma unroll
                for (int m = 0; m < 4; ++m) { bf16_t* rowp = base + (size_t)(row0 + ai * HALF + m * 16) * pitch;
#pragma unroll
                    for (int bj = 0; bj < 2; ++bj) *(u32x4*)(rowp + 32 * bj) = pack8(acc[ai][bj][m][0], acc[ai][bj][m][1]); }
        }
    }
};

struct EpiGateMul {
    static constexpr bool PERM = true, AFTER_DRAIN = false;
    bf16_t* GT;
    __device__ __forceinline__ void operator()(const f32x4 (&acc)[2][2][4][2], const Unit& u, int wr, int wc, int fr, int fq) const {
        const int row0 = u.pm * BM + wr * 64 + fr, col0 = u.pn * BM + wc * 32 + 8 * fq;
#pragma unroll
        for (int ai = 0; ai < 2; ++ai)
#pragma unroll
            for (int m = 0; m < 4; ++m) { bf16_t* rowp = GT + (size_t)(row0 + ai * HALF + m * 16) * 3072 + col0;
#pragma unroll
                for (int bj = 0; bj < 2; ++bj) { const u32x4 gw = *(const u32x4*)(rowp + bj * HALF);
                    f32x4 g0, g1;
                    g0[0] = __uint_as_float(gw.x << 16); g0[1] = __uint_as_float(gw.x & 0xffff0000u); g0[2] = __uint_as_float(gw.y << 16); g0[3] = __uint_as_float(gw.y & 0xffff0000u);
                    g1[0] = __uint_as_float(gw.z << 16); g1[1] = __uint_as_float(gw.z & 0xffff0000u); g1[2] = __uint_as_float(gw.w << 16); g1[3] = __uint_as_float(gw.w & 0xffff0000u);
                    *(u32x4*)(rowp + bj * HALF) = pack8(acc[ai][bj][m][0] * g0, acc[ai][bj][m][1] * g1); }
                asm volatile("" ::: "memory"); }
    }
};

struct EpiOutProj {
    static constexpr bool PERM = false, AFTER_DRAIN = false;
    const float* X; float* OUT; bf16_t* X1B; float* SSQ;
    __device__ __forceinline__ void operator()(const f32x4 (&acc)[2][2][4][2], const Unit& u, int wr, int wc, int fr, int fq) const {
        const int row0 = u.pm * BM + wr * 64 + fr, col0 = u.pn * BM + wc * 32 + 4 * fq;
#pragma unroll
        for (int ai = 0; ai < 2; ++ai)
#pragma unroll
            for (int m = 0; m < 4; ++m) { const int row = row0 + ai * HALF + m * 16; const size_t off = (size_t)row * 1024 + col0; float ss = 0.f;
#pragma unroll
                for (int bj = 0; bj < 2; ++bj)
#pragma unroll
                    for (int n = 0; n < 2; ++n) { const size_t o2 = off + bj * HALF + n * 16; const f32x4 v = *(const f32x4*)(X + o2) + acc[ai][bj][m][n];
                        *(f32x4*)(OUT + o2) = v; ss += dot4(v); u32x2 w; w.x = cvt_pk_bf16(v[0], v[1]); w.y = cvt_pk_bf16(v[2], v[3]); *(u32x2*)(X1B + o2) = w; }
                ss += __shfl_xor(ss, 16); ss += __shfl_xor(ss, 32);
                if (fq == 0) SSQ[(size_t)row * 16 + u.pn * 4 + wc] = ss;
                asm volatile("" ::: "memory"); }
    }
};

struct EpiUp {
    static constexpr bool PERM = true, AFTER_DRAIN = false;
    const float* SSQ; bf16_t* U;
    __device__ __forceinline__ void operator()(const f32x4 (&acc)[2][2][4][2], const Unit& u, int wr, int wc, int fr, int fq) const {
        const int row0 = u.pm * BM + wr * 64 + fr, col0 = u.pn * BM + wc * 32 + 8 * fq;
#pragma unroll
        for (int ai = 0; ai < 2; ++ai)
#pragma unroll
            for (int m = 0; m < 4; ++m) { const int row = row0 + ai * HALF + m * 16; const f32x4* sp = (const f32x4*)(SSQ + (size_t)row * 16);
                const f32x4 s4 = (sp[0] + sp[1]) + (sp[2] + sp[3]); const float tot = (s4[0] + s4[1]) + (s4[2] + s4[3]);
                const float r = 1.0f / sqrtf(tot * (1.0f / 1024.0f) + kEps);
                bf16_t* rowp = U + (size_t)row * 4096 + col0;
#pragma unroll
                for (int bj = 0; bj < 2; ++bj) { f32x4 a = acc[ai][bj][m][0] * r, b = acc[ai][bj][m][1] * r;
#pragma unroll
                    for (int j = 0; j < 4; ++j) { a[j] = fmaxf(a[j], 0.f); a[j] *= a[j]; b[j] = fmaxf(b[j], 0.f); b[j] *= b[j]; }
                    *(u32x4*)(rowp + bj * HALF) = pack8(a, b); }
                asm volatile("" ::: "memory"); }
    }
};

struct EpiDown {
    static constexpr bool PERM = false, AFTER_DRAIN = false;
    float* OUT;
    __device__ __forceinline__ void operator()(const f32x4 (&acc)[2][2][4][2], const Unit& u, int wr, int wc, int fr, int fq) const {
        const int row0 = u.pm * BM + wr * 64 + fr, col0 = u.pn * BM + wc * 32 + 4 * fq;
#pragma unroll
        for (int ai = 0; ai < 2; ++ai)
#pragma unroll
            for (int m = 0; m < 4; ++m) { const size_t off = (size_t)(row0 + ai * HALF + m * 16) * 1024 + col0;
#pragma unroll
                for (int bj = 0; bj < 2; ++bj)
#pragma unroll
                    for (int n = 0; n < 2; ++n) { const size_t o2 = off + bj * HALF + n * 16; *(f32x4*)(OUT + o2) = *(const f32x4*)(OUT + o2) + acc[ai][bj][m][n]; }
                asm volatile("" ::: "memory"); }
    }
};

template <class Epi, class Sched, bool ALIGN_EPI = false, bool SP2 = false>
__device__ __forceinline__ void gemm_phase(PG8_LAS unsigned char* lds, const int K_, const Sched& S, const Epi& E) {
    const int tid = threadIdx.x, wid = __builtin_amdgcn_readfirstlane(tid >> 6), lane = tid & 63, wr = wid >> 2, wc = wid & 3, fr = lane & 15, fq = lane >> 4;
    const int K = K_, nt = K / BK;
    unsigned voffA[2], voffB[2];
#pragma unroll
    for (int i = 0; i < 2; ++i) { int R, C; stage_rc(tid * 16 + i * 8192, R, C); const int Rb = Epi::PERM ? ((R & ~31) + perm32(R & 31)) : R;
        voffA[i] = (unsigned)(R * K + C) * 2u; voffB[i] = (unsigned)(Rb * K + C) * 2u; }
    const size_t kstep = (size_t)(BK * 2);
    const size_t hstep = (size_t)HALF * K * 2;
    const size_t tstep = 2 * hstep;
    const unsigned ldsw = (unsigned)wid * 1024u;
    const int aoff = lds_byte(wr * 64 + fr, fq * 8), boff = lds_byte(wc * 32 + fr, fq * 8);
#define PG8_SA(b, h) (((b) * 2 + (h)) * HTB)
#define PG8_SB(b, h) ((4 + (b) * 2 + (h)) * HTB)
#define PG8_STAGE(bufoff, gbase, voff) do { _Pragma("unroll") for (int _i = 0; _i < 2; ++_i) \
        __builtin_amdgcn_global_load_lds((const unsigned*)((const char*)(gbase) + (voff)[_i]), (PG8_LAS unsigned*)(lds + (bufoff) + ldsw + _i * 8192), 16, 0, 0); } while (0)
#define PG8_LDA(dst, b, h) do { _Pragma("unroll") for (int m = 0; m < 4; ++m) _Pragma("unroll") for (int k = 0; k < 2; ++k) dst[m][k] = *(const PG8_LAS bf16x8*)(lds + PG8_SA(b, h) + aoff + m * 2048 + k * 1024); } while (0)
#define PG8_LDB(dst, b, h) do { _Pragma("unroll") for (int n = 0; n < 2; ++n) _Pragma("unroll") for (int k = 0; k < 2; ++k) dst[n][k] = *(const PG8_LAS bf16x8*)(lds + PG8_SB(b, h) + boff + n * 2048 + k * 1024); } while (0)
#define PG8_MMA(ai, bj, At, Bt) do { __builtin_amdgcn_s_setprio(1); _Pragma("unroll") for (int m = 0; m < 4; ++m) _Pragma("unroll") for (int n = 0; n < 2; ++n) _Pragma("unroll") for (int k = 0; k < 2; ++k) \
        acc[ai][bj][m][n] = __builtin_amdgcn_mfma_f32_16x16x32_bf16(Bt[n][k], At[m][k], acc[ai][bj][m][n], 0, 0, 0); __builtin_amdgcn_s_setprio(0); } while (0)
#define PG8_WAIT_V(n) asm volatile("s_waitcnt vmcnt(" #n ")" ::: "memory")
#define PG8_WAIT_L(n) asm volatile("s_waitcnt lgkmcnt(" #n ")" ::: "memory")
#define PG8_BAR __builtin_amdgcn_s_barrier()
#define PG8_SCHED __builtin_amdgcn_sched_barrier(0)
    Unit cur, nxt; int ui = 0;
    if (!S.next(0, cur)) return;
    f32x4 acc[2][2][4][2];
#pragma unroll
    for (int a = 0; a < 2; ++a)
#pragma unroll
        for (int b = 0; b < 2; ++b)
#pragma unroll
            for (int m = 0; m < 4; ++m)
#pragma unroll
                for (int n = 0; n < 2; ++n) acc[a][b][m][n] = (f32x4){0.f, 0.f, 0.f, 0.f};
    bf16x8 At[4][2], B0[2][2], B1[2][2];
    const char* cA = S.a_ptr(cur); const char* cB = S.b_ptr(cur);
    S.a_ready(cur);
    if constexpr (SP2) {
        PG8_STAGE(PG8_SB(0, 0), cB, voffB); PG8_STAGE(PG8_SB(0, 1), cB + hstep, voffB); PG8_STAGE(PG8_SA(0, 0), cA, voffA); PG8_STAGE(PG8_SA(0, 1), cA + hstep, voffA);
        if (wr == 1) PG8_BAR;
        PG8_WAIT_V(2); PG8_BAR;
        PG8_STAGE(PG8_SB(1, 0), cB + kstep, voffB); PG8_STAGE(PG8_SA(1, 0), cA + kstep, voffA); PG8_STAGE(PG8_SB(1, 1), cB + hstep + kstep, voffB);
        PG8_WAIT_V(6); PG8_BAR;
    } else {
        PG8_STAGE(PG8_SB(0, 0), cB, voffB); PG8_STAGE(PG8_SA(0, 0), cA, voffA); PG8_STAGE(PG8_SB(0, 1), cB + hstep, voffB); PG8_STAGE(PG8_SA(0, 1), cA + hstep, voffA);
        if (wr == 1) PG8_BAR;
        PG8_WAIT_V(4); PG8_BAR;
        PG8_STAGE(PG8_SB(1, 0), cB + kstep, voffB); PG8_STAGE(PG8_SA(1, 0), cA + kstep, voffA); PG8_STAGE(PG8_SB(1, 1), cB + hstep + kstep, voffB);
        PG8_WAIT_V(6); PG8_BAR;
    }
    for (;;) {
        const bool has_next = S.next(ui + 1, nxt);
        const char* nA = has_next ? S.a_ptr(nxt) : cA; const char* nB = has_next ? S.b_ptr(nxt) : cB;
        for (int t = 0; t < nt; t += 2) {
            const bool last = (t == nt - 2);
            const char* a1 = cA + (size_t)(t + 1) * kstep;
            const char* a2 = last ? nA : cA + (size_t)(t + 2) * kstep; const char* b2 = last ? nB : cB + (size_t)(t + 2) * kstep;
            const char* a3 = a2 + kstep; const char* b3 = b2 + kstep;
            if (last && has_next) S.a_ready(nxt);
            if constexpr (SP2) {
            PG8_LDB(B0, 0, 0); PG8_LDB(B1, 0, 1); PG8_SCHED; PG8_LDA(At, 0, 0); PG8_STAGE(PG8_SA(1, 1), a1 + hstep, voffA);
            PG8_WAIT_V(8); PG8_WAIT_L(0); PG8_BAR; PG8_MMA(0, 0, At, B0); PG8_MMA(0, 1, At, B1); PG8_BAR; PG8_SCHED;
            PG8_LDA(At, 0, 1); PG8_STAGE(PG8_SB(0, 0), b2, voffB); PG8_STAGE(PG8_SB(0, 1), b2 + hstep, voffB); PG8_STAGE(PG8_SA(0, 0), a2, voffA);
            PG8_WAIT_V(8); PG8_WAIT_L(0); PG8_BAR; PG8_MMA(1, 0, At, B0); PG8_MMA(1, 1, At, B1); PG8_BAR; PG8_SCHED;
            PG8_LDB(B0, 1, 0); PG8_LDB(B1, 1, 1); PG8_SCHED; PG8_LDA(At, 1, 0); PG8_STAGE(PG8_SA(0, 1), a2 + hstep, voffA);
            PG8_WAIT_V(8); PG8_WAIT_L(0); PG8_BAR; PG8_MMA(0, 0, At, B0); PG8_MMA(0, 1, At, B1); PG8_BAR; PG8_SCHED;
            PG8_LDA(At, 1, 1); PG8_STAGE(PG8_SB(1, 0), b3, voffB); PG8_STAGE(PG8_SB(1, 1), b3 + hstep, voffB); PG8_STAGE(PG8_SA(1, 0), a3, voffA);
            PG8_WAIT_V(8); PG8_WAIT_L(0); PG8_BAR; PG8_MMA(1, 0, At, B0); PG8_MMA(1, 1, At, B1); PG8_BAR; PG8_SCHED;
            } else {
            PG8_LDB(B0, 0, 0); PG8_SCHED; PG8_LDA(At, 0, 0); PG8_STAGE(PG8_SA(1, 1), a1 + hstep, voffA);
            PG8_WAIT_L(8); PG8_BAR; PG8_WAIT_L(0); PG8_MMA(0, 0, At, B0); PG8_BAR; PG8_SCHED;
            PG8_LDB(B1, 0, 1); PG8_STAGE(PG8_SB(0, 0), b2, voffB);
            PG8_BAR; PG8_WAIT_L(0); PG8_MMA(0, 1, At, B1); PG8_BAR;
            PG8_LDA(At, 0, 1); PG8_STAGE(PG8_SA(0, 0), a2, voffA);
            PG8_BAR; PG8_WAIT_L(0); PG8_MMA(1, 0, At, B0); PG8_BAR; PG8_SCHED;
            PG8_STAGE(PG8_SB(0, 1), b2 + hstep, voffB);
            PG8_WAIT_V(6); PG8_BAR; PG8_MMA(1, 1, At, B1); PG8_BAR;
            PG8_LDB(B0, 1, 0); PG8_SCHED; PG8_LDA(At, 1, 0); PG8_STAGE(PG8_SA(0, 1), a2 + hstep, voffA);
            PG8_WAIT_L(8); PG8_BAR; PG8_WAIT_L(0); PG8_MMA(0, 0, At, B0); PG8_BAR; PG8_SCHED;
            PG8_LDB(B1, 1, 1); PG8_STAGE(PG8_SB(1, 0), b3, voffB);
            PG8_BAR; PG8_WAIT_L(0); PG8_MMA(0, 1, At, B1); PG8_BAR;
            PG8_LDA(At, 1, 1); PG8_STAGE(PG8_SA(1, 0), a3, voffA);
            PG8_BAR; PG8_WAIT_L(0); PG8_MMA(1, 0, At, B0); PG8_BAR; PG8_SCHED;
            PG8_STAGE(PG8_SB(1, 1), b3 + hstep, voffB);
            PG8_WAIT_V(6); PG8_BAR; PG8_MMA(1, 1, At, B1); PG8_BAR;
            }
        }
        if constexpr (ALIGN_EPI) { if (wr == 0) PG8_BAR; }
        if constexpr (!Epi::AFTER_DRAIN) { E(acc, cur, wr, wc, fr, fq); S.done(cur); }
        if (!has_next) break;
#pragma unroll
        for (int a = 0; a < 2; ++a)
#pragma unroll
            for (int b = 0; b < 2; ++b)
#pragma unroll
                for (int m = 0; m < 4; ++m)
#pragma unroll
                    for (int n = 0; n < 2; ++n) acc[a][b][m][n] = (f32x4){0.f, 0.f, 0.f, 0.f};
        cur = nxt; cA = nA; cB = nB; ++ui;
        if constexpr (ALIGN_EPI) { if (wr == 1) PG8_BAR; }
    }
    PG8_WAIT_V(0);
    if constexpr (!ALIGN_EPI) { if (wr == 0) PG8_BAR; }
    PG8_BAR;
    if constexpr (Epi::AFTER_DRAIN) { E.fused(acc, cur, wr, wc, fr, fq, lds, wid, lane); S.done(cur); }
#undef PG8_SA
#undef PG8_SB
#undef PG8_STAGE
#undef PG8_LDA
#undef PG8_LDB
#undef PG8_MMA
#undef PG8_WAIT_V
#undef PG8_WAIT_L
#undef PG8_BAR
#undef PG8_SCHED
}
}
namespace attn_body {
using bf16=__hip_bfloat16;
using bf16x8=__attribute__((ext_vector_type(8)))short;
using s16x4=__attribute__((ext_vector_type(4)))short;
using f32x16=__attribute__((ext_vector_type(16)))float;
using f32x4=__attribute__((ext_vector_type(4)))float;
using u32x4=__attribute__((ext_vector_type(4)))unsigned;
constexpr int SEQ=4096,D=64,PQ=512;
constexpr int NW=8,QBLK=32,QB=QBLK*NW,KVBLK=64;
__device__ __forceinline__ int crow(int r,int hi){return (r&3)+8*(r>>2)+4*hi;}
#define SBAR() __builtin_amdgcn_sched_barrier(0)
__device__ __forceinline__ void cmask(f32x16&p0,f32x16&p1,int jb,int qrel,int hi){
  const float NEG=-INFINITY; int kb=64*jb+4*hi;
  #pragma unroll
  for(int r=0;r<16;++r){int kv=kb+(r&3)+8*(r>>2); if(kv>qrel)p0[r]=NEG; if(kv+32>qrel)p1[r]=NEG;}
}
constexpr int NSLOT=3, SLOTB=8192;
constexpr int LDS_K=0, LDS_V=NSLOT*SLOTB, LDS_WS=2*NSLOT*SLOTB, LDS_OST=LDS_WS+NW*64*4, LDS_GL=LDS_OST+NW*4096+2048  , LDS_TB=LDS_GL+16384  , LDS_BYTES=LDS_TB+2560;
constexpr float LOG2E=1.4426950408889634f;
__device__ __forceinline__ void glds16(const void*gsrc,unsigned lds_dst){unsigned keep;
  asm volatile("s_mov_b32 %0, m0\n\ts_mov_b32 m0, %2\n\ts_nop 0\n\tglobal_load_lds_dwordx4 %1, off\n\ts_mov_b32 m0, %0":"=&s"(keep):"v"(gsrc),"s"(lds_dst):"memory");}
typedef float f32x2_t __attribute__((ext_vector_type(2))); typedef __bf16 bf16x2_t __attribute__((ext_vector_type(2)));
__device__ __forceinline__ unsigned cvtpk_s(float lo,float hi){f32x2_t v={lo,hi};bf16x2_t b=__builtin_convertvector(v,bf16x2_t);return __builtin_bit_cast(unsigned,b);}
#define WAIT_BAR(N) asm volatile("s_waitcnt vmcnt(" #N ") lgkmcnt(0)\n\ts_barrier":::"memory")
typedef __attribute__((address_space(3))) const char* lds_cptr;
typedef __attribute__((address_space(3))) float* lds_fptr;
typedef __attribute__((address_space(3))) f32x4* lds_f4ptr;
typedef short v4i16_t __attribute__((ext_vector_type(4)));
#define MX3(a,b,c) __builtin_fmaxf(__builtin_fmaxf((a),(b)),(c))
__device__ __forceinline__ void qkt(f32x16&p0,f32x16&p1,const char*Kslot,const bf16x8*qr,int r32,int hi){
  const char*kb=Kslot+hi*1024+r32*16;
  #pragma unroll
  for(int d0=0;d0<4;++d0){
    const bf16x8 b0=*reinterpret_cast<const bf16x8*>(kb+d0*2048);
    const bf16x8 b1=*reinterpret_cast<const bf16x8*>(kb+d0*2048+512);
    p0=__builtin_amdgcn_mfma_f32_32x32x16_bf16(b0,qr[d0],p0,0,0,0);p1=__builtin_amdgcn_mfma_f32_32x32x16_bf16(b1,qr[d0],p1,0,0,0);}
}
__device__ __forceinline__ void kload8(bf16x8*kf,lds_cptr kp){
  kf[0]=*(const __attribute__((address_space(3))) bf16x8*)(kp);      kf[1]=*(const __attribute__((address_space(3))) bf16x8*)(kp+512);
  kf[2]=*(const __attribute__((address_space(3))) bf16x8*)(kp+2048); kf[3]=*(const __attribute__((address_space(3))) bf16x8*)(kp+2560);
  kf[4]=*(const __attribute__((address_space(3))) bf16x8*)(kp+4096); kf[5]=*(const __attribute__((address_space(3))) bf16x8*)(kp+4608);
  kf[6]=*(const __attribute__((address_space(3))) bf16x8*)(kp+6144); kf[7]=*(const __attribute__((address_space(3))) bf16x8*)(kp+6656);
}
__device__ __forceinline__ void kload2(bf16x8*kf,lds_cptr kp,int j){ kf[2*j]=*(const __attribute__((address_space(3))) bf16x8*)(kp+j*2048); kf[2*j+1]=*(const __attribute__((address_space(3))) bf16x8*)(kp+j*2048+512); }
__device__ __forceinline__ s16x4 vtr(lds_cptr p){ return __builtin_bit_cast(s16x4,__builtin_amdgcn_ds_read_tr16_b64_v4i16((__attribute__((address_space(3))) v4i16_t*)p)); }
__device__ __forceinline__ float rowmax(const f32x16&p0,const f32x16&p1){
  float a=MX3(p0[0],p0[1],p1[0]),b=MX3(p0[2],p0[3],p1[1]);a=MX3(a,p1[2],p1[3]);
  #pragma unroll
  for(int r=4;r<16;r+=4){a=MX3(a,p0[r],p0[r+1]);b=MX3(b,p0[r+2],p0[r+3]);a=MX3(a,p1[r],p1[r+1]);b=MX3(b,p1[r+2],p1[r+3]);}
  float m=__builtin_fmaxf(a,b);
  auto rr=__builtin_amdgcn_permlane32_swap(__float_as_uint(m),__float_as_uint(m),false,false);
  return __builtin_fmaxf(__uint_as_float(rr[0]),__uint_as_float(rr[1]));
}
__device__ __forceinline__ void pv(f32x16*o,int vb,bf16x8 pa0,bf16x8 pa1,bf16x8 pa2,bf16x8 pa3){
  #pragma unroll
  for(int d0=0;d0<2;++d0){s16x4 lo[4],hi[4];
    #pragma unroll
    for(int ks=0;ks<4;++ks){
      asm volatile("ds_read_b64_tr_b16 %0,%1 offset:%c2":"=&v"(lo[ks]):"v"(vb),"i"(d0*4096+ks*1024):"memory");
      asm volatile("ds_read_b64_tr_b16 %0,%1 offset:%c2":"=&v"(hi[ks]):"v"(vb),"i"(d0*4096+ks*1024+512):"memory");}
    asm volatile("s_waitcnt lgkmcnt(0)":::"memory");SBAR();
    #define PK(k) (bf16x8){lo[k][0],lo[k][1],lo[k][2],lo[k][3],hi[k][0],hi[k][1],hi[k][2],hi[k][3]}
    o[d0]=__builtin_amdgcn_mfma_f32_32x32x16_bf16(pa0,PK(0),o[d0],0,0,0);
    o[d0]=__builtin_amdgcn_mfma_f32_32x32x16_bf16(pa1,PK(1),o[d0],0,0,0);
    o[d0]=__builtin_amdgcn_mfma_f32_32x32x16_bf16(pa2,PK(2),o[d0],0,0,0);
    o[d0]=__builtin_amdgcn_mfma_f32_32x32x16_bf16(pa3,PK(3),o[d0],0,0,0);
    #undef PK
  }
}

#define ATTN_STORE16(p,v) (*(u32x4*)(p)=(v))
template<int MODE,int PKV,int THRL> __device__ __forceinline__ void attn_unit(const bf16*Qw0,const bf16*__restrict__ Kh,const bf16*__restrict__ Vh,bf16*Ow0,const int NT,const int q0,const int dq,const float l0,const float*__restrict__ gsrc,const float*__restrict__ rb,char*shm){
  const int tid=threadIdx.x,lane=tid&63,r32=lane&31,hi=lane>>5; const int wid=__builtin_amdgcn_readfirstlane(tid>>6);
  const bf16*Qw=Qw0+(long)(wid*QBLK)*PQ;
  const unsigned lds0=(unsigned)(uintptr_t)shm;
  float*wsf=(float*)(shm+LDS_WS)+wid*64;
  const lds_cptr shm3=(lds_cptr)shm;
  const lds_fptr gl=(lds_fptr)(shm3+LDS_GL); const lds_fptr tb=(lds_fptr)(shm3+LDS_TB);
  if(MODE==0){ const int n4=(q0+QB)>>2; for(int i=tid;i<n4;i+=NW*64) ((lds_f4ptr)gl)[i]=((const f32x4*)gsrc)[i]; }
  else{ for(int i=tid;i<640;i+=NW*64){ const int d=i-256; float v=-1e30f;
      if(d>=0&&d<128){ int bk=d; if(d>=16){ bk=16+(int)(__logf((float)d*(1.0f/16.0f))*(16.0f/2.0794415416798357f)); bk=bk>31?31:bk; } v=rb[bk*8]*LOG2E; }
      tb[i]=v; } }
  const bf16*ksrc=Kh+(long)lane*PKV+wid*8;
  const bf16*vsrc=Vh+(long)(16*(wid&3)+(lane>>2))*PKV+(wid>>2)*32+(lane&3)*8;
  const unsigned kdst=lds0+LDS_K+wid*1024, vdst=lds0+LDS_V+wid*1024;
  #define DMA_K(t,slot) glds16(ksrc+(long)(t)*KVBLK*PKV,(unsigned)__builtin_amdgcn_readfirstlane(kdst+(slot)))
  #define DMA_V(t,slot) glds16(vsrc+(long)(t)*KVBLK*PKV,(unsigned)__builtin_amdgcn_readfirstlane(vdst+(slot)))
  const int vb0=(int)(lds0+LDS_V)+((lane>>4)&1)*32+(lane&3)*8+(4*hi+((lane&15)>>2))*64;
  const char*Kbase=shm+LDS_K; bf16x8 kf[8];
  const lds_cptr kp0=shm3+LDS_K+hi*1024+r32*16; const lds_cptr vp0=shm3+LDS_V+((lane>>4)&1)*32+(lane&3)*8+(4*hi+((lane&15)>>2))*64;
  DMA_K(0,0);DMA_V(0,0);DMA_K(1,SLOTB);
  bf16x8 qr[4];
  #pragma unroll
  for(int d0=0;d0<4;++d0)qr[d0]=*reinterpret_cast<const bf16x8*>(&Qw[(long)r32*PQ+d0*16+hi*8]);
  const int qrel=wid*QBLK+r32;
  float mhat=(MODE==0)?gsrc[q0+qrel]:0.f; float l_reg=(MODE==0)?0.f:((hi==0)?l0:0.f);
  f32x16 o[2];o[0]=f32x16{};o[1]=f32x16{};
  #define CMASK(P0,P1,t) do{ if(MODE==0){int jb_=(t)-(NT-4); if(jb_>=0)cmask(P0,P1,jb_,qrel,hi);} }while(0)
  #define CINIT(X0,X1,tt) do{ if(MODE==0){ const lds_f4ptr gp_=(lds_f4ptr)(gl+64*(tt)+4*hi); \
        _Pragma("unroll") for(int g4=0;g4<4;++g4){ const f32x4 a_=gp_[2*g4], b_=gp_[8+2*g4]; \
          X0[4*g4]=a_[0]-mhat;X0[4*g4+1]=a_[1]-mhat;X0[4*g4+2]=a_[2]-mhat;X0[4*g4+3]=a_[3]-mhat; X1[4*g4]=b_[0]-mhat;X1[4*g4+1]=b_[1]-mhat;X1[4*g4+2]=b_[2]-mhat;X1[4*g4+3]=b_[3]-mhat; } } \
      else{ const lds_fptr tp_=tb+(dq+qrel-4*hi+256-64*(tt)); \
        _Pragma("unroll") for(int r=0;r<16;++r){ X0[r]=tp_[-((r&3)+8*(r>>2))]-mhat; X1[r]=tp_[-32-((r&3)+8*(r>>2))]-mhat; } } }while(0)
  bool resc=false;
  #define RESC() do{ if(resc){ asm volatile("s_waitcnt lgkmcnt(0)":::"memory"); \
      _Pragma("unroll") for(int d_=0;d_<2;++d_) _Pragma("unroll") for(int r=0;r<16;++r)o[d_][r]*=wsf[crow(r,hi)]; } }while(0)
  f32x16 pA0,pA1,pB0,pB1;
  int sl_prev=0,sl_cur=0,sl_next=SLOTB;
  #define ROT() do{sl_prev=sl_cur;sl_cur=sl_next;sl_next=(sl_next==(NSLOT-1)*SLOTB)?0:sl_next+SLOTB;}while(0)
  DMA_K(2,2*SLOTB);
  WAIT_BAR(3);
  CINIT(pA0,pA1,0);
  qkt(pA0,pA1,Kbase,qr,r32,hi);CMASK(pA0,pA1,0);
  { const float rm=rowmax(pA0,pA1);
    if(__any(rm>(float)THRL)){ const float dl=__builtin_fmaxf(rm,0.f); mhat+=dl;
      _Pragma("unroll") for(int r=0;r<16;++r){pA0[r]-=dl;pA1[r]-=dl;}
      l_reg*=__builtin_amdgcn_exp2f(-dl); }
    _Pragma("unroll") for(int r=0;r<16;++r){pA0[r]=__builtin_amdgcn_exp2f(pA0[r]);pA1[r]=__builtin_amdgcn_exp2f(pA1[r]);} }
  WAIT_BAR(0);
  DMA_K(3,0);DMA_V(1,SLOTB);
  ROT();
  kload8(kf,kp0+sl_cur);
  CINIT(pB0,pB1,1);
  WAIT_BAR(2);
  s16x4 vlo[8],vhi[8]; u32x4 pw0,pw1,pw2,pw3;
  #define PKW(P,B) cvtpk_s(P[B],P[B+1])
  #define PAF(k) __builtin_bit_cast(bf16x8,pw##k)
  #define VFR(i) (bf16x8){vlo[i][0],vlo[i][1],vlo[i][2],vlo[i][3],vhi[i][0],vhi[i][1],vhi[i][2],vhi[i][3]}
  #define PIN(x) asm volatile("":"+v"(x))
  #define GAPA(MF,A0,A1,A2,A3,W0,W1,PW) do{ MF; sacc+=A0; sacc+=A1; sacc+=A2; sacc+=A3; PIN(sacc); W0; W1; PIN(PW); SBAR(); }while(0)
  #define EX(v) __builtin_amdgcn_exp2f(v)
  #define GAPB(MF,X,B) do{ MF; X[B]=EX(X[B]); X[B+1]=EX(X[B+1]); X[B+2]=EX(X[B+2]); X[B+3]=EX(X[B+3]); PIN(X); SBAR(); }while(0)
  #define VRD(i) do{ vlo[i]=vtr(vp_+(((i)>>2)*4096+((i)&3)*1024)); vhi[i]=vtr(vp_+(((i)>>2)*4096+((i)&3)*1024+512)); }while(0)
  #define KRD(G,j) do{ if(G){ kload2(kf,kp0+sl_next,j); SBAR(); } }while(0)
  #define STEP(C0,C1,P0,P1,t,GK,GV,GL) do{ SBAR(); \
    const lds_cptr vp_=vp0+sl_prev; \
    VRD(0); SBAR(); float sacc=(P0[0]+P0[1]); \
    GAPA(C0=__builtin_amdgcn_mfma_f32_32x32x16_bf16(kf[0],qr[0],C0,0,0,0), P0[2],P0[3],P0[4],P0[5],     pw0[0]=PKW(P0,0), pw0[1]=PKW(P0,2), pw0); \
    VRD(4); SBAR(); GAPA(C1=__builtin_amdgcn_mfma_f32_32x32x16_bf16(kf[1],qr[0],C1,0,0,0), P0[6],P0[7],P0[8],P0[9],     pw0[2]=PKW(P0,4), pw0[3]=PKW(P0,6), pw0); \
    VRD(1); SBAR(); GAPA(C0=__builtin_amdgcn_mfma_f32_32x32x16_bf16(kf[2],qr[1],C0,0,0,0),   P0[10],P0[11],P0[12],P0[13], pw1[0]=PKW(P0,8), pw1[1]=PKW(P0,10), pw1); \
    VRD(5); SBAR(); GAPA(C1=__builtin_amdgcn_mfma_f32_32x32x16_bf16(kf[3],qr[1],C1,0,0,0),   P0[14],P0[15],P1[0],P1[1],   pw1[2]=PKW(P0,12),pw1[3]=PKW(P0,14), pw1); \
    VRD(2); SBAR(); GAPA(C0=__builtin_amdgcn_mfma_f32_32x32x16_bf16(kf[4],qr[2],C0,0,0,0),   P1[2],P1[3],P1[4],P1[5],     pw2[0]=PKW(P1,0), pw2[1]=PKW(P1,2), pw2); \
    VRD(6); SBAR(); GAPA(C1=__builtin_amdgcn_mfma_f32_32x32x16_bf16(kf[5],qr[2],C1,0,0,0),   P1[6],P1[7],P1[8],P1[9],     pw2[2]=PKW(P1,4), pw2[3]=PKW(P1,6), pw2); \
    VRD(3); SBAR(); GAPA(C0=__builtin_amdgcn_mfma_f32_32x32x16_bf16(kf[6],qr[3],C0,0,0,0),   P1[10],P1[11],P1[12],P1[13], pw3[0]=PKW(P1,8), pw3[1]=PKW(P1,10), pw3); \
    VRD(7); SBAR(); GAPA(C1=__builtin_amdgcn_mfma_f32_32x32x16_bf16(kf[7],qr[3],C1,0,0,0),   P1[14],P1[15],0.f,0.f,       pw3[2]=PKW(P1,12),pw3[3]=PKW(P1,14), pw3); \
    l_reg+=sacc; \
    if(GK){DMA_K((t)+3,sl_cur);} if(GV){DMA_V((t)+1,sl_next);} \
    CMASK(C0,C1,t); \
    { float a=MX3(C0[0],C0[1],C1[0]),b=MX3(C0[2],C0[3],C1[1]); a=MX3(a,C1[2],C1[3]); \
      _Pragma("unroll") for(int r=4;r<16;r+=4){a=MX3(a,C0[r],C0[r+1]);b=MX3(b,C0[r+2],C0[r+3]);a=MX3(a,C1[r],C1[r+1]);b=MX3(b,C1[r+2],C1[r+3]);} \
      float rm=__builtin_fmaxf(a,b); { auto rr=__builtin_amdgcn_permlane32_swap(__float_as_uint(rm),__float_as_uint(rm),false,false); rm=__builtin_fmaxf(__uint_as_float(rr[0]),__uint_as_float(rr[1])); } \
      resc=false; \
      if(__builtin_expect(__any(rm>(float)THRL),0)){ const float dl=__builtin_fmaxf(rm,0.f); mhat+=dl; \
        _Pragma("unroll") for(int r=0;r<16;++r){C0[r]-=dl;C1[r]-=dl;} \
        const float f=__builtin_amdgcn_exp2f(-dl); l_reg*=f; if(hi==0)wsf[r32]=f; resc=true; } } \
    SBAR(); \
    GAPB(o[0]=__builtin_amdgcn_mfma_f32_32x32x16_bf16(PAF(0),VFR(0),o[0],0,0,0), C0,0); \
    GAPB(o[1]=__builtin_amdgcn_mfma_f32_32x32x16_bf16(PAF(0),VFR(4),o[1],0,0,0), C0,4); \
    KRD(GL,0); GAPB(o[0]=__builtin_amdgcn_mfma_f32_32x32x16_bf16(PAF(1),VFR(1),o[0],0,0,0), C0,8); \
    KRD(GL,1); GAPB(o[1]=__builtin_amdgcn_mfma_f32_32x32x16_bf16(PAF(1),VFR(5),o[1],0,0,0), C0,12); \
    KRD(GL,2); GAPB(o[0]=__builtin_amdgcn_mfma_f32_32x32x16_bf16(PAF(2),VFR(2),o[0],0,0,0), C1,0); \
    KRD(GL,3); GAPB(o[1]=__builtin_amdgcn_mfma_f32_32x32x16_bf16(PAF(2),VFR(6),o[1],0,0,0), C1,4); \
    GAPB(o[0]=__builtin_amdgcn_mfma_f32_32x32x16_bf16(PAF(3),VFR(3),o[0],0,0,0), C1,8); \
    GAPB(o[1]=__builtin_amdgcn_mfma_f32_32x32x16_bf16(PAF(3),VFR(7),o[1],0,0,0), C1,12); \
    if(GV){ CINIT(P0,P1,(t)+1); SBAR(); } \
    }while(0)
  int t=1;
  #undef CMASK
  #define CMASK(P0,P1,t) do{}while(0)
  for(;t+5<NT;t+=2){
    STEP(pB0,pB1,pA0,pA1,t,true,true,true);     WAIT_BAR(2); RESC(); ROT();
    STEP(pA0,pA1,pB0,pB1,t+1,true,true,true);   WAIT_BAR(2); RESC(); ROT();
  }
  #undef CMASK
  #define CMASK(P0,P1,t) do{ if(MODE==0){int jb_=(t)-(NT-4); if(jb_>=0)cmask(P0,P1,jb_,qrel,hi);} }while(0)
  #define ENDW(tt) do{ if((tt)+3<NT){WAIT_BAR(2);} else if((tt)+2<NT){WAIT_BAR(1);} else {WAIT_BAR(0);} }while(0)
  for(;t+1<NT;t+=2){
    STEP(pB0,pB1,pA0,pA1,t,(t+3<NT),(t+1<NT),(t+1<NT));       ENDW(t);   RESC(); ROT();
    STEP(pA0,pA1,pB0,pB1,t+1,(t+4<NT),(t+2<NT),(t+2<NT));     ENDW(t+1); RESC(); ROT();
  }
  STEP(pB0,pB1,pA0,pA1,NT-1,false,false,false); RESC();
  { float sacc=pB0[0]+pB0[1]; _Pragma("unroll") for(int r=2;r<16;++r)sacc+=pB0[r]; _Pragma("unroll") for(int r=0;r<16;++r)sacc+=pB1[r]; l_reg+=sacc;
    pw0=(u32x4){PKW(pB0,0),PKW(pB0,2),PKW(pB0,4),PKW(pB0,6)};pw1=(u32x4){PKW(pB0,8),PKW(pB0,10),PKW(pB0,12),PKW(pB0,14)};pw2=(u32x4){PKW(pB1,0),PKW(pB1,2),PKW(pB1,4),PKW(pB1,6)};pw3=(u32x4){PKW(pB1,8),PKW(pB1,10),PKW(pB1,12),PKW(pB1,14)};
    SBAR(); pv(o,vb0+sl_cur,PAF(0),PAF(1),PAF(2),PAF(3)); }
  #undef PKW
  #undef PAF
  #undef VFR
  #undef PIN
  #undef GAPA
  #undef GAPB
  #undef EX
  #undef VRD
  #undef KRD
  #undef STEP
  #undef ENDW
  {auto rr=__builtin_amdgcn_permlane32_swap(__float_as_uint(l_reg),__float_as_uint(l_reg),false,false);l_reg=__uint_as_float(rr[0])+__uint_as_float(rr[1]);}
  if(hi==0)wsf[32+r32]=l_reg;asm volatile("s_waitcnt lgkmcnt(0)":::"memory");
  float rli[16];
  #pragma unroll
  for(int r=0;r<16;++r)rli[r]=__builtin_amdgcn_rcpf(wsf[32+crow(r,hi)]);
  bf16*Ow=Ow0+(long)(wid*QBLK)*PQ;
  { bf16*stg=(bf16*)(shm+LDS_OST)+wid*2048;
    #pragma unroll
    for(int r=0;r<16;++r){const int orow=crow(r,hi);
      #pragma unroll
      for(int d0=0;d0<2;++d0)stg[orow*64+d0*32+r32]=__float2bfloat16(o[d0][r]*rli[r]);}
    asm volatile("s_waitcnt lgkmcnt(0)":::"memory");
    #pragma unroll
    for(int i=0;i<4;++i){const int row=i*8+(lane>>3),ch=lane&7; const u32x4 v=*(const u32x4*)(stg+row*64+ch*8); ATTN_STORE16(Ow+(long)row*PQ+ch*8,v);} }
  asm volatile("s_waitcnt lgkmcnt(0)\n\ts_barrier":::"memory");
  #undef DMA_K
  #undef DMA_V
  #undef CMASK
  #undef CINIT
  #undef RESC
  #undef ROT
}

constexpr int MEM_K=0, MEM_V=65536;
__device__ __forceinline__ void mem_unit(int b,int h,int qb,const float*__restrict__ MKV,const bf16*QM,bf16*OM,const float*__restrict__ kn,const float*__restrict__ qn,char*shm,char*wsbase){
  const int tid=threadIdx.x,lane=tid&63,r32=lane&31,hi=lane>>5; const int wid=__builtin_amdgcn_readfirstlane(tid>>6);
  const lds_cptr shm3=(lds_cptr)shm;
  const lds_fptr wsf=(lds_fptr)((lds_cptr)wsbase)+wid*64;
  constexpr float C2M=0.08838834764831845f*LOG2E, EPSM=1e-6f;
  { const int j=tid>>1,hf=tid&1; const float*kr=MKV+(size_t)(b*256+j)*1024+h*128+64*hf;
    f32x4 v[16]; float ss=0.f;
    #pragma unroll
    for(int i=0;i<16;++i){ v[i]=((const f32x4*)kr)[i]; ss+=(v[i][0]*v[i][0]+v[i][1]*v[i][1])+(v[i][2]*v[i][2]+v[i][3]*v[i][3]); }
    ss+=__shfl_xor(ss,1);
    const float rk=(1.0f/sqrtf(ss*(1.0f/128.0f)+EPSM))*C2M;
    const f32x4*kg=(const f32x4*)(kn+64*hf); const f32x4*qg=(const f32x4*)(qn+64*hf);
    #pragma unroll
    for(int c8=0;c8<8;++c8){ const f32x4 a=v[2*c8]*rk*kg[2*c8]*qg[2*c8], bb=v[2*c8+1]*rk*kg[2*c8+1]*qg[2*c8+1];
      u32x4 w; w.x=cvtpk_s(a[0],a[1]); w.y=cvtpk_s(a[2],a[3]); w.z=cvtpk_s(bb[0],bb[1]); w.w=cvtpk_s(bb[2],bb[3]);
      *(__attribute__((address_space(3))) u32x4*)(shm3+MEM_K+(8*hf+c8)*4096+j*16)=w; }
    const float*vr=kr+512;
    #pragma unroll
    for(int i=0;i<16;++i) v[i]=((const f32x4*)vr)[i];
    #pragma unroll
    for(int q16=0;q16<8;++q16){ const f32x4 a=v[2*q16], bb=v[2*q16+1];
      u32x4 w; w.x=cvtpk_s(a[0],a[1]); w.y=cvtpk_s(a[2],a[3]); w.z=cvtpk_s(bb[0],bb[1]); w.w=cvtpk_s(bb[2],bb[3]);
      *(__attribute__((address_space(3))) u32x4*)(shm3+MEM_V+(j>>6)*16384+(2*hf+(q16>>2))*4096+(j&63)*64+(q16&3)*16)=w; } }
  const bf16*Qw=QM+(size_t)(b*SEQ+qb*QB+wid*QBLK+r32)*PQ+h*128+hi*8;
  bf16x8 qr[8]; float qs=0.f;
  #pragma unroll
  for(int d0=0;d0<8;++d0){ qr[d0]=*reinterpret_cast<const bf16x8*>(Qw+16*d0);
    #pragma unroll
    for(int e=0;e<8;++e){ const float f=__uint_as_float(((unsigned)(unsigned short)qr[d0][e])<<16); qs+=f*f; } }
  { auto rr=__builtin_amdgcn_permlane32_swap(__float_as_uint(qs),__float_as_uint(qs),false,false); qs=__uint_as_float(rr[0])+__uint_as_float(rr[1]); }
  const float sc=1.0f/sqrtf(qs*(1.0f/128.0f)+EPSM);
  __syncthreads();
  float m=-1e30f,l=0.f; f32x16 o[4]; o[0]=f32x16{};o[1]=f32x16{};o[2]=f32x16{};o[3]=f32x16{};
  const lds_cptr kp0=shm3+MEM_K+hi*4096+r32*16;
  const lds_cptr vp0=shm3+MEM_V+((lane>>4)&1)*32+(lane&3)*8+(4*hi+((lane&15)>>2))*64;
  #pragma unroll 1
  for(int t=0;t<4;++t){
    f32x16 p0=f32x16{},p1=f32x16{};
    #pragma unroll
    for(int d0=0;d0<8;++d0){ const bf16x8 a0=*(const __attribute__((address_space(3))) bf16x8*)(kp0+d0*8192+t*1024), a1=*(const __attribute__((address_space(3))) bf16x8*)(kp0+d0*8192+t*1024+512);
      p0=__builtin_amdgcn_mfma_f32_32x32x16_bf16(a0,qr[d0],p0,0,0,0); p1=__builtin_amdgcn_mfma_f32_32x32x16_bf16(a1,qr[d0],p1,0,0,0); }
    #pragma unroll
    for(int r=0;r<16;++r){p0[r]*=sc;p1[r]*=sc;}
    const float rm=rowmax(p0,p1); const float mn=__builtin_fmaxf(m,rm); const float alpha=__builtin_amdgcn_exp2f(m-mn); m=mn;
    float rs=0.f;
    #pragma unroll
    for(int r=0;r<16;++r){p0[r]=__builtin_amdgcn_exp2f(p0[r]-mn);p1[r]=__builtin_amdgcn_exp2f(p1[r]-mn);rs+=p0[r]+p1[r];}
    l=l*alpha+rs;
    if(hi==0)wsf[r32]=alpha;
    #pragma unroll
    for(int r=0;r<16;++r){ const float a=wsf[crow(r,hi)]; o[0][r]*=a;o[1][r]*=a;o[2][r]*=a;o[3][r]*=a; }
    u32x4 pw0,pw1,pw2,pw3;
    pw0=(u32x4){cvtpk_s(p0[0],p0[1]),cvtpk_s(p0[2],p0[3]),cvtpk_s(p0[4],p0[5]),cvtpk_s(p0[6],p0[7])};
    pw1=(u32x4){cvtpk_s(p0[8],p0[9]),cvtpk_s(p0[10],p0[11]),cvtpk_s(p0[12],p0[13]),cvtpk_s(p0[14],p0[15])};
    pw2=(u32x4){cvtpk_s(p1[0],p1[1]),cvtpk_s(p1[2],p1[3]),cvtpk_s(p1[4],p1[5]),cvtpk_s(p1[6],p1[7])};
    pw3=(u32x4){cvtpk_s(p1[8],p1[9]),cvtpk_s(p1[10],p1[11]),cvtpk_s(p1[12],p1[13]),cvtpk_s(p1[14],p1[15])};
    const lds_cptr vp=vp0+t*16384;
    #pragma unroll
    for(int db=0;db<4;++db){
      #pragma unroll
      for(int ks=0;ks<4;++ks){ const s16x4 lo=vtr(vp+db*4096+ks*1024), hh=vtr(vp+db*4096+ks*1024+512);
        const bf16x8 vf=(bf16x8){lo[0],lo[1],lo[2],lo[3],hh[0],hh[1],hh[2],hh[3]};
        const bf16x8 pa=(ks==0)?__builtin_bit_cast(bf16x8,pw0):(ks==1)?__builtin_bit_cast(bf16x8,pw1):(ks==2)?__builtin_bit_cast(bf16x8,pw2):__builtin_bit_cast(bf16x8,pw3);
        o[db]=__builtin_amdgcn_mfma_f32_32x32x16_bf16(pa,vf,o[db],0,0,0); } }
  }
  { auto rr=__builtin_amdgcn_permlane32_swap(__float_as_uint(l),__float_as_uint(l),false,false); l=__uint_as_float(rr[0])+__uint_as_float(rr[1]); }
  if(hi==0)wsf[32+r32]=l;
  bf16*Ow=OM+(size_t)(b*SEQ+qb*QB+wid*QBLK)*PQ+h*128+r32;
  #pragma unroll
  for(int r=0;r<16;++r){ const float rl=__builtin_amdgcn_rcpf(wsf[32+crow(r,hi)]); bf16*op=Ow+(size_t)crow(r,hi)*PQ;
    #pragma unroll
    for(int db=0;db<4;++db) op[32*db]=__float2bfloat16(o[db][r]*rl); }
  __syncthreads();
}
#undef SBAR
#undef WAIT_BAR
#undef MX3
}

constexpr int NWAVES = 8;
constexpr int SEQ = 4096, NBATCH = 8, MTOK = NBATCH * SEQ, MMEM = NBATCH * 256;
constexpr int NIN_ARGS = 23;
enum InIdx { I_X = 0, I_MEM, I_GMIX, I_WIN, I_BGATE, I_BFORGET, I_QNSWA, I_KNSWA, I_SINK, I_RELBIAS, I_QNFOX, I_KNFOX, I_GMEM, I_WMEMKV, I_QNMEM, I_KNMEM, I_WOSWA, I_WOFOX, I_WOMEM, I_WOUT, I_GMLP, I_WUP, I_WDN };
constexpr size_t MiB = 1u << 20;
constexpr size_t WS_CTL = 0, CTL_ZERO_BYTES = 1 * MiB;
constexpr size_t WS_WIN = 2 * MiB, WS_WKV = 14 * MiB, WS_WO = 16 * MiB, WS_WOUT = 19 * MiB, WS_WUP = 25 * MiB, WS_WD = 33 * MiB;
constexpr size_t WS_LOGF = 41 * MiB, WS_G2 = 42 * MiB, WS_SSQ = 43 * MiB, WS_MEMN = 45 * MiB, WS_MKV = 49 * MiB;
constexpr size_t WS_GT = 64 * MiB;
constexpr size_t WS_H = 256 * MiB;
constexpr size_t WS_U = 64 * MiB;
constexpr size_t WS_QA = 320 * MiB, WS_QF = 352 * MiB, WS_QM = 384 * MiB, WS_KA = 416 * MiB, WS_VA = 424 * MiB, WS_KF = 432 * MiB, WS_VF = 464 * MiB;
constexpr size_t WS_X1B = 320 * MiB;
constexpr size_t WS_END = 496 * MiB;
constexpr int CW_BAR = 4096;
constexpr int RING_OFF = 0, RING_BYTES = 131072;
constexpr int LDSCTL_OFF = RING_BYTES, MISC_OFF = LDSCTL_OFF + 320, MEMWS_OFF = LDSCTL_OFF + 1024;
constexpr int LDS_BYTES = 147456;
static_assert(MEMWS_OFF + 2048 <= LDS_BYTES && attn_body::LDS_BYTES <= RING_BYTES, "LDS map");
static_assert(WS_QF - WS_QA == WS_QM - WS_QF, "QA | QF | QM equally spaced");
#define GAS __attribute__((address_space(1)))
#define LAS __attribute__((address_space(3)))
typedef unsigned short bf16;
typedef unsigned v4u __attribute__((ext_vector_type(4)));
typedef float f32x4 __attribute__((ext_vector_type(4)));
typedef short bf16x8 __attribute__((ext_vector_type(8)));
typedef GAS unsigned gu32;
typedef GAS unsigned long long gu64;
#define RLX_AGENT __ATOMIC_RELAXED, __HIP_MEMORY_SCOPE_AGENT
#define LDS_WAIT() asm volatile("s_waitcnt lgkmcnt(0)" ::: "memory")
#define VM_WAIT() asm volatile("s_waitcnt vmcnt(0)" ::: "memory")
__device__ __forceinline__ unsigned long long rt() { return __builtin_amdgcn_s_memrealtime(); }
__device__ __forceinline__ unsigned f2bf(float f) { unsigned u = __builtin_bit_cast(unsigned, f); return (u + 0x7fffu + ((u >> 16) & 1u)) >> 16; }
__device__ __forceinline__ unsigned pk2(float lo, float hi) { return f2bf(lo) | (f2bf(hi) << 16); }

#define XB_TMO      128
#define XB_XCNT(j)  (256  + 64 * (j))
#define XB_XSUB(j)  (1280 + 64 * (j))
#define XB_XGEN(j)  (2304 + 64 * (j))
#define XB_TOP      3328
#define XB_TOPGEN   3392
#define XCD_BAR_WORDS 3456
#define XB_SPIN_CAP (1u << 18)

__device__ __forceinline__ unsigned xb_ld(unsigned* p)              { return __hip_atomic_load(p, __ATOMIC_RELAXED, __HIP_MEMORY_SCOPE_AGENT); }
__device__ __forceinline__ unsigned xb_add(unsigned* p, unsigned v) { return __hip_atomic_fetch_add(p, v, __ATOMIC_RELAXED, __HIP_MEMORY_SCOPE_AGENT); }
__device__ __forceinline__ unsigned xb_xcc_id() { return (unsigned)__builtin_amdgcn_s_getreg((3 << 11) | 20) & 0xFu; }
#define XB_SPIN(cond, bar) do { unsigned _sp = 0; while (cond) { __builtin_amdgcn_s_sleep(1); \
    if ((++_sp & 255u) == 0u) { if (xb_ld(&(bar)[XB_TMO])) break; if (_sp > XB_SPIN_CAP) { atomicAdd(&(bar)[XB_TMO], 1u); break; } } } } while (0)

struct XcdBarrier {
    unsigned* bar; unsigned x;
    volatile LAS unsigned* st;
};

__device__ __forceinline__ XcdBarrier xcd_barrier_post(unsigned* bar, volatile LAS unsigned* st) {
    XcdBarrier b; b.bar = bar; b.x = xb_xcc_id(); b.st = st;
    if (threadIdx.x == 0) (void)xb_add(&bar[XB_XCNT(b.x)], 1u);
    return b;
}
__device__ __forceinline__ void xcd_barrier_complete(unsigned* bar, unsigned x, unsigned& nloc, unsigned& nx) {
    const unsigned G = gridDim.x * gridDim.y * gridDim.z;
    unsigned sum, cnt, mine, sp = 0u;
    for (;;) {
        sum = 0u; cnt = 0u; mine = 0u;
#pragma unroll
        for (unsigned j = 0; j < 16; ++j) { const unsigned c = xb_ld(&bar[XB_XCNT(j)]); sum += c; cnt += (c > 0u) ? 1u : 0u; mine = (j == x) ? c : mine; }
        if (sum == G) break;
        __builtin_amdgcn_s_sleep(1);
        if ((++sp & 255u) == 0u) { if (xb_ld(&bar[XB_TMO])) break; if (sp > XB_SPIN_CAP) { atomicAdd(&bar[XB_TMO], 1u); break; } }
    }
    nloc = mine > 0u ? mine : 1u; nx = cnt > 0u ? cnt : 1u;
}

__device__ __forceinline__ void xcd_barrier(const XcdBarrier& b) {
    asm volatile("s_waitcnt vmcnt(0)" ::: "memory");
    __syncthreads();
    if (threadIdx.x == 0) {
        unsigned* bar = b.bar;
        __builtin_amdgcn_s_waitcnt(0);
        unsigned nloc = b.st[0], nx = b.st[1];
        if (nloc == 0u) { xcd_barrier_complete(bar, b.x, nloc, nx); b.st[0] = nloc; b.st[1] = nx; }
        const unsigned old = xb_add(&bar[XB_XSUB(b.x)], 1u);
        const unsigned gen = old / nloc;
        if (old + 1u == (gen + 1u) * nloc) {
            __builtin_amdgcn_fence(__ATOMIC_RELEASE, "agent");
            asm volatile("s_waitcnt vmcnt(0)" ::: "memory");
            const unsigned og = xb_add(&bar[XB_TOP], 1u);
            const unsigned tg = og / nx;
            if (og + 1u == (tg + 1u) * nx) xb_add(&bar[XB_TOPGEN], 1u);
            else XB_SPIN(xb_ld(&bar[XB_TOPGEN]) == tg, bar);
            __builtin_amdgcn_fence(__ATOMIC_ACQUIRE, "agent");
            xb_add(&bar[XB_XGEN(b.x)], 1u);
            asm volatile("s_waitcnt vmcnt(0)" ::: "memory");
        } else {
            XB_SPIN(xb_ld(&bar[XB_XGEN(b.x)]) == gen, bar);
            __builtin_amdgcn_fence(__ATOMIC_ACQUIRE, "agent");
            asm volatile("s_waitcnt vmcnt(0)" ::: "memory");
        }
    }
    __syncthreads();
}

#if defined(DETPROBE) && DETPROBE
constexpr size_t WS_CHK = 57 * MiB;
__global__ void chk_sum(const unsigned* p, size_t nwords, unsigned long long* dst) {
    unsigned long long s = 0; const size_t stride = (size_t)gridDim.x * blockDim.x;
    for (size_t i = (size_t)blockIdx.x * blockDim.x + threadIdx.x; i < nwords; i += stride) s += (unsigned long long)p[i] * (unsigned long long)((i & 1023) + 1);
#pragma unroll
    for (int o = 32; o > 0; o >>= 1) s += __shfl_xor(s, o);
    if ((threadIdx.x & 63) == 0) atomicAdd(dst, s);
}
__global__ void chk_report(const unsigned long long* chk, float* out, int nslots, size_t n) {
    float mk = 0.f; for (int s = 0; s < nslots; ++s) if (chk[s] != chk[64 + s]) { mk = 1000.0f * (float)(s + 1); break; }
    const size_t stride = (size_t)gridDim.x * blockDim.x;
    for (size_t i = (size_t)blockIdx.x * blockDim.x + threadIdx.x; i < n; i += stride) out[i] = (i == 0) ? mk : 0.f;
}
#endif

struct Frame {
    LAS unsigned char* lds;
    volatile LAS unsigned* MISC;
    gu32* ctl;
    int tid, lane, wave;
    int vcu, G;
    const float *x, *mem, *w_in, *w_mem_kv, *w_o_swa, *w_o_fox, *w_o_mem, *w_out, *w_up, *w_dn, *g_mix, *g_mlp, *g_mem, *b_forget;
    float* out; unsigned char* ws;
};

__device__ __forceinline__ float wave_sum(float v) {
#pragma unroll
    for (int o = 1; o < 64; o <<= 1) v += __shfl_xor(v, o);
    return v;
}
__device__ __forceinline__ void p0_tr_item(const float* __restrict__ W, int ldw, int k0, int n0, bf16* WT, int ldt, int drow0, int ncopy, int kcstride, const float* __restrict__ kscale, LAS float* scr, int lane) {
#pragma unroll 8
    for (int i = 0; i < 32; ++i) { const int kk = 2 * i + (lane >> 5); scr[kk * 33 + (lane & 31)] = W[(size_t)(k0 + kk) * ldw + n0 + (lane & 31)]; }
    LDS_WAIT(); asm volatile("" ::: "memory");
    const int c = lane & 7;
    float ks[8];
#pragma unroll
    for (int e = 0; e < 8; ++e) ks[e] = kscale ? kscale[k0 + 8 * c + e] : 1.0f;
#pragma unroll
    for (int j = 0; j < 4; ++j) { const int n = (lane >> 3) + 8 * j; const LAS float* s = scr + (8 * c) * 33 + n;
        v4u o; o.x = pk2(s[0 * 33] * ks[0], s[1 * 33] * ks[1]); o.y = pk2(s[2 * 33] * ks[2], s[3 * 33] * ks[3]); o.z = pk2(s[4 * 33] * ks[4], s[5 * 33] * ks[5]); o.w = pk2(s[6 * 33] * ks[6], s[7 * 33] * ks[7]);
        for (int cc = 0; cc < ncopy; ++cc) *(GAS v4u*)(WT + (size_t)(drow0 + n) * ldt + cc * kcstride + k0 + 8 * c) = o; }
    LDS_WAIT(); asm volatile("" ::: "memory");
}
__device__ __forceinline__ int in_srcbase(int g) {
    return g < 8 ? 64 * g : g < 10 ? 512 + 64 * (g - 8) : g < 12 ? 640 + 64 * (g - 10) : g < 20 ? 768 + 64 * (g - 12) : g < 28 ? 1280 + 64 * (g - 20) : g < 36 ? 1792 + 64 * (g - 28) : g < 44 ? 2312 + 64 * (g - 36) : 2824 + 64 * (g - 44);
}
__device__ __forceinline__ float rms_row_to_bf16(const float* xrow, const f32x4 (&gn)[4], bf16* orow, int lane, f32x4 (&vg)[4]) {
    const GAS f32x4* xr = (const GAS f32x4*)xrow + lane;
    f32x4 v[4]; float s = 0.f;
#pragma unroll
    for (int j = 0; j < 4; ++j) { v[j] = xr[64 * j]; s += (v[j].x * v[j].x + v[j].y * v[j].y) + (v[j].z * v[j].z + v[j].w * v[j].w); }
    const float r = 1.f / sqrtf(wave_sum(s) * (1.f / 1024.f) + 1e-6f);
    GAS unsigned long long* o8 = (GAS unsigned long long*)orow + lane;
#pragma unroll
    for (int j = 0; j < 4; ++j) { vg[j] = v[j] * gn[j]; const f32x4 y = vg[j] * r; o8[64 * j] = (unsigned long long)pk2(y.x, y.y) | ((unsigned long long)pk2(y.z, y.w) << 32); }
    return r;
}
__device__ __forceinline__ void p0_prologue(Frame& F) {
    const float* x = F.x; const float* mem = F.mem; const float* w_in = F.w_in;
    bf16* Win_t = (bf16*)(F.ws + WS_WIN); bf16* Wkv_t = (bf16*)(F.ws + WS_WKV); bf16* Wo_t = (bf16*)(F.ws + WS_WO); bf16* Wout_t = (bf16*)(F.ws + WS_WOUT); bf16* Wup_t = (bf16*)(F.ws + WS_WUP); bf16* Wd_t = (bf16*)(F.ws + WS_WD);
    LAS float* scr = (LAS float*)(F.lds + RING_OFF + F.wave * 16384);
    const int gw = F.vcu * NWAVES + F.wave, NGW = F.G * NWAVES;
    constexpr int I_IN = 16 * 184, I_KV = 16 * 32, I_O1 = 8 * 32, I_OUT = 16 * 32, I_UP = 16 * 128, I_DN = 64 * 32;
    constexpr int NITEMS = I_IN + I_KV + 3 * I_O1 + I_OUT + I_UP + I_DN;
    for (int it = gw; it < NITEMS; it += NGW) {
        int r = it;
        if (r < I_IN) { const int kb = r / 184, gg = r % 184, g = gg >> 1, bj = gg & 1;
            p0_tr_item(w_in, 5896, 64 * kb, in_srcbase(g) + 32 * bj, Win_t, 1024, 256 * (g >> 2) + 128 * bj + 32 * (g & 3), 1, 0, nullptr, scr, F.lane); continue; } r -= I_IN;
        if (r < I_KV) { p0_tr_item(F.w_mem_kv, 1024, 64 * (r / 32), 32 * (r % 32), Wkv_t, 1024, 32 * (r % 32), 1, 0, nullptr, scr, F.lane); continue; } r -= I_KV;
        if (r < I_O1) { p0_tr_item(F.w_o_swa, 1024, 64 * (r / 32), 32 * (r % 32), Wo_t, 512, 32 * (r % 32), 1, 0, nullptr, scr, F.lane); continue; } r -= I_O1;
        if (r < I_O1) { p0_tr_item(F.w_o_fox, 1024, 64 * (r / 32), 32 * (r % 32), Wo_t, 512, 1024 + 32 * (r % 32), 1, 0, nullptr, scr, F.lane); continue; } r -= I_O1;
        if (r < I_O1) { p0_tr_item(F.w_o_mem, 1024, 64 * (r / 32), 32 * (r % 32), Wo_t, 512, 2048 + 32 * (r % 32), 1, 0, nullptr, scr, F.lane); continue; } r -= I_O1;
        if (r < I_OUT) { p0_tr_item(F.w_out, 1024, 64 * (r / 32), 32 * (r % 32), Wout_t, 3072, 32 * (r % 32), 3, 1024, nullptr, scr, F.lane); continue; } r -= I_OUT;
        if (r < I_UP) { p0_tr_item(F.w_up, 4096, 64 * (r / 128), 32 * (r % 128), Wup_t, 1024, 32 * (r % 128), 1, 0, F.g_mlp, scr, F.lane); continue; } r -= I_UP;
        p0_tr_item(F.w_dn, 1024, 64 * (r / 32), 32 * (r % 32), Wd_t, 4096, 32 * (r % 32), 1, 0, nullptr, scr, F.lane);
    }
    {
        bf16* H = (bf16*)(F.ws + WS_H); float* LOGF = (float*)(F.ws + WS_LOGF);
        f32x4 gn[4];
#pragma unroll
        for (int j = 0; j < 4; ++j) gn[j] = ((const GAS f32x4*)F.g_mix)[F.lane + 64 * j];
        f32x4 wf[4][4][2];
#pragma unroll
        for (int j = 0; j < 4; ++j)
#pragma unroll
            for (int e = 0; e < 4; ++e) { const GAS f32x4* wp = (const GAS f32x4*)(w_in + (size_t)(4 * F.lane + 256 * j + e) * 5896 + 2304); wf[j][e][0] = wp[0]; wf[j][e][1] = wp[1]; }
        const f32x4 bf0 = ((const GAS f32x4*)F.b_forget)[0], bf1 = ((const GAS f32x4*)F.b_forget)[1];
        for (int m = gw; m < MTOK; m += NGW) {
            f32x4 vg[4]; const float r = rms_row_to_bf16(x + (size_t)m * 1024, gn, H + (size_t)m * 1024, F.lane, vg);
            f32x4 p0 = (f32x4){0.f, 0.f, 0.f, 0.f}, p1 = p0;
#pragma unroll
            for (int j = 0; j < 4; ++j)
#pragma unroll
                for (int e = 0; e < 4; ++e) { p0 += wf[j][e][0] * vg[j][e]; p1 += wf[j][e][1] * vg[j][e]; }
#pragma unroll
            for (int cidx = 0; cidx < 4; ++cidx) { p0[cidx] = wave_sum(p0[cidx]); p1[cidx] = wave_sum(p1[cidx]); }
            f32x4 z0 = p0 * r + bf0, z1 = p1 * r + bf1;
#pragma unroll
            for (int cidx = 0; cidx < 4; ++cidx) { z0[cidx] = fminf(z0[cidx], 0.f) - log1pf(expf(-fabsf(z0[cidx]))); z1[cidx] = fminf(z1[cidx], 0.f) - log1pf(expf(-fabsf(z1[cidx]))); }
            if (F.lane == 0) { GAS f32x4* lp = (GAS f32x4*)(LOGF + (size_t)m * 8); lp[0] = z0; lp[1] = z1; }
        }
    }
    {
        bf16* MEMN = (bf16*)(F.ws + WS_MEMN);
        f32x4 gn[4];
#pragma unroll
        for (int j = 0; j < 4; ++j) gn[j] = ((const GAS f32x4*)F.g_mem)[F.lane + 64 * j];
        for (int m = gw; m < MMEM; m += NGW) { f32x4 vg[4]; (void)rms_row_to_bf16(mem + (size_t)m * 1024, gn, MEMN + (size_t)m * 1024, F.lane, vg); }
    }
}
__device__ __forceinline__ void p1_scan(Frame& F) {
    if (F.vcu >= 64) return;
    const float* LOGF = (const float*)(F.ws + WS_LOGF); float* G2 = (float*)(F.ws + WS_G2);
    const int b = F.vcu >> 3, h = F.vcu & 7, s0 = 8 * F.tid;
    float a[8]; float run = 0.f;
#pragma unroll
    for (int i = 0; i < 8; ++i) { run += LOGF[((size_t)(b * SEQ + s0 + i)) * 8 + h]; a[i] = run; }
    float sc = run;
#pragma unroll
    for (int o = 1; o < 64; o <<= 1) { const float y = __shfl_up(sc, o); if (F.lane >= o) sc += y; }
    volatile LAS float* wt = (volatile LAS float*)(F.MISC + 16);
    if (F.lane == 63) wt[F.wave] = sc;
    __syncthreads();
    float woff = 0.f;
#pragma unroll
    for (int w = 0; w < NWAVES; ++w) woff += (w < F.wave) ? wt[w] : 0.f;
    const float off = woff + (sc - run);
    f32x4 o0, o1;
#pragma unroll
    for (int i = 0; i < 4; ++i) { o0[i] = -(a[i] + off) * 1.4426950408889634f; o1[i] = -(a[4 + i] + off) * 1.4426950408889634f; }
    GAS f32x4* gp = (GAS f32x4*)(G2 + (size_t)F.vcu * SEQ + s0); gp[0] = o0; gp[1] = o1;
    __syncthreads();
}

struct Args { const float* in[NIN_ARGS]; float* out; unsigned char* ws; int ph_lo, ph_hi; };
__global__ void __launch_bounds__(NWAVES * 64, 2) mega_fwd(Args args) {
    extern __shared__ __attribute__((aligned(16))) unsigned char lds[];
    Frame F;
    F.lds = (LAS unsigned char*)lds;
    F.MISC = (volatile LAS unsigned*)(F.lds + MISC_OFF);
    F.tid = threadIdx.x; F.lane = F.tid & 63; F.wave = __builtin_amdgcn_readfirstlane(F.tid >> 6);
    F.G = gridDim.x; { const int bx = blockIdx.x; F.vcu = (F.G % 8 == 0) ? (bx % 8) * (F.G / 8) + bx / 8 : bx; }
    unsigned char* ws = args.ws; F.ws = ws; F.out = args.out;
    F.x = args.in[I_X]; F.mem = args.in[I_MEM]; F.w_in = args.in[I_WIN]; F.w_mem_kv = args.in[I_WMEMKV]; F.w_o_swa = args.in[I_WOSWA]; F.w_o_fox = args.in[I_WOFOX]; F.w_o_mem = args.in[I_WOMEM];
    F.w_out = args.in[I_WOUT]; F.w_up = args.in[I_WUP]; F.w_dn = args.in[I_WDN]; F.g_mix = args.in[I_GMIX]; F.g_mlp = args.in[I_GMLP]; F.g_mem = args.in[I_GMEM]; F.b_forget = args.in[I_BFORGET];
    F.ctl = (gu32*)(ws + WS_CTL);
    for (int u = F.tid; u < (LDS_BYTES - LDSCTL_OFF) / 4; u += NWAVES * 64) ((LAS unsigned*)(F.lds + LDSCTL_OFF))[u] = 0u;
    __syncthreads();
    const int lo = args.ph_lo, hi = args.ph_hi;
    const bool use_bar = (hi - lo) > 1;
    XcdBarrier bar; bar.bar = (unsigned*)(F.ctl + CW_BAR); bar.x = 0; bar.st = nullptr;
    if (use_bar) bar = xcd_barrier_post((unsigned*)(F.ctl + CW_BAR), F.MISC + 8);
#define IN(k) (lo <= (k) && (k) < hi)
#define BOTH(k) (IN(k) && IN((k) + 1))
#define GRID_BAR() xcd_barrier(bar)

    bf16* Win_t = (bf16*)(ws + WS_WIN); bf16* Wkv_t = (bf16*)(ws + WS_WKV); bf16* Wo_t = (bf16*)(ws + WS_WO); bf16* Wout_t = (bf16*)(ws + WS_WOUT); bf16* Wup_t = (bf16*)(ws + WS_WUP); bf16* Wd_t = (bf16*)(ws + WS_WD);
    bf16* H = (bf16*)(ws + WS_H); bf16* GT = (bf16*)(ws + WS_GT); bf16* U = (bf16*)(ws + WS_U); bf16* X1B = (bf16*)(ws + WS_X1B); bf16* MEMN = (bf16*)(ws + WS_MEMN);
    bf16* QA = (bf16*)(ws + WS_QA); bf16* KA = (bf16*)(ws + WS_KA); bf16* VA = (bf16*)(ws + WS_VA); bf16* QF = (bf16*)(ws + WS_QF); bf16* KF = (bf16*)(ws + WS_KF); bf16* VF = (bf16*)(ws + WS_VF); bf16* QM = (bf16*)(ws + WS_QM);
    float* MKV = (float*)(ws + WS_MKV); float* SSQ = (float*)(ws + WS_SSQ); float* G2 = (float*)(ws + WS_G2);

    if (IN(0)) { p0_prologue(F); if (BOTH(0)) GRID_BAR(); }

    if (IN(1)) {
        p1_scan(F);
        pg8::Sched S; S.init(MTOK, 5888, 1024, F.G, (int)blockIdx.x, H, Win_t); S.nx = 32; S.Ax = (const char*)MEMN; S.Bx = (const char*)Wkv_t;
        pg8::EpiInProj E{QA, KA, VA, QF, KF, VF, QM, GT, MKV, args.in[I_QNSWA], args.in[I_KNSWA], args.in[I_QNFOX], args.in[I_KNFOX], args.in[I_BGATE]};
        pg8::gemm_phase<pg8::EpiInProj, pg8::Sched, true, true>(F.lds + RING_OFF, 1024, S, E);
        if (BOTH(1)) GRID_BAR();
    }

    if (IN(2)) {
        using ab = attn_body::bf16;
        char* shm = (char*)lds + RING_OFF;
        for (int i = 0;; ++i) { const int id = (F.G == 256) ? F.vcu * 4 + i : i * F.G + F.vcu; if (id >= 1024 || (F.G == 256 && i >= 4)) break;
            const int bh = id >> 4, slot = id & 15, k4 = slot >> 2, j4 = slot & 3; const int qb = (j4 == 0) ? 15 - k4 : (j4 == 1) ? 8 + k4 : (j4 == 2) ? 7 - k4 : k4;
            const int b = bh >> 3, h = bh & 7; const size_t rb = (size_t)b * SEQ;
            attn_body::attn_unit<0, 512, 8>((const ab*)QF + (rb + qb * 256) * 512 + h * 64, (const ab*)KF + rb * 512 + h * 64, (const ab*)VF + rb * 512 + h * 64, (ab*)QF + (rb + qb * 256) * 512 + h * 64,
                                              4 * qb + 4, qb * 256, 0, 0.f, G2 + (size_t)bh * SEQ, nullptr, shm); }
        for (int i = 0;; ++i) { const int id = (F.G == 256) ? F.vcu * 4 + i : i * F.G + F.vcu; if (id >= 1024 || (F.G == 256 && i >= 4)) break;
            const int b = id >> 7, hq = (id >> 4) & 7, qb = id & 15, kvh = hq >> 2; const size_t rb = (size_t)b * SEQ;
            const int T0 = (qb == 0) ? 0 : 4 * qb - 2, NT = 4 * qb + 4 - T0;
            const float l0 = __builtin_amdgcn_exp2f(args.in[I_SINK][hq] * 1.4426950408889634f);
            attn_body::attn_unit<1, 128, 8>((const ab*)QA + (rb + qb * 256) * 512 + hq * 64, (const ab*)KA + (rb + 64 * T0) * 128 + kvh * 64, (const ab*)VA + (rb + 64 * T0) * 128 + kvh * 64, (ab*)QA + (rb + qb * 256) * 512 + hq * 64,
                                              NT, qb * 256, qb * 256 - 64 * T0, l0, nullptr, args.in[I_RELBIAS] + hq, shm); }
        for (int i = 0;; ++i) { const int id = (F.G == 256) ? F.vcu * 2 + i : i * F.G + F.vcu; if (id >= 512 || (F.G == 256 && i >= 2)) break;
            attn_body::mem_unit(id >> 6, (id >> 4) & 3, id & 15, MKV, (const ab*)QM, (ab*)QM, args.in[I_KNMEM], args.in[I_QNMEM], shm, (char*)lds + MEMWS_OFF); }
        if (BOTH(2)) GRID_BAR();
    }

    if (IN(3)) {
        pg8::Sched S; S.init(MTOK, 3072, 512, F.G, (int)blockIdx.x, QA, Wo_t); S.asel = 1; S.astride = WS_QF - WS_QA;
        pg8::EpiGateMul E{GT};
        pg8::gemm_phase<pg8::EpiGateMul, pg8::Sched, true, true>(F.lds + RING_OFF, 512, S, E);
        if (BOTH(3)) GRID_BAR();
    }

    if (IN(4)) {
        pg8::Sched S; S.init(MTOK, 1024, 3072, F.G, (int)blockIdx.x, GT, Wout_t);
        pg8::EpiOutProj E{F.x, F.out, X1B, SSQ};
        pg8::gemm_phase<pg8::EpiOutProj, pg8::Sched, true, true>(F.lds + RING_OFF, 3072, S, E);
        if (BOTH(4)) GRID_BAR();
    }

    if (IN(5)) {
        pg8::Sched S; S.init(MTOK, 4096, 1024, F.G, (int)blockIdx.x, X1B, Wup_t);
        pg8::EpiUp E{SSQ, U};
        pg8::gemm_phase<pg8::EpiUp, pg8::Sched, true, true>(F.lds + RING_OFF, 1024, S, E);
        if (BOTH(5)) GRID_BAR();
    }

    if (IN(6)) {
        pg8::Sched S; S.init(MTOK, 1024, 4096, F.G, (int)blockIdx.x, U, Wd_t);
        pg8::EpiDown E{F.out};
        pg8::gemm_phase<pg8::EpiDown, pg8::Sched, true, true>(F.lds + RING_OFF, 4096, S, E);
    }
#undef IN
#undef BOTH
#undef GRID_BAR
}

extern "C" void kernel_launch(void* const* d_in, const int* in_sizes, int n_in, void* d_out, int out_size, void* d_ws, size_t ws_size, hipStream_t stream) {
    static int grid = 0;
    if (grid == 0) {
        if (n_in != NIN_ARGS || in_sizes[0] != MTOK * 1024 || out_size != MTOK * 1024 || ws_size < WS_END) { fprintf(stderr, "kernel_launch: unexpected shapes (n_in %d, in0 %d, out %d, ws %zu < %zu); nothing launched\n", n_in, n_in > 0 ? in_sizes[0] : -1, out_size, ws_size, (size_t)WS_END); grid = -1; return; }
        int dev = 0, cus = 0, per_cu = 0;
        if (hipGetDevice(&dev) != hipSuccess || hipDeviceGetAttribute(&cus, hipDeviceAttributeMultiprocessorCount, dev) != hipSuccess) { fprintf(stderr, "kernel_launch: hipGetDevice / hipDeviceGetAttribute failed\n"); grid = -1; return; }
        if (hipFuncSetAttribute((const void*)mega_fwd, hipFuncAttributeMaxDynamicSharedMemorySize, LDS_BYTES) != hipSuccess) { fprintf(stderr, "kernel_launch: hipFuncSetAttribute failed\n"); grid = -1; return; }
        if (hipOccupancyMaxActiveBlocksPerMultiprocessor(&per_cu, (const void*)mega_fwd, NWAVES * 64, LDS_BYTES) != hipSuccess || per_cu < 1) { fprintf(stderr, "kernel_launch: occupancy query says %d workgroups per CU\n", per_cu); per_cu = 1; }
        (void)hipGetLastError();
        if (per_cu > 1) per_cu = 1;
        grid = cus * per_cu;
    }
    if (grid < 0) return;
    if (hipMemsetAsync((char*)d_ws + WS_CTL, 0, CTL_ZERO_BYTES, stream) != hipSuccess) { fprintf(stderr, "kernel_launch: hipMemsetAsync failed\n"); return; }
    Args a{};
    for (int i = 0; i < NIN_ARGS; ++i) a.in[i] = (const float*)d_in[i];
    a.out = (float*)d_out; a.ws = (unsigned char*)d_ws;
#if defined(DETPROBE) && DETPROBE
    {   unsigned char* w = (unsigned char*)d_ws; unsigned long long* chk = (unsigned long long*)(w + WS_CHK);
        (void)hipMemsetAsync(chk, 0, 2 * 64 * 8, stream);
        struct Slot { int phase; size_t off; size_t bytes; bool in_out; };
        const Slot slots[] = { {0, WS_WIN, 39 * MiB, false}, {0, WS_LOGF, 1 * MiB, false}, {0, WS_MEMN, 4 * MiB, false}, {0, WS_H, 64 * MiB, false},
            {1, WS_G2, 1 * MiB, false}, {1, WS_MKV, 8 * MiB, false}, {1, WS_GT, 192 * MiB, false}, {1, WS_QA, 32 * MiB, false}, {1, WS_KA, 8 * MiB, false}, {1, WS_VA, 8 * MiB, false},
            {1, WS_QF, 32 * MiB, false}, {1, WS_KF, 32 * MiB, false}, {1, WS_VF, 32 * MiB, false}, {1, WS_QM, 32 * MiB, false},
            {2, WS_QF, 32 * MiB, false}, {2, WS_QA, 32 * MiB, false}, {2, WS_QM, 32 * MiB, false},
            {3, WS_GT, 192 * MiB, false}, {4, 0, 128 * MiB, true}, {4, WS_X1B, 64 * MiB, false}, {4, WS_SSQ, 2 * MiB, false}, {5, WS_U, 256 * MiB, false}, {6, 0, 128 * MiB, true} };
        const int nslots = (int)(sizeof(slots) / sizeof(slots[0]));
        for (int run = 0; run < 2; ++run)
            for (int p = 0; p < 7; ++p) { a.ph_lo = p; a.ph_hi = p + 1; if (p == 1) (void)hipMemsetAsync(w + WS_GT, 0, 192 * MiB, stream); if (p == 1) (void)hipMemsetAsync(w + WS_QA, 0, 176 * MiB, stream);
                hipLaunchKernelGGL(mega_fwd, dim3(grid), dim3(NWAVES * 64), LDS_BYTES, stream, a);
                for (int s = 0; s < nslots; ++s) if (slots[s].phase == p) { const unsigned* src = slots[s].in_out ? (const unsigned*)d_out : (const unsigned*)(w + slots[s].off);
                    hipLaunchKernelGGL(chk_sum, dim3(2048), dim3(256), 0, stream, src, slots[s].bytes / 4, chk + run * 64 + s); } }
        hipLaunchKernelGGL(chk_report, dim3(2048), dim3(256), 0, stream, (const unsigned long long*)chk, (float*)d_out, nslots, (size_t)out_size);
    }
#elif N_LAUNCHES == 1
    a.ph_lo = 0; a.ph_hi = 7;
    hipLaunchKernelGGL(mega_fwd, dim3(grid), dim3(NWAVES * 64), LDS_BYTES, stream, a);
#else
    for (int p = 0; p < 7; ++p) { a.ph_lo = p; a.ph_hi = p + 1; hipLaunchKernelGGL(mega_fwd, dim3(grid), dim3(NWAVES * 64), LDS_BYTES, stream, a); }
#endif
    const hipError_t le = hipPeekAtLastError();
    if (le != hipSuccess) fprintf(stderr, "kernel_launch: launch failed: %s\n", hipGetErrorName(le));
}
```

```cpp
#include <hip/hip_runtime.h>
#include <hip/hip_bf16.h>
#include <cstdio>
#include <cstdint>
#include <cmath>
#ifndef N_LAUNCHES
#define N_LAUNCHES 1
#endif
#if defined(TSPROBE) && !defined(TS_A)
#define TS_A TSPROBE
#define TS_B (TSPROBE + 1)
#endif
namespace pg8 {
#define PG8_LAS __attribute__((address_space(3)))
typedef unsigned short bf16_t;
typedef short bf16x8 __attribute__((ext_vector_type(8)));
typedef float f32x4 __attribute__((ext_vector_type(4)));
typedef unsigned u32x4 __attribute__((ext_vector_type(4)));
constexpr int BM = 256, BK = 64, HALF = 128, HTB = HALF * BK * 2  , STAGE_BYTES = 8 * HTB, NXCD = 8, WGM = 8;

__host__ __device__ __forceinline__ int lds_byte(int r, int c) { const int st = (r >> 4) * 2 + (c >> 5), rr = r & 15, cc = c & 31, ob = rr * 64 + cc * 2; return st * 1024 + (ob ^ (((ob >> 9) & 1) << 5)); }
__host__ __device__ __forceinline__ void stage_rc(int b, int& R, int& C) { const int st = b / 1024, sb = b % 1024, swz = sb ^ (((sb >> 9) & 1) << 5); R = (st >> 1) * 16 + swz / 64; C = (st & 1) * 32 + (swz % 64) / 2; }
__host__ __device__ __forceinline__ int perm32(int rho) { const int n = rho >> 4, i = rho & 15; return 8 * (i >> 2) + 4 * n + (i & 3); }

#if defined(NO_EPI_RETIRE)
#define EPI_RETIRE do {} while (0)
#else
#define EPI_RETIRE asm volatile("s_waitcnt vmcnt(0)" ::: "memory")
#endif
struct Unit { int pm, pn; };
typedef float f32x2_t __attribute__((ext_vector_type(2))); typedef __bf16 bf16x2_t __attribute__((ext_vector_type(2)));
__device__ __forceinline__ unsigned cvt_pk_bf16(float lo, float hi) { f32x2_t v = {lo, hi}; bf16x2_t b = __builtin_convertvector(v, bf16x2_t); return __builtin_bit_cast(unsigned, b); }
typedef unsigned u32x2 __attribute__((ext_vector_type(2)));

struct Sched {
    int nM, nN, nwg, G, c, nx, asel;
    const char *A0, *Bt, *Ax, *Bx; size_t tstep, astride; void* tsbase;
    __device__ __forceinline__ void init(int M, int N, int K, int G_, int c_, const void* a0, const void* bt) {
        nM = M / BM; nN = N / BM; nwg = nM * nN; G = G_; c = c_; nx = 0; asel = 0; astride = 0; tsbase = nullptr; A0 = (const char*)a0; Bt = (const char*)bt; Ax = Bx = (const char*)a0; tstep = (size_t)BM * K * 2; }
    __device__ __forceinline__ bool next(int i, Unit& u) const {
        const long L = (long)i * G + c;
        if (L >= nwg) { const long e = L - nwg; if (e >= nx) return false; u.pm = nM + (int)(e >> 2); u.pn = (int)(e & 3); return true; }
        int wgid = (int)L; { const int q = nwg / NXCD, r = nwg % NXCD, xcd = wgid % NXCD, off = wgid / NXCD; wgid = (xcd < r ? xcd * (q + 1) : r * (q + 1) + (xcd - r) * q) + off; }
        const int nig = WGM * nN, gid = wgid / nig, fm = gid * WGM, gsz = (nM - fm) < WGM ? (nM - fm) : WGM;
        u.pm = fm + ((wgid % nig) % gsz); u.pn = (wgid % nig) / gsz; return true;
    }
    __device__ __forceinline__ const char* a_ptr(const Unit& u) const {
        if (u.pm >= nM) return Ax + (size_t)(u.pm - nM) * tstep;
        return A0 + (size_t)(asel ? (u.pn >> 2) : 0) * astride + (size_t)u.pm * tstep; }
    __device__ __forceinline__ const char* b_ptr(const Unit& u) const { return ((u.pm >= nM) ? Bx : Bt) + (size_t)u.pn * tstep; }
    __device__ __forceinline__ void a_ready(const Unit&) const {}
    __device__ __forceinline__ void done(const Unit&) const {}
};

__device__ __forceinline__ float dot4(const f32x4 a) { return (a[0] * a[0] + a[1] * a[1]) + (a[2] * a[2] + a[3] * a[3]); }
__device__ __forceinline__ u32x4 pack8(const f32x4 a, const f32x4 b) { u32x4 w; w.x = cvt_pk_bf16(a[0], a[1]); w.y = cvt_pk_bf16(a[2], a[3]); w.z = cvt_pk_bf16(b[0], b[1]); w.w = cvt_pk_bf16(b[2], b[3]); return w; }

__device__ __forceinline__ int quad_src_idx(int lane) { return ((((lane & 3) << 4) | (lane >> 2)) << 2); }
__device__ __forceinline__ u32x4 quad_gather(const u32x4 w, int pidx) { u32x4 o; o.x = (unsigned)__builtin_amdgcn_ds_bpermute(pidx, (int)w.x); o.y = (unsigned)__builtin_amdgcn_ds_bpermute(pidx, (int)w.y);
    o.z = (unsigned)__builtin_amdgcn_ds_bpermute(pidx, (int)w.z); o.w = (unsigned)__builtin_amdgcn_ds_bpermute(pidx, (int)w.w); return o; }
constexpr float kLog2e = 1.4426950408889634f;
constexpr float kEps = 1e-6f;
constexpr float kC2_64 = 0.125f * 1.4426950408889634f;

struct EpiInProj {
    static constexpr bool PERM = true, AFTER_DRAIN = false, HAS_MID = false;
    bf16_t *QA, *KA, *VA, *QF, *KF, *VF, *QM; unsigned char* GT8;
    PG8_LAS const float* tab;
    __device__ __forceinline__ void operator()(const f32x4 (&acc)[2][2][4][2], const Unit& u, int wr, int wc, int fr, int fq) const {
        const int g = u.pn * 4 + wc;
        bf16_t* dst; int pitch, dcol, mode;
        if (g < 8)       { dst = QA; pitch = 1536; dcol = 64 * g;        mode = 1; }
        else if (g < 10) { dst = KA; pitch = 128;  dcol = 64 * (g - 8);  mode = 1; }
        else if (g < 12) { dst = VA; pitch = 128;  dcol = 64 * (g - 10); mode = 0; }
        else if (g < 20) { dst = QF; pitch = 1536; dcol = 64 * (g - 12); mode = 1; }
        else if (g < 28) { dst = KF; pitch = 512;  dcol = 64 * (g - 20); mode = 1; }
        else if (g < 36) { dst = VF; pitch = 512;  dcol = 64 * (g - 28); mode = 0; }
        else if (g < 44) { dst = QM; pitch = 1536; dcol = 64 * (g - 36); mode = 0; }
        else             { dst = nullptr; pitch = 0; dcol = 64 * (g - 44); mode = 2; }
        const int row0 = u.pm * BM + wr * 64 + fr;
        bf16_t* base = dst + dcol + 8 * fq;
        f32x4 cv[2][2];
#pragma unroll
        for (int bj = 0; bj < 2; ++bj)
#pragma unroll
            for (int n = 0; n < 2; ++n) cv[bj][n] = *(PG8_LAS const f32x4*)(tab + g * 64 + ((g >= 44) ? 16 * fq + 8 * bj : 32 * bj + 8 * fq) + 4 * n);
        if (mode == 1) {
#pragma unroll
            for (int ai = 0; ai < 2; ++ai)
#pragma unroll
                for (int m = 0; m < 4; ++m) { bf16_t* rowp = base + (size_t)(row0 + ai * HALF + m * 16) * pitch;
                    float ss = (dot4(acc[ai][0][m][0]) + dot4(acc[ai][0][m][1])) + (dot4(acc[ai][1][m][0]) + dot4(acc[ai][1][m][1]));
                    ss += __shfl_xor(ss, 16); ss += __shfl_xor(ss, 32);
                    const float r = 1.0f / sqrtf(ss * (1.0f / 64.0f) + kEps);
                    if (ai == 0 && m == 0) EPI_RETIRE;
#pragma unroll
                    for (int bj = 0; bj < 2; ++bj) *(u32x4*)(rowp + 32 * bj) = pack8(acc[ai][bj][m][0] * r * cv[bj][0], acc[ai][bj][m][1] * r * cv[bj][1]); }
        } else if (mode == 2) {
            unsigned char* gbase = (unsigned char*)GT8 + dcol + 16 * fq;
#pragma unroll
            for (int ai = 0; ai < 2; ++ai)
#pragma unroll
                for (int m = 0; m < 4; ++m) { u32x4 w;
#pragma unroll
                    for (int bj = 0; bj < 2; ++bj)
#pragma unroll
                        for (int n = 0; n < 2; ++n) { const f32x4 z = (acc[ai][bj][m][n] + cv[bj][n]) * (-kLog2e); unsigned q = 0;
#pragma unroll
                            for (int j = 0; j < 4; ++j) { const float g = __builtin_amdgcn_rcpf(1.0f + __builtin_amdgcn_exp2f(z[j])); unsigned b8 = (unsigned)(g * 255.0f + 0.5f); b8 = b8 < 1u ? 1u : b8; q |= b8 << (8 * j); }
                            w[2 * bj + n] = q; }
                    if (ai == 0 && m == 0) EPI_RETIRE;
                    *(u32x4*)(gbase + (size_t)(row0 + ai * HALF + m * 16) * 3072) = w; asm volatile("" ::: "memory"); }
        } else {
            EPI_RETIRE;
#pragma unroll
            for (int ai = 0; ai < 2; ++ai)
#pragma unroll
                for (int m = 0; m < 4; ++m) { bf16_t* rowp = base + (size_t)(row0 + ai * HALF + m * 16) * pitch;
#pragma unroll
                    for (int bj = 0; bj < 2; ++bj) *(u32x4*)(rowp + 32 * bj) = pack8(acc[ai][bj][m][0], acc[ai][bj][m][1]); }
        }
    }
};

struct EpiMemKV {
    static constexpr bool PERM = true, AFTER_DRAIN = false, HAS_MID = false;
    unsigned char* MIMG; PG8_LAS const float* tab; PG8_LAS float* ex;
    __device__ __forceinline__ void operator()(const f32x4 (&acc)[2][2][4][2], const Unit& u, int wr, int wc, int fr, int fq) const {
            const int b = u.pm, hp = (u.pn & 1) * 2, key0 = wr * 64 + fr;
            unsigned char* im0 = MIMG + (size_t)(b * 4 + hp) * 131072;
            if (u.pn < 2) {
                PG8_LAS const f32x4* gp = (PG8_LAS const f32x4*)(tab + 28 * 64 + 32 * wc + 8 * fq);
#pragma unroll
                for (int bj = 0; bj < 2; ++bj) {
#pragma unroll
                    for (int ai = 0; ai < 2; ++ai)
#pragma unroll
                        for (int m = 0; m < 4; ++m) { float ss = dot4(acc[ai][bj][m][0]) + dot4(acc[ai][bj][m][1]); ss += __shfl_xor(ss, 16); ss += __shfl_xor(ss, 32);
                            if (fq == 0) ex[(ai * HALF + key0 + m * 16) * 4 + wc] = ss; }
                    asm volatile("s_waitcnt lgkmcnt(0)" ::: "memory"); __builtin_amdgcn_s_barrier(); asm volatile("" ::: "memory");
                    if (bj == 0) EPI_RETIRE;
                    unsigned char* im = im0 + (size_t)bj * 131072 + (4 * wc + fq) * 4096;
#pragma unroll
                    for (int ai = 0; ai < 2; ++ai)
#pragma unroll
                        for (int m = 0; m < 4; ++m) { const int key = ai * HALF + key0 + m * 16; const f32x4 e4 = *(PG8_LAS const f32x4*)(ex + key * 4);
                            const float r = 1.0f / sqrtf(((e4[0] + e4[1]) + (e4[2] + e4[3])) * (1.0f / 128.0f) + kEps);
                            *(u32x4*)(im + key * 16) = pack8(acc[ai][bj][m][0] * r * gp[0], acc[ai][bj][m][1] * r * gp[1]); }
                    asm volatile("s_waitcnt lgkmcnt(0)" ::: "memory"); __builtin_amdgcn_s_barrier(); asm volatile("" ::: "memory");
                }
            } else {
                EPI_RETIRE;
#pragma unroll
                for (int bj = 0; bj < 2; ++bj) { unsigned char* im = im0 + (size_t)bj * 131072 + 65536 + wc * 4096 + fq * 16;
#pragma unroll
                    for (int ai = 0; ai < 2; ++ai)
#pragma unroll
                        for (int m = 0; m < 4; ++m) { const int key = ai * HALF + key0 + m * 16; *(u32x4*)(im + (key >> 6) * 16384 + (key & 63) * 64) = pack8(acc[ai][bj][m][0], acc[ai][bj][m][1]); } }
            }
    }
};

__device__ __forceinline__ void unpack8(const u32x4 w, f32x4& a, f32x4& b) {
    a[0] = __uint_as_float(w.x << 16); a[1] = __uint_as_float(w.x & 0xffff0000u); a[2] = __uint_as_float(w.y << 16); a[3] = __uint_as_float(w.y & 0xffff0000u);
    b[0] = __uint_as_float(w.z << 16); b[1] = __uint_as_float(w.z & 0xffff0000u); b[2] = __uint_as_float(w.w << 16); b[3] = __uint_as_float(w.w & 0xffff0000u); }
__device__ __forceinline__ f32x4 ub4(unsigned w) { return (f32x4){(float)(w & 0xffu), (float)((w >> 8) & 0xffu), (float)((w >> 16) & 0xffu), (float)(w >> 24)}; }
struct EpiMerge {
    static constexpr bool PERM = true, AFTER_DRAIN = false, HAS_MID = true;
    const unsigned char* GT8; bf16_t* MRG; void* tsbase;
    static __device__ __forceinline__ void scale16(f32x4& a00, f32x4& a01, f32x4& a10, f32x4& a11, const u32x4 nw, const u32x4 dw) {
        const f32x4 n0 = ub4(nw.x), n1 = ub4(nw.y), n2 = ub4(nw.z), n3 = ub4(nw.w), d0 = ub4(dw.x), d1 = ub4(dw.y), d2 = ub4(dw.z), d3 = ub4(dw.w);
#pragma unroll
        for (int j = 0; j < 4; ++j) { a00[j] *= n0[j] * __builtin_amdgcn_rcpf(d0[j]); a01[j] *= n1[j] * __builtin_amdgcn_rcpf(d1[j]); a10[j] *= n2[j] * __builtin_amdgcn_rcpf(d2[j]); a11[j] *= n3[j] * __builtin_amdgcn_rcpf(d3[j]); } }
    __device__ __forceinline__ void mid(f32x4 (&acc)[2][2][4][2], const Unit& u, int t, int wr, int wc, int fr, int fq) const {
        const unsigned char* base = GT8 + (size_t)(u.pm * BM + wr * 64 + fr) * 3072 + u.pn * BM + wc * 64 + 16 * fq + ((t == 8) ? 0 : 1024);
        u32x4 nA, dA, nB, dB, nC, dC;
#define MID_LOAD(N, D, g) do { const unsigned char* rp_ = base + (size_t)(((g) >> 2) * HALF + ((g) & 3) * 16) * 3072; N = *(const u32x4*)(rp_); D = *(const u32x4*)(rp_ + 1024); } while (0)
#define MID_APPLY(N, D, g) do { scale16(acc[(g) >> 2][0][(g) & 3][0], acc[(g) >> 2][0][(g) & 3][1], acc[(g) >> 2][1][(g) & 3][0], acc[(g) >> 2][1][(g) & 3][1], N, D); \
        asm volatile("" : "+v"(acc[(g) >> 2][0][(g) & 3][0]), "+v"(acc[(g) >> 2][0][(g) & 3][1]), "+v"(acc[(g) >> 2][1][(g) & 3][0]), "+v"(acc[(g) >> 2][1][(g) & 3][1]) :: "memory"); } while (0)
        MID_LOAD(nA, dA, 0); MID_LOAD(nB, dB, 1);
        MID_LOAD(nC, dC, 2); MID_APPLY(nA, dA, 0);
        MID_LOAD(nA, dA, 3); MID_APPLY(nB, dB, 1);
        MID_LOAD(nB, dB, 4); MID_APPLY(nC, dC, 2);
        MID_LOAD(nC, dC, 5); MID_APPLY(nA, dA, 3);
        MID_LOAD(nA, dA, 6); MID_APPLY(nB, dB, 4);
        MID_LOAD(nB, dB, 7); MID_APPLY(nC, dC, 5);
        MID_APPLY(nA, dA, 6);
        MID_APPLY(nB, dB, 7);
#undef MID_LOAD
#undef MID_APPLY
    }
    __device__ __forceinline__ void operator()(const f32x4 (&acc)[2][2][4][2], const Unit& u, int wr, int wc, int fr, int fq) const {
        const int row0 = u.pm * BM + wr * 64 + fr, col0 = u.pn * BM + wc * 64 + 16 * fq;
        u32x4 gw[2][4];
#pragma unroll
        for (int ai = 0; ai < 2; ++ai)
#pragma unroll
            for (int m = 0; m < 4; ++m) gw[ai][m] = *(const u32x4*)(GT8 + (size_t)(row0 + ai * HALF + m * 16) * 3072 + 2048 + col0);
        EPI_RETIRE;
#pragma unroll
        for (int ai = 0; ai < 2; ++ai)
#pragma unroll
            for (int m = 0; m < 4; ++m) { bf16_t* op = MRG + (size_t)(row0 + ai * HALF + m * 16) * 1024 + col0; const float k = 1.0f / 255.0f;
                *(u32x4*)(op) = pack8(acc[ai][0][m][0] * (ub4(gw[ai][m].x) * k), acc[ai][0][m][1] * (ub4(gw[ai][m].y) * k));
                *(u32x4*)(op + 8) = pack8(acc[ai][1][m][0] * (ub4(gw[ai][m].z) * k), acc[ai][1][m][1] * (ub4(gw[ai][m].w) * k)); }
    }
};

struct EpiOutProj {
    static constexpr bool PERM = true, AFTER_DRAIN = false, HAS_MID = false;
    const bf16_t* Hn; const float* RINV; PG8_LAS const float* ginv; bf16_t* X1B; float* SSQ;
    __device__ __forceinline__ void operator()(const f32x4 (&acc)[2][2][4][2], const Unit& u, int wr, int wc, int fr, int fq) const {
        const int row0 = u.pm * BM + wr * 64 + fr, col0 = u.pn * BM + wc * 32 + 8 * fq;
        f32x4 gi[2][2];
#pragma unroll
        for (int bj = 0; bj < 2; ++bj)
#pragma unroll
            for (int n = 0; n < 2; ++n) gi[bj][n] = *(PG8_LAS const f32x4*)(ginv + col0 + bj * HALF + 4 * n);
#pragma unroll
        for (int ai = 0; ai < 2; ++ai) {
            u32x4 hw[4][2]; float ri[4];
#pragma unroll
            for (int m = 0; m < 4; ++m) { const int row = row0 + ai * HALF + m * 16; ri[m] = RINV[row]; hw[m][0] = *(const u32x4*)(Hn + (size_t)row * 1024 + col0); hw[m][1] = *(const u32x4*)(Hn + (size_t)row * 1024 + col0 + HALF); }
            if (ai == 0) EPI_RETIRE;
#pragma unroll
            for (int m = 0; m < 4; ++m) { const int row = row0 + ai * HALF + m * 16; const size_t off = (size_t)row * 1024 + col0; float ss = 0.f;
#pragma unroll
                for (int bj = 0; bj < 2; ++bj) { f32x4 h0, h1; unpack8(hw[m][bj], h0, h1);
                    const f32x4 v0 = h0 * ri[m] * gi[bj][0] + acc[ai][bj][m][0], v1 = h1 * ri[m] * gi[bj][1] + acc[ai][bj][m][1];
                    ss += dot4(v0) + dot4(v1); *(u32x4*)(X1B + off + bj * HALF) = pack8(v0, v1); }
                ss += __shfl_xor(ss, 16); ss += __shfl_xor(ss, 32);
                if (fq == 0) SSQ[(size_t)row * 16 + u.pn * 4 + wc] = ss; }
            asm volatile("" ::: "memory"); }
    }
};

template <bool NOSTORE = false> struct EpiUpT {
    static constexpr bool PERM = true, AFTER_DRAIN = false, HAS_MID = false;
    const float* SSQ; bf16_t* U; PG8_LAS float* rl;
    __device__ __forceinline__ void operator()(const f32x4 (&acc)[2][2][4][2], const Unit& u, int wr, int wc, int fr, int fq) const {
        const int lane_ = fq * 16 + fr, pidx = quad_src_idx(lane_);
        const int row0 = u.pm * BM + wr * 64 + (lane_ >> 2), col0 = u.pn * BM + wc * 32 + 8 * (lane_ & 3);
        { const int t = (wr * 4 + wc) * 64 + fq * 16 + fr;
          if (t < BM) { const f32x4* sp = (const f32x4*)(SSQ + (size_t)(u.pm * BM + t) * 16); const f32x4 s4 = (sp[0] + sp[1]) + (sp[2] + sp[3]);
              rl[t] = 1.0f / sqrtf(((s4[0] + s4[1]) + (s4[2] + s4[3])) * (1.0f / 1024.0f) + kEps); }
          asm volatile("s_waitcnt lgkmcnt(0)" ::: "memory"); __builtin_amdgcn_s_barrier(); asm volatile("" ::: "memory"); }
        EPI_RETIRE;
#pragma unroll
        for (int ai = 0; ai < 2; ++ai) {
#pragma unroll
            for (int m = 0; m < 4; ++m) { const float r = rl[ai * HALF + wr * 64 + m * 16 + fr];
                bf16_t* rowp = U + (size_t)(row0 + ai * HALF + m * 16) * 4096 + col0;
#pragma unroll
                for (int bj = 0; bj < 2; ++bj) { f32x4 a = acc[ai][bj][m][0] * r, b = acc[ai][bj][m][1] * r;
#pragma unroll
                    for (int j = 0; j < 4; ++j) { a[j] = fmaxf(a[j], 0.f); a[j] *= a[j]; b[j] = fmaxf(b[j], 0.f); b[j] *= b[j]; }
                    const u32x4 pk_ = quad_gather(pack8(a, b), pidx); if (NOSTORE) asm volatile("" :: "v"(pk_)); else *(u32x4*)(rowp + bj * HALF) = pk_; } } }
        asm volatile("s_waitcnt lgkmcnt(0)" ::: "memory"); __builtin_amdgcn_s_barrier(); asm volatile("" ::: "memory");
    }
};
typedef EpiUpT<false> EpiUp;

struct EpiDown {
    static constexpr bool PERM = true, AFTER_DRAIN = false, HAS_MID = false;
    const bf16_t* X1B; float* OUT;
    __device__ __forceinline__ void operator()(const f32x4 (&acc)[2][2][4][2], const Unit& u, int wr, int wc, int fr, int fq) const {
        const int row0 = u.pm * BM + wr * 64 + fr, col0 = u.pn * BM + wc * 32 + 8 * fq;
        u32x4 xw[2][4][2];
#pragma unroll
        for (int ai = 0; ai < 2; ++ai)
#pragma unroll
            for (int m = 0; m < 4; ++m) { const size_t off = (size_t)(row0 + ai * HALF + m * 16) * 1024 + col0; xw[ai][m][0] = *(const u32x4*)(X1B + off); xw[ai][m][1] = *(const u32x4*)(X1B + off + HALF); }
        EPI_RETIRE;
#pragma unroll
        for (int ai = 0; ai < 2; ++ai)
#pragma unroll
            for (int m = 0; m < 4; ++m) { const size_t off = (size_t)(row0 + ai * HALF + m * 16) * 1024 + col0;
#pragma unroll
                for (int bj = 0; bj < 2; ++bj) { f32x4 r0, r1; unpack8(xw[ai][m][bj], r0, r1);
                    *(f32x4*)(OUT + off + bj * HALF) = r0 + acc[ai][bj][m][0]; *(f32x4*)(OUT + off + bj * HALF + 4) = r1 + acc[ai][bj][m][1]; } }
    }
};

template <class Epi, class Sched, bool ALIGN_EPI = false, bool SP2 = false>
__device__ __forceinline__ void gemm_phase(PG8_LAS unsigned char* lds, const int K_, const Sched& S, const Epi& E) {
    const int tid = threadIdx.x, wid = __builtin_amdgcn_readfirstlane(tid >> 6), lane = tid & 63, wr = wid >> 2, wc = wid & 3, fr = lane & 15, fq = lane >> 4;
    const int K = K_, nt = K / BK;
    unsigned voffA[2], voffB[2];
#pragma unroll
    for (int i = 0; i < 2; ++i) { int R, C; stage_rc(tid * 16 + i * 8192, R, C); const int Rb = Epi::PERM ? ((R & ~31) + perm32(R & 31)) : R;
        voffA[i] = (unsigned)(R * K + C) * 2u; voffB[i] = (unsigned)(Rb * K + C) * 2u; }
    const size_t kstep = (size_t)(BK * 2);
    const size_t hstep = (size_t)HALF * K * 2;
    const size_t tstep = 2 * hstep;
    const unsigned ldsw = (unsigned)wid * 1024u;
    const int aoff = lds_byte(wr * 64 + fr, fq * 8), boff = lds_byte(wc * 32 + fr, fq * 8);
#define PG8_SA(b, h) (((b) * 2 + (h)) * HTB)
#define PG8_SB(b, h) ((4 + (b) * 2 + (h)) * HTB)
#define PG8_STAGE(bufoff, gbase, voff) do { _Pragma("unroll") for (int _i = 0; _i < 2; ++_i) \
        __builtin_amdgcn_global_load_lds((const unsigned*)((const char*)(gbase) + (voff)[_i]), (PG8_LAS unsigned*)(lds + (bufoff) + ldsw + _i * 8192), 16, 0, 0); } while (0)
#define PG8_LDA(dst, b, h) do { _Pragma("unroll") for (int m = 0; m < 4; ++m) _Pragma("unroll") for (int k = 0; k < 2; ++k) dst[m][k] = *(const PG8_LAS bf16x8*)(lds + PG8_SA(b, h) + aoff + m * 2048 + k * 1024); } while (0)
#define PG8_LDB(dst, b, h) do { _Pragma("unroll") for (int n = 0; n < 2; ++n) _Pragma("unroll") for (int k = 0; k < 2; ++k) dst[n][k] = *(const PG8_LAS bf16x8*)(lds + PG8_SB(b, h) + boff + n * 2048 + k * 1024); } while (0)
#define PG8_MMA(ai, bj, At, Bt) do { __builtin_amdgcn_s_setprio(1); _Pragma("unroll") for (int m = 0; m < 4; ++m) _Pragma("unroll") for (int n = 0; n < 2; ++n) _Pragma("unroll") for (int k = 0; k < 2; ++k) \
        acc[ai][bj][m][n] = __builtin_amdgcn_mfma_f32_16x16x32_bf16(Bt[n][k], At[m][k], acc[ai][bj][m][n], 0, 0, 0); __builtin_amdgcn_s_setprio(0); } while (0)
#define PG8_WAIT_V(n) asm volatile("s_waitcnt vmcnt(" #n ")" ::: "memory")
#define PG8_WAIT_L(n) asm volatile("s_waitcnt lgkmcnt(" #n ")" ::: "memory")
#if defined(NO_TZ)
#define PG8_WAIT_V8_T(tz) PG8_WAIT_V(8)
#else
#define PG8_WAIT_V8_T(tz) asm volatile("s_cmp_eq_u32 %0, 0\n\ts_cbranch_scc1 .Lpg8w_%=\n\ts_waitcnt vmcnt(8)\n.Lpg8w_%=:" :: "s"(tz) : "memory", "scc")
#endif
#define PG8_BAR __builtin_amdgcn_s_barrier()
#define PG8_SCHED __builtin_amdgcn_sched_barrier(0)
    Unit cur, nxt; int ui = 0;
    if (!S.next(0, cur)) return;
    f32x4 acc[2][2][4][2];
#pragma unroll
    for (int a = 0; a < 2; ++a)
#pragma unroll
        for (int b = 0; b < 2; ++b)
#pragma unroll
            for (int m = 0; m < 4; ++m)
#pragma unroll
                for (int n = 0; n < 2; ++n) acc[a][b][m][n] = (f32x4){0.f, 0.f, 0.f, 0.f};
    bf16x8 At[4][2], B0[2][2], B1[2][2];
    const char* cA = S.a_ptr(cur); const char* cB = S.b_ptr(cur);
    S.a_ready(cur);
    if constexpr (SP2) {
        PG8_STAGE(PG8_SB(0, 0), cB, voffB); PG8_STAGE(PG8_SB(0, 1), cB + hstep, voffB); PG8_STAGE(PG8_SA(0, 0), cA, voffA); PG8_STAGE(PG8_SA(0, 1), cA + hstep, voffA);
        if (wr == 1) PG8_BAR;
        PG8_WAIT_V(2); PG8_BAR;
        PG8_STAGE(PG8_SB(1, 0), cB + kstep, voffB); PG8_STAGE(PG8_SA(1, 0), cA + kstep, voffA); PG8_STAGE(PG8_SB(1, 1), cB + hstep + kstep, voffB); PG8_STAGE(PG8_SA(1, 1), cA + hstep + kstep, voffA);
        PG8_WAIT_V(0); PG8_BAR;
    } else {
        PG8_STAGE(PG8_SB(0, 0), cB, voffB); PG8_STAGE(PG8_SA(0, 0), cA, voffA); PG8_STAGE(PG8_SB(0, 1), cB + hstep, voffB); PG8_STAGE(PG8_SA(0, 1), cA + hstep, voffA);
        if (wr == 1) PG8_BAR;
        PG8_WAIT_V(4); PG8_BAR;
        PG8_STAGE(PG8_SB(1, 0), cB + kstep, voffB); PG8_STAGE(PG8_SA(1, 0), cA + kstep, voffA); PG8_STAGE(PG8_SB(1, 1), cB + hstep + kstep, voffB);
        PG8_WAIT_V(6); PG8_BAR;
    }
    for (;;) {
        const bool has_next = S.next(ui + 1, nxt);
        const char* nA = has_next ? S.a_ptr(nxt) : cA; const char* nB = has_next ? S.b_ptr(nxt) : cB;
#if defined(TSPROBE)
        const unsigned long long kc0_ = __builtin_amdgcn_s_memtime();
#endif
        for (int t = 0; t < nt; t += 2) {
            if constexpr (Epi::HAS_MID) { if (t == 8 || t == 16) {
#if defined(TSPROBE)
                const unsigned long long h0_ = __builtin_amdgcn_s_memrealtime();
#endif
                E.mid(acc, cur, t, wr, wc, fr, fq);
#if defined(TSPROBE)
                if (blockIdx.x == 0 && threadIdx.x == 0) { unsigned long long* tsp_ = (unsigned long long*)E.tsbase; tsp_[15] = tsp_[15] + (__builtin_amdgcn_s_memrealtime() - h0_); }
#endif
            } }
            const bool last = (t == nt - 2);
            const char* a1 = cA + (size_t)(t + 1) * kstep;
            const char* a2 = last ? nA : cA + (size_t)(t + 2) * kstep; const char* b2 = last ? nB : cB + (size_t)(t + 2) * kstep;
            const char* a3 = a2 + kstep; const char* b3 = b2 + kstep;
            if (last && has_next) S.a_ready(nxt);
            const int tz = __builtin_amdgcn_readfirstlane(t);
            if constexpr (SP2) {
            PG8_LDB(B0, 0, 0); PG8_LDB(B1, 0, 1); PG8_SCHED; PG8_LDA(At, 0, 0); PG8_STAGE(PG8_SA(1, 1), a1 + hstep, voffA);
            PG8_WAIT_V8_T(tz); PG8_WAIT_L(0); PG8_BAR; PG8_MMA(0, 0, At, B0); PG8_MMA(0, 1, At, B1); PG8_BAR; PG8_SCHED;
            PG8_LDA(At, 0, 1); PG8_STAGE(PG8_SB(0, 0), b2, voffB); PG8_STAGE(PG8_SB(0, 1), b2 + hstep, voffB); PG8_STAGE(PG8_SA(0, 0), a2, voffA);
            PG8_WAIT_V8_T(tz); PG8_WAIT_L(0); PG8_BAR; PG8_MMA(1, 0, At, B0); PG8_MMA(1, 1, At, B1); PG8_BAR; PG8_SCHED;
            PG8_LDB(B0, 1, 0); PG8_LDB(B1, 1, 1); PG8_SCHED; PG8_LDA(At, 1, 0); PG8_STAGE(PG8_SA(0, 1), a2 + hstep, voffA);
            PG8_WAIT_V8_T(tz); PG8_WAIT_L(0); PG8_BAR; PG8_MMA(0, 0, At, B0); PG8_MMA(0, 1, At, B1); PG8_BAR; PG8_SCHED;
            PG8_LDA(At, 1, 1); PG8_STAGE(PG8_SB(1, 0), b3, voffB); PG8_STAGE(PG8_SB(1, 1), b3 + hstep, voffB); PG8_STAGE(PG8_SA(1, 0), a3, voffA);
            PG8_WAIT_V(8); PG8_WAIT_L(0); PG8_BAR; PG8_MMA(1, 0, At, B0); PG8_MMA(1, 1, At, B1); PG8_BAR; PG8_SCHED;
            } else {
            PG8_LDB(B0, 0, 0); PG8_SCHED; PG8_LDA(At, 0, 0); PG8_STAGE(PG8_SA(1, 1), a1 + hstep, voffA);
            PG8_WAIT_L(8); PG8_BAR; PG8_WAIT_L(0); PG8_MMA(0, 0, At, B0); PG8_BAR; PG8_SCHED;
            PG8_LDB(B1, 0, 1); PG8_STAGE(PG8_SB(0, 0), b2, voffB);
            PG8_BAR; PG8_WAIT_L(0); PG8_MMA(0, 1, At, B1); PG8_BAR;
            PG8_LDA(At, 0, 1); PG8_STAGE(PG8_SA(0, 0), a2, voffA);
            PG8_BAR; PG8_WAIT_L(0); PG8_MMA(1, 0, At, B0); PG8_BAR; PG8_SCHED;
            PG8_STAGE(PG8_SB(0, 1), b2 + hstep, voffB);
            PG8_WAIT_V(6); PG8_BAR; PG8_MMA(1, 1, At, B1); PG8_BAR;
            PG8_LDB(B0, 1, 0); PG8_SCHED; PG8_LDA(At, 1, 0); PG8_STAGE(PG8_SA(0, 1), a2 + hstep, voffA);
            PG8_WAIT_L(8); PG8_BAR; PG8_WAIT_L(0); PG8_MMA(0, 0, At, B0); PG8_BAR; PG8_SCHED;
            PG8_LDB(B1, 1, 1); PG8_STAGE(PG8_SB(1, 0), b3, voffB);
            PG8_BAR; PG8_WAIT_L(0); PG8_MMA(0, 1, At, B1); PG8_BAR;
            PG8_LDA(At, 1, 1); PG8_STAGE(PG8_SA(1, 0), a3, voffA);
            PG8_BAR; PG8_WAIT_L(0); PG8_MMA(1, 0, At, B0); PG8_BAR; PG8_SCHED;
            PG8_STAGE(PG8_SB(1, 1), b3 + hstep, voffB);
            PG8_WAIT_V(6); PG8_BAR; PG8_MMA(1, 1, At, B1); PG8_BAR;
            }
        }
#if defined(TSPROBE)
        if (blockIdx.x == 0 && threadIdx.x == 0) { unsigned long long* tsp_ = (unsigned long long*)S.tsbase; tsp_[42] = tsp_[42] + (__builtin_amdgcn_s_memtime() - kc0_); tsp_[44] = tsp_[44] + (unsigned long long)nt; }
#endif
#if !defined(NO_PRESTAGE)
        if constexpr (SP2) PG8_STAGE(PG8_SA(1, 1), nA + kstep + hstep, voffA);
#endif
        if constexpr (ALIGN_EPI) { if (wr == 0) PG8_BAR; }
#if defined(TSPROBE)
        const unsigned long long e0_ = __builtin_amdgcn_s_memrealtime();
#endif
        if constexpr (!Epi::AFTER_DRAIN) { E(acc, cur, wr, wc, fr, fq); S.done(cur); }
#if defined(TSPROBE)
        if (blockIdx.x == 0 && threadIdx.x == 0) { unsigned long long* tsp_ = (unsigned long long*)S.tsbase; tsp_[17] = tsp_[17] + (__builtin_amdgcn_s_memrealtime() - e0_); }
#endif
        if (!has_next) break;
#pragma unroll
        for (int a = 0; a < 2; ++a)
#pragma unroll
            for (int b = 0; b < 2; ++b)
#pragma unroll
                for (int m = 0; m < 4; ++m)
#pragma unroll
                    for (int n = 0; n < 2; ++n) acc[a][b][m][n] = (f32x4){0.f, 0.f, 0.f, 0.f};
        cur = nxt; cA = nA; cB = nB; ++ui;
        if constexpr (ALIGN_EPI) { if (wr == 1) PG8_BAR; }
    }
    PG8_WAIT_V(0);
    if constexpr (!ALIGN_EPI) { if (wr == 0) PG8_BAR; }
    PG8_BAR;
    if constexpr (Epi::AFTER_DRAIN) { E.fused(acc, cur, wr, wc, fr, fq, lds, wid, lane); S.done(cur); }
#undef PG8_SA
#undef PG8_SB
#undef PG8_STAGE
#undef PG8_LDA
#undef PG8_LDB
#undef PG8_MMA
#undef PG8_WAIT_V
#undef PG8_WAIT_L
#undef PG8_BAR
#undef PG8_SCHED
}
}
namespace attn_body {
using bf16=__hip_bfloat16;
using bf16x8=__attribute__((ext_vector_type(8)))short;
using s16x4=__attribute__((ext_vector_type(4)))short;
using f32x16=__attribute__((ext_vector_type(16)))float;
using f32x4=__attribute__((ext_vector_type(4)))float;
using u32x4=__attribute__((ext_vector_type(4)))unsigned;
constexpr int SEQ=4096,D=64,PQ=1536;
constexpr int NW=8,QBLK=32,QB=QBLK*NW,KVBLK=64;
__device__ __forceinline__ int crow(int r,int hi){return (r&3)+8*(r>>2)+4*hi;}
#define SBAR() __builtin_amdgcn_sched_barrier(0)
__device__ __forceinline__ void cmask(f32x16&p0,f32x16&p1,int jb,int qrel,int hi){
  const float NEG=-INFINITY; int kb=64*jb+4*hi;
  #pragma unroll
  for(int r=0;r<16;++r){int kv=kb+(r&3)+8*(r>>2); if(kv>qrel)p0[r]=NEG; if(kv+32>qrel)p1[r]=NEG;}
}
constexpr int NSLOT=3, SLOTB=8192;
constexpr int LDS_K=0, LDS_V=NSLOT*SLOTB, LDS_WS=2*NSLOT*SLOTB, LDS_OST=LDS_WS+NW*64*4, LDS_GL=LDS_OST+NW*4096+2048  , LDS_TB=LDS_GL+16384  , LDS_BYTES=LDS_TB+2560;
constexpr float LOG2E=1.4426950408889634f;
__device__ __forceinline__ void glds16(const void*gsrc,unsigned lds_dst){unsigned keep;
  asm volatile("s_mov_b32 %0, m0\n\ts_mov_b32 m0, %2\n\ts_nop 0\n\tglobal_load_lds_dwordx4 %1, off\n\ts_mov_b32 m0, %0":"=&s"(keep):"v"(gsrc),"s"(lds_dst):"memory");}
typedef float f32x2_t __attribute__((ext_vector_type(2))); typedef __bf16 bf16x2_t __attribute__((ext_vector_type(2)));
__device__ __forceinline__ unsigned cvtpk_s(float lo,float hi){f32x2_t v={lo,hi};bf16x2_t b=__builtin_convertvector(v,bf16x2_t);return __builtin_bit_cast(unsigned,b);}
#define WAIT_BAR(N) asm volatile("s_waitcnt vmcnt(" #N ") lgkmcnt(0)\n\ts_barrier":::"memory")
typedef __attribute__((address_space(3))) const char* lds_cptr;
typedef __attribute__((address_space(3))) float* lds_fptr;
typedef __attribute__((address_space(3))) f32x4* lds_f4ptr;
typedef short v4i16_t __attribute__((ext_vector_type(4)));
#define MX3(a,b,c) __builtin_fmaxf(__builtin_fmaxf((a),(b)),(c))
__device__ __forceinline__ void qkt(f32x16&p0,f32x16&p1,const char*Kslot,const bf16x8*qr,int r32,int hi){
  const char*kb=Kslot+hi*1024+r32*16;
  #pragma unroll
  for(int d0=0;d0<4;++d0){
    const bf16x8 b0=*reinterpret_cast<const bf16x8*>(kb+d0*2048);
    const bf16x8 b1=*reinterpret_cast<const bf16x8*>(kb+d0*2048+512);
    p0=__builtin_amdgcn_mfma_f32_32x32x16_bf16(b0,qr[d0],p0,0,0,0);p1=__builtin_amdgcn_mfma_f32_32x32x16_bf16(b1,qr[d0],p1,0,0,0);}
}
__device__ __forceinline__ void kload8(bf16x8*kf,lds_cptr kp){
  kf[0]=*(const __attribute__((address_space(3))) bf16x8*)(kp);      kf[1]=*(const __attribute__((address_space(3))) bf16x8*)(kp+512);
  kf[2]=*(const __attribute__((address_space(3))) bf16x8*)(kp+2048); kf[3]=*(const __attribute__((address_space(3))) bf16x8*)(kp+2560);
  kf[4]=*(const __attribute__((address_space(3))) bf16x8*)(kp+4096); kf[5]=*(const __attribute__((address_space(3))) bf16x8*)(kp+4608);
  kf[6]=*(const __attribute__((address_space(3))) bf16x8*)(kp+6144); kf[7]=*(const __attribute__((address_space(3))) bf16x8*)(kp+6656);
}
__device__ __forceinline__ void kload2(bf16x8*kf,lds_cptr kp,int j){ kf[2*j]=*(const __attribute__((address_space(3))) bf16x8*)(kp+j*2048); kf[2*j+1]=*(const __attribute__((address_space(3))) bf16x8*)(kp+j*2048+512); }
__device__ __forceinline__ s16x4 vtr(lds_cptr p){ return __builtin_bit_cast(s16x4,__builtin_amdgcn_ds_read_tr16_b64_v4i16((__attribute__((address_space(3))) v4i16_t*)p)); }
__device__ __forceinline__ float rowmax(const f32x16&p0,const f32x16&p1){
  float a=MX3(p0[0],p0[1],p1[0]),b=MX3(p0[2],p0[3],p1[1]);a=MX3(a,p1[2],p1[3]);
  #pragma unroll
  for(int r=4;r<16;r+=4){a=MX3(a,p0[r],p0[r+1]);b=MX3(b,p0[r+2],p0[r+3]);a=MX3(a,p1[r],p1[r+1]);b=MX3(b,p1[r+2],p1[r+3]);}
  float m=__builtin_fmaxf(a,b);
  auto rr=__builtin_amdgcn_permlane32_swap(__float_as_uint(m),__float_as_uint(m),false,false);
  return __builtin_fmaxf(__uint_as_float(rr[0]),__uint_as_float(rr[1]));
}
__device__ __forceinline__ void pv(f32x16*o,int vb,bf16x8 pa0,bf16x8 pa1,bf16x8 pa2,bf16x8 pa3){
  #pragma unroll
  for(int d0=0;d0<2;++d0){s16x4 lo[4],hi[4];
    #pragma unroll
    for(int ks=0;ks<4;++ks){
      asm volatile("ds_read_b64_tr_b16 %0,%1 offset:%c2":"=&v"(lo[ks]):"v"(vb),"i"(d0*4096+ks*1024):"memory");
      asm volatile("ds_read_b64_tr_b16 %0,%1 offset:%c2":"=&v"(hi[ks]):"v"(vb),"i"(d0*4096+ks*1024+512):"memory");}
    asm volatile("s_waitcnt lgkmcnt(0)":::"memory");SBAR();
    #define PK(k) (bf16x8){lo[k][0],lo[k][1],lo[k][2],lo[k][3],hi[k][0],hi[k][1],hi[k][2],hi[k][3]}
    o[d0]=__builtin_amdgcn_mfma_f32_32x32x16_bf16(pa0,PK(0),o[d0],0,0,0);
    o[d0]=__builtin_amdgcn_mfma_f32_32x32x16_bf16(pa1,PK(1),o[d0],0,0,0);
    o[d0]=__builtin_amdgcn_mfma_f32_32x32x16_bf16(pa2,PK(2),o[d0],0,0,0);
    o[d0]=__builtin_amdgcn_mfma_f32_32x32x16_bf16(pa3,PK(3),o[d0],0,0,0);
    #undef PK
  }
}

#define ATTN_STORE16(p,v) (*(u32x4*)(p)=(v))
template<int MODE,int PKV,int THRL> __device__ __forceinline__ void attn_unit(const bf16*Qw0,const bf16*__restrict__ Kh,const bf16*__restrict__ Vh,bf16*Ow0,const int NT,const int q0,const int dq,const float l0,const float*__restrict__ gsrc,const float*__restrict__ rb,char*shm){
  int tid_=threadIdx.x; asm volatile("":"+v"(tid_));
  static_assert(MODE==0,"only the FoX form is instantiated: the phase-B C-init interleave reads the g copy (the window-table form is swa_unit)");
  const int tid=tid_,lane=tid&63,r32=lane&31,hi=lane>>5; const int wid=__builtin_amdgcn_readfirstlane(tid>>6);
  const bf16*Qw=Qw0+(long)(wid*QBLK)*PQ;
  const unsigned lds0=(unsigned)(uintptr_t)shm;
  float*wsf=(float*)(shm+LDS_WS)+wid*64;
  const lds_cptr shm3=(lds_cptr)shm;
  const lds_fptr gl=(lds_fptr)(shm3+LDS_GL); const lds_fptr tb=(lds_fptr)(shm3+LDS_TB);
  const bf16*ksrc=Kh+(long)lane*PKV+wid*8;
  const bf16*vsrc=Vh+(long)(16*(wid&3)+(lane>>2))*PKV+(wid>>2)*32+(lane&3)*8;
  const unsigned kdst=lds0+LDS_K+wid*1024, vdst=lds0+LDS_V+wid*1024;
  #define DMA_K(t,slot) glds16(ksrc+(long)(t)*KVBLK*PKV,(unsigned)__builtin_amdgcn_readfirstlane(kdst+(slot)))
  #define DMA_V(t,slot) glds16(vsrc+(long)(t)*KVBLK*PKV,(unsigned)__builtin_amdgcn_readfirstlane(vdst+(slot)))
  const int vb0=(int)(lds0+LDS_V)+((lane>>4)&1)*32+(lane&3)*8+(4*hi+((lane&15)>>2))*64;
  const char*Kbase=shm+LDS_K; bf16x8 kf[8];
  const lds_cptr kp0=shm3+LDS_K+hi*1024+r32*16; const lds_cptr vp0=shm3+LDS_V+((lane>>4)&1)*32+(lane&3)*8+(4*hi+((lane&15)>>2))*64;
  DMA_K(0,0);DMA_V(0,0);DMA_K(1,SLOTB);
  if(MODE==0){ const int n4=(q0+QB)>>2; for(int i=tid;i<n4;i+=NW*64) ((lds_f4ptr)gl)[i]=((const f32x4*)gsrc)[i]; }
  else{ for(int i=tid;i<640;i+=NW*64){ const int d=i-256; float v=-1e30f;
      if(d>=0&&d<128){ int bk=d; if(d>=16){ bk=16+(int)(__logf((float)d*(1.0f/16.0f))*(16.0f/2.0794415416798357f)); bk=bk>31?31:bk; } v=rb[bk*8]*LOG2E; }
      tb[i]=v; } }
  bf16x8 qr[4];
  #pragma unroll
  for(int d0=0;d0<4;++d0)qr[d0]=*reinterpret_cast<const bf16x8*>(&Qw[(long)r32*PQ+d0*16+hi*8]);
  const int qrel=wid*QBLK+r32;
  float mhat=(MODE==0)?gsrc[q0+qrel]:0.f; float l_reg=(MODE==0)?0.f:((hi==0)?l0:0.f);
  f32x16 o[2];o[0]=f32x16{};o[1]=f32x16{};
  #define CMASK(P0,P1,t) do{ if(MODE==0){int jb_=(t)-(NT-4); if(jb_>=0)cmask(P0,P1,jb_,qrel,hi);} }while(0)
  #define CINIT(X0,X1,tt) do{ if(MODE==0){ const lds_f4ptr gp_=(lds_f4ptr)(gl+64*(tt)+4*hi); \
        _Pragma("unroll") for(int g4=0;g4<4;++g4){ const f32x4 a_=gp_[2*g4], b_=gp_[8+2*g4]; \
          X0[4*g4]=a_[0]-mhat;X0[4*g4+1]=a_[1]-mhat;X0[4*g4+2]=a_[2]-mhat;X0[4*g4+3]=a_[3]-mhat; X1[4*g4]=b_[0]-mhat;X1[4*g4+1]=b_[1]-mhat;X1[4*g4+2]=b_[2]-mhat;X1[4*g4+3]=b_[3]-mhat; } } \
      else{ const lds_fptr tp_=tb+(dq+qrel-4*hi+256-64*(tt)); \
        _Pragma("unroll") for(int r=0;r<16;++r){ X0[r]=tp_[-((r&3)+8*(r>>2))]-mhat; X1[r]=tp_[-32-((r&3)+8*(r>>2))]-mhat; } } }while(0)
  bool resc=false;
  #define RESC() do{ if(resc){ asm volatile("s_waitcnt lgkmcnt(0)":::"memory"); \
      _Pragma("unroll") for(int d_=0;d_<2;++d_) _Pragma("unroll") for(int r=0;r<16;++r)o[d_][r]*=wsf[crow(r,hi)]; } }while(0)
  f32x16 pA0,pA1,pB0,pB1;
  int sl_prev=0,sl_cur=0,sl_next=SLOTB;
  #define ROT() do{sl_prev=sl_cur;sl_cur=sl_next;sl_next=(sl_next==(NSLOT-1)*SLOTB)?0:sl_next+SLOTB;}while(0)
  DMA_K(2,2*SLOTB);
  WAIT_BAR(3);
  CINIT(pA0,pA1,0);
  qkt(pA0,pA1,Kbase,qr,r32,hi);CMASK(pA0,pA1,0);
  { const float rm=rowmax(pA0,pA1);
    if(__any(rm>(float)THRL)){ const float dl=__builtin_fmaxf(rm,0.f); mhat+=dl;
      _Pragma("unroll") for(int r=0;r<16;++r){pA0[r]-=dl;pA1[r]-=dl;}
      l_reg*=__builtin_amdgcn_exp2f(-dl); }
    _Pragma("unroll") for(int r=0;r<16;++r){pA0[r]=__builtin_amdgcn_exp2f(pA0[r]);pA1[r]=__builtin_amdgcn_exp2f(pA1[r]);} }
  WAIT_BAR(0);
  DMA_K(3,0);DMA_V(1,SLOTB);
  ROT();
  kload8(kf,kp0+sl_cur);
  CINIT(pB0,pB1,1);
  WAIT_BAR(2);
  s16x4 vlo[8],vhi[8]; u32x4 pw0,pw1,pw2,pw3;
  #define PKW(P,B) cvtpk_s(P[B],P[B+1])
  #define PAF(k) __builtin_bit_cast(bf16x8,pw##k)
  #define VFR(i) (bf16x8){vlo[i][0],vlo[i][1],vlo[i][2],vlo[i][3],vhi[i][0],vhi[i][1],vhi[i][2],vhi[i][3]}
  #define PIN(x) asm volatile("":"+v"(x))
  #define GAPA(MF,A0,A1,A2,A3,W0,W1,PW) do{ MF; sacc+=A0; sacc+=A1; sacc+=A2; sacc+=A3; PIN(sacc); W0; W1; PIN(PW); SBAR(); }while(0)
  #define EX(v) __builtin_amdgcn_exp2f(v)
  #define GAPB(MF,X,B) do{ MF; X[B]=EX(X[B]); X[B+1]=EX(X[B+1]); X[B+2]=EX(X[B+2]); X[B+3]=EX(X[B+3]); PIN(X); SBAR(); }while(0)
  #define GAPB2(MF,X,B,G,LD,Y,YB,CI) do{ if(G){ LD; } MF; X[B]=EX(X[B]); X[B+1]=EX(X[B+1]); X[B+2]=EX(X[B+2]); X[B+3]=EX(X[B+3]); PIN(X); if(G){ Y[YB]=CI[0]-mhat; Y[YB+1]=CI[1]-mhat; Y[YB+2]=CI[2]-mhat; Y[YB+3]=CI[3]-mhat; PIN(Y); } SBAR(); }while(0)
  #define VRD(i) do{ vlo[i]=vtr(vp_+(((i)>>2)*4096+((i)&3)*1024)); vhi[i]=vtr(vp_+(((i)>>2)*4096+((i)&3)*1024+512)); }while(0)
  #define KRD(G,j) do{ if(G){ kload2(kf,kp0+sl_next,j); SBAR(); } }while(0)
  #define STEP(C0,C1,P0,P1,t,GK,GV,GL) do{ SBAR(); \
    const lds_cptr vp_=vp0+sl_prev; \
    VRD(0); SBAR(); float sacc=(P0[0]+P0[1]); \
    GAPA(C0=__builtin_amdgcn_mfma_f32_32x32x16_bf16(kf[0],qr[0],C0,0,0,0), P0[2],P0[3],P0[4],P0[5],     pw0[0]=PKW(P0,0), pw0[1]=PKW(P0,2), pw0); \
    VRD(4); SBAR(); GAPA(C1=__builtin_amdgcn_mfma_f32_32x32x16_bf16(kf[1],qr[0],C1,0,0,0), P0[6],P0[7],P0[8],P0[9],     pw0[2]=PKW(P0,4), pw0[3]=PKW(P0,6), pw0); \
    VRD(1); SBAR(); GAPA(C0=__builtin_amdgcn_mfma_f32_32x32x16_bf16(kf[2],qr[1],C0,0,0,0),   P0[10],P0[11],P0[12],P0[13], pw1[0]=PKW(P0,8), pw1[1]=PKW(P0,10), pw1); \
    VRD(5); SBAR(); GAPA(C1=__builtin_amdgcn_mfma_f32_32x32x16_bf16(kf[3],qr[1],C1,0,0,0),   P0[14],P0[15],P1[0],P1[1],   pw1[2]=PKW(P0,12),pw1[3]=PKW(P0,14), pw1); \
    VRD(2); SBAR(); GAPA(C0=__builtin_amdgcn_mfma_f32_32x32x16_bf16(kf[4],qr[2],C0,0,0,0),   P1[2],P1[3],P1[4],P1[5],     pw2[0]=PKW(P1,0), pw2[1]=PKW(P1,2), pw2); \
    VRD(6); SBAR(); GAPA(C1=__builtin_amdgcn_mfma_f32_32x32x16_bf16(kf[5],qr[2],C1,0,0,0),   P1[6],P1[7],P1[8],P1[9],     pw2[2]=PKW(P1,4), pw2[3]=PKW(P1,6), pw2); \
    VRD(3); SBAR(); GAPA(C0=__builtin_amdgcn_mfma_f32_32x32x16_bf16(kf[6],qr[3],C0,0,0,0),   P1[10],P1[11],P1[12],P1[13], pw3[0]=PKW(P1,8), pw3[1]=PKW(P1,10), pw3); \
    VRD(7); SBAR(); GAPA(C1=__builtin_amdgcn_mfma_f32_32x32x16_bf16(kf[7],qr[3],C1,0,0,0),   P1[14],P1[15],0.f,0.f,       pw3[2]=PKW(P1,12),pw3[3]=PKW(P1,14), pw3); \
    l_reg+=sacc; \
    if(GK){DMA_K((t)+3,sl_cur);} if(GV){DMA_V((t)+1,sl_next);} \
    CMASK(C0,C1,t); \
    { float a=MX3(C0[0],C0[1],C1[0]),b=MX3(C0[2],C0[3],C1[1]); a=MX3(a,C1[2],C1[3]); \
      _Pragma("unroll") for(int r=4;r<16;r+=4){a=MX3(a,C0[r],C0[r+1]);b=MX3(b,C0[r+2],C0[r+3]);a=MX3(a,C1[r],C1[r+1]);b=MX3(b,C1[r+2],C1[r+3]);} \
      float rm=__builtin_fmaxf(a,b); { auto rr=__builtin_amdgcn_permlane32_swap(__float_as_uint(rm),__float_as_uint(rm),false,false); rm=__builtin_fmaxf(__uint_as_float(rr[0]),__uint_as_float(rr[1])); } \
      resc=false; \
      if(__builtin_expect(__any(rm>(float)THRL),0)){ const float dl=__builtin_fmaxf(rm,0.f); mhat+=dl; \
        _Pragma("unroll") for(int r=0;r<16;++r){C0[r]-=dl;C1[r]-=dl;} \
        const float f=__builtin_amdgcn_exp2f(-dl); l_reg*=f; if(hi==0)wsf[r32]=f; resc=true; } } \
    SBAR(); \
      \
    const lds_f4ptr cig_=(lds_f4ptr)(gl+64*((t)+1)+4*hi); f32x4 cia_,cib_; \
    if(GV){ cia_=cig_[0]; } \
    GAPB2(o[0]=__builtin_amdgcn_mfma_f32_32x32x16_bf16(PAF(0),VFR(0),o[0],0,0,0), C0,0,  GV, cib_=cig_[8],  P0,0, cia_); \
    GAPB2(o[1]=__builtin_amdgcn_mfma_f32_32x32x16_bf16(PAF(0),VFR(4),o[1],0,0,0), C0,4,  GV, cia_=cig_[2],  P1,0, cib_); \
    KRD(GL,0); GAPB2(o[0]=__builtin_amdgcn_mfma_f32_32x32x16_bf16(PAF(1),VFR(1),o[0],0,0,0), C0,8,  GV, cib_=cig_[10], P0,4, cia_); \
    KRD(GL,1); GAPB2(o[1]=__builtin_amdgcn_mfma_f32_32x32x16_bf16(PAF(1),VFR(5),o[1],0,0,0), C0,12, GV, cia_=cig_[4],  P1,4, cib_); \
    KRD(GL,2); GAPB2(o[0]=__builtin_amdgcn_mfma_f32_32x32x16_bf16(PAF(2),VFR(2),o[0],0,0,0), C1,0,  GV, cib_=cig_[12], P0,8, cia_); \
    KRD(GL,3); GAPB2(o[1]=__builtin_amdgcn_mfma_f32_32x32x16_bf16(PAF(2),VFR(6),o[1],0,0,0), C1,4,  GV, cia_=cig_[6],  P1,8, cib_); \
    GAPB2(o[0]=__builtin_amdgcn_mfma_f32_32x32x16_bf16(PAF(3),VFR(3),o[0],0,0,0), C1,8,  GV, cib_=cig_[14], P0,12, cia_); \
    GAPB2(o[1]=__builtin_amdgcn_mfma_f32_32x32x16_bf16(PAF(3),VFR(7),o[1],0,0,0), C1,12, GV, (void)0,         P1,12, cib_); \
    }while(0)
  int t=1;
  #undef CMASK
  #define CMASK(P0,P1,t) do{}while(0)
  for(;t+5<NT;t+=2){
    STEP(pB0,pB1,pA0,pA1,t,true,true,true);     WAIT_BAR(2); RESC(); ROT();
    STEP(pA0,pA1,pB0,pB1,t+1,true,true,true);   WAIT_BAR(2); RESC(); ROT();
  }
  #undef CMASK
  #define CMASK(P0,P1,t) do{ if(MODE==0){int jb_=(t)-(NT-4); if(jb_>=0)cmask(P0,P1,jb_,qrel,hi);} }while(0)
  #define ENDW(tt) do{ if((tt)+3<NT){WAIT_BAR(2);} else if((tt)+2<NT){WAIT_BAR(1);} else {WAIT_BAR(0);} }while(0)
  for(;t+1<NT;t+=2){
    STEP(pB0,pB1,pA0,pA1,t,(t+3<NT),(t+1<NT),(t+1<NT));       ENDW(t);   RESC(); ROT();
    STEP(pA0,pA1,pB0,pB1,t+1,(t+4<NT),(t+2<NT),(t+2<NT));     ENDW(t+1); RESC(); ROT();
  }
  STEP(pB0,pB1,pA0,pA1,NT-1,false,false,false); RESC();
  { float sacc=pB0[0]+pB0[1]; _Pragma("unroll") for(int r=2;r<16;++r)sacc+=pB0[r]; _Pragma("unroll") for(int r=0;r<16;++r)sacc+=pB1[r]; l_reg+=sacc;
    pw0=(u32x4){PKW(pB0,0),PKW(pB0,2),PKW(pB0,4),PKW(pB0,6)};pw1=(u32x4){PKW(pB0,8),PKW(pB0,10),PKW(pB0,12),PKW(pB0,14)};pw2=(u32x4){PKW(pB1,0),PKW(pB1,2),PKW(pB1,4),PKW(pB1,6)};pw3=(u32x4){PKW(pB1,8),PKW(pB1,10),PKW(pB1,12),PKW(pB1,14)};
    SBAR(); pv(o,vb0+sl_cur,PAF(0),PAF(1),PAF(2),PAF(3)); }
  #undef PKW
  #undef PAF
  #undef VFR
  #undef PIN
  #undef GAPA
  #undef GAPB
  #undef GAPB2
  #undef EX
  #undef VRD
  #undef KRD
  #undef STEP
  #undef ENDW
  {auto rr=__builtin_amdgcn_permlane32_swap(__float_as_uint(l_reg),__float_as_uint(l_reg),false,false);l_reg=__uint_as_float(rr[0])+__uint_as_float(rr[1]);}
  if(hi==0)wsf[32+r32]=l_reg;asm volatile("s_waitcnt lgkmcnt(0)":::"memory");
  float rli[16];
  #pragma unroll
  for(int r=0;r<16;++r)rli[r]=__builtin_amdgcn_rcpf(wsf[32+crow(r,hi)]);
  bf16*Ow=Ow0+(long)(wid*QBLK)*PQ;
  { bf16*stg=(bf16*)(shm+LDS_OST)+wid*2048;
    #pragma unroll
    for(int r=0;r<16;++r){const int orow=crow(r,hi);
      #pragma unroll
      for(int d0=0;d0<2;++d0)stg[orow*64+d0*32+r32]=__float2bfloat16(o[d0][r]*rli[r]);}
    asm volatile("s_waitcnt lgkmcnt(0)":::"memory");
    #pragma unroll
    for(int i=0;i<4;++i){const int row=i*8+(lane>>3),ch=lane&7; const u32x4 v=*(const u32x4*)(stg+row*64+ch*8); ATTN_STORE16(Ow+(long)row*PQ+ch*8,v);} }
  asm volatile("s_waitcnt lgkmcnt(0)\n\ts_barrier":::"memory");
  #undef DMA_K
  #undef DMA_V
  #undef CMASK
  #undef CINIT
  #undef RESC
  #undef ROT
}

constexpr int SWA_K=0, SWA_V=49152, SWA_TB=98304, SWA_LDS_BYTES=SWA_TB+4*640*4;
__device__ __forceinline__ void swa_unit(int b,int kvh,int qb,bf16*QA,const bf16*__restrict__ KA,const bf16*__restrict__ VA,const float*__restrict__ sink,const float*__restrict__ rel_bias,char*shm){
  int tid_=threadIdx.x; asm volatile("":"+v"(tid_));
  const int tid=tid_,lane=tid&63,r32=lane&31,hi=lane>>5; const int wid=__builtin_amdgcn_readfirstlane(tid>>6);
  const lds_cptr shm3=(lds_cptr)shm; const unsigned lds0=(unsigned)(uintptr_t)shm;
  const lds_fptr tb=(lds_fptr)(shm3+SWA_TB);
  const int q0=qb*QB, T0=(qb==0)?0:4*qb-2, NT=4*qb+4-T0, dq=q0-64*T0; const size_t rb=(size_t)b*SEQ;
  { const bf16*ksrc=KA+(rb+64*T0+lane)*128+kvh*64+wid*8;
    const bf16*vsrc=VA+(rb+64*T0+16*(wid&3)+(lane>>2))*128+kvh*64+(wid>>2)*32+(lane&3)*8;
    for(int t=0;t<NT;++t){ glds16(ksrc+(long)t*KVBLK*128,(unsigned)__builtin_amdgcn_readfirstlane(lds0+SWA_K+t*SLOTB+wid*1024)); glds16(vsrc+(long)t*KVBLK*128,(unsigned)__builtin_amdgcn_readfirstlane(lds0+SWA_V+t*SLOTB+wid*1024)); } }
  for(int i=tid;i<640;i+=NW*64){ const int d=i-256; const bool in=(d>=0&&d<128); int bk=d<0?0:d; if(d>=16){ bk=16+(int)(__logf((float)d*(1.0f/16.0f))*(16.0f/2.0794415416798357f)); bk=bk>31?31:bk; }
    const float*rp=rel_bias+bk*8+4*kvh;
    #pragma unroll
    for(int hh=0;hh<4;++hh) tb[hh*640+i]=in?rp[hh]*LOG2E:-1e30f; }
  asm volatile("s_waitcnt vmcnt(0) lgkmcnt(0)\n\ts_barrier":::"memory");
  const int qrel=wid*QBLK+r32, off=dq+QBLK*wid;
  const int t_lo=(off>127)?((off-127)>>6):0, t_hi=(off+31)>>6;
  const lds_cptr kp0=shm3+SWA_K+hi*1024+r32*16; const lds_cptr vp0=shm3+SWA_V+((lane>>4)&1)*32+(lane&3)*8+(4*hi+((lane&15)>>2))*64;
  bf16x8 qn[4];
  { const bf16*Q0=QA+(rb+q0+wid*QBLK)*PQ+(4*kvh)*64;
    #pragma unroll
    for(int d0=0;d0<4;++d0)qn[d0]=*reinterpret_cast<const bf16x8*>(&Q0[(long)r32*PQ+d0*16+hi*8]); }
  #pragma unroll 1
  for(int hh=0;hh<4;++hh){
    const int hq=4*kvh+hh; bf16*Qw=QA+(rb+q0+wid*QBLK)*PQ+hq*64;
    bf16x8 qr[4];
    #pragma unroll
    for(int d0=0;d0<4;++d0)qr[d0]=qn[d0];
    { const bf16*Q1=Qw+((hh<3)?64:0);
      #pragma unroll
      for(int d0=0;d0<4;++d0)qn[d0]=*reinterpret_cast<const bf16x8*>(&Q1[(long)r32*PQ+d0*16+hi*8]); }
    const lds_fptr tp=tb+hh*640+(dq+qrel-4*hi+256);
    f32x16 s[3][2];
    #pragma unroll
    for(int k=0;k<3;++k){ const int t=t_lo+k;
      if(t<=t_hi){ const lds_fptr tq=tp-64*t;
        #pragma unroll
        for(int r=0;r<16;++r){ s[k][0][r]=tq[-((r&3)+8*(r>>2))]; s[k][1][r]=tq[-32-((r&3)+8*(r>>2))]; }
        const lds_cptr kp=kp0+t*SLOTB;
        #pragma unroll
        for(int d0=0;d0<4;++d0){ const bf16x8 a0=*(const __attribute__((address_space(3))) bf16x8*)(kp+d0*2048), a1=*(const __attribute__((address_space(3))) bf16x8*)(kp+d0*2048+512);
          s[k][0]=__builtin_amdgcn_mfma_f32_32x32x16_bf16(a0,qr[d0],s[k][0],0,0,0); s[k][1]=__builtin_amdgcn_mfma_f32_32x32x16_bf16(a1,qr[d0],s[k][1],0,0,0); } }
      else{
        #pragma unroll
        for(int r=0;r<16;++r){ s[k][0][r]=-1e30f; s[k][1][r]=-1e30f; } } }
    const float sk2=sink[hq]*LOG2E;
    float m=__builtin_fmaxf(__builtin_fmaxf(rowmax(s[0][0],s[0][1]),rowmax(s[1][0],s[1][1])),__builtin_fmaxf(rowmax(s[2][0],s[2][1]),sk2));
    float l=0.f;
    #pragma unroll
    for(int k=0;k<3;++k)
      #pragma unroll
      for(int r=0;r<16;++r){ s[k][0][r]=__builtin_amdgcn_exp2f(s[k][0][r]-m); s[k][1][r]=__builtin_amdgcn_exp2f(s[k][1][r]-m); l+=s[k][0][r]+s[k][1][r]; }
    { auto rr=__builtin_amdgcn_permlane32_swap(__float_as_uint(l),__float_as_uint(l),false,false); l=__uint_as_float(rr[0])+__uint_as_float(rr[1]); }
    l+=__builtin_amdgcn_exp2f(sk2-m);
    f32x16 o[2]; o[0]=f32x16{}; o[1]=f32x16{};
    #pragma unroll
    for(int k=0;k<3;++k){ const int t=t_lo+k;
      if(t<=t_hi){ const lds_cptr vp=vp0+t*SLOTB;
        u32x4 pw[4];
        pw[0]=(u32x4){cvtpk_s(s[k][0][0],s[k][0][1]),cvtpk_s(s[k][0][2],s[k][0][3]),cvtpk_s(s[k][0][4],s[k][0][5]),cvtpk_s(s[k][0][6],s[k][0][7])};
        pw[1]=(u32x4){cvtpk_s(s[k][0][8],s[k][0][9]),cvtpk_s(s[k][0][10],s[k][0][11]),cvtpk_s(s[k][0][12],s[k][0][13]),cvtpk_s(s[k][0][14],s[k][0][15])};
        pw[2]=(u32x4){cvtpk_s(s[k][1][0],s[k][1][1]),cvtpk_s(s[k][1][2],s[k][1][3]),cvtpk_s(s[k][1][4],s[k][1][5]),cvtpk_s(s[k][1][6],s[k][1][7])};
        pw[3]=(u32x4){cvtpk_s(s[k][1][8],s[k][1][9]),cvtpk_s(s[k][1][10],s[k][1][11]),cvtpk_s(s[k][1][12],s[k][1][13]),cvtpk_s(s[k][1][14],s[k][1][15])};
        #pragma unroll
        for(int dh=0;dh<2;++dh)
          #pragma unroll
          for(int ks=0;ks<4;++ks){ const s16x4 lo=vtr(vp+dh*4096+ks*1024), hh2=vtr(vp+dh*4096+ks*1024+512);
            const bf16x8 vf=(bf16x8){lo[0],lo[1],lo[2],lo[3],hh2[0],hh2[1],hh2[2],hh2[3]};
            o[dh]=__builtin_amdgcn_mfma_f32_32x32x16_bf16(__builtin_bit_cast(bf16x8,pw[ks]),vf,o[dh],0,0,0); } } }
    const lds_fptr wsf=(lds_fptr)(shm3+SWA_LDS_BYTES)+wid*64;
    if(hi==0)wsf[r32]=l;
    float rli[16];
    #pragma unroll
    for(int r=0;r<16;++r)rli[r]=__builtin_amdgcn_rcpf(wsf[crow(r,hi)]);
    { bf16*stg=(bf16*)(shm+SWA_LDS_BYTES+2048)+wid*2048;
      #pragma unroll
      for(int r=0;r<16;++r){const int orow=crow(r,hi);
        #pragma unroll
        for(int d0=0;d0<2;++d0)stg[orow*64+d0*32+r32]=__float2bfloat16(o[d0][r]*rli[r]);}
      #pragma unroll
      for(int i=0;i<4;++i){const int row=i*8+(lane>>3),ch=lane&7; const u32x4 v=*(const u32x4*)(stg+row*64+ch*8); *(u32x4*)(Qw+(long)row*PQ+ch*8)=v;} }
  }
  asm volatile("s_waitcnt lgkmcnt(0)\n\ts_barrier":::"memory");
}

constexpr int MEM_K=0, MEM_V=65536;
__device__ __forceinline__ void mem_unit(int b,int h,int qb,const bool prep,const unsigned char*__restrict__ MIMG,const bf16*QM,bf16*OM,char*shm,char*wsbase,char*stgbase,void*tsdbg){
  int tid_=threadIdx.x; asm volatile("":"+v"(tid_));
  const int tid=tid_,lane=tid&63,r32=lane&31,hi=lane>>5; const int wid=__builtin_amdgcn_readfirstlane(tid>>6);
  const lds_cptr shm3=(lds_cptr)shm;
  const lds_fptr wsf=(lds_fptr)((lds_cptr)wsbase)+wid*64;
  constexpr float EPSM=1e-6f;
  if(prep){ const unsigned lds0=(unsigned)(uintptr_t)shm; const unsigned char*src=MIMG+(size_t)(b*4+h)*131072+wid*1024+lane*16;
    #pragma unroll 4
    for(int i=0;i<16;++i) glds16(src+i*8192,(unsigned)__builtin_amdgcn_readfirstlane(lds0+i*8192+wid*1024)); }
  const bf16*Qw=QM+(size_t)(b*SEQ+qb*QB+wid*QBLK+r32)*PQ+h*128+hi*8;
  bf16x8 qr[8]; float qs=0.f;
  #pragma unroll
  for(int d0=0;d0<8;++d0){ qr[d0]=*reinterpret_cast<const bf16x8*>(Qw+16*d0);
    #pragma unroll
    for(int e=0;e<8;++e){ const float f=__uint_as_float(((unsigned)(unsigned short)qr[d0][e])<<16); qs+=f*f; } }
  { auto rr=__builtin_amdgcn_permlane32_swap(__float_as_uint(qs),__float_as_uint(qs),false,false); qs=__uint_as_float(rr[0])+__uint_as_float(rr[1]); }
  const float sc=1.0f/sqrtf(qs*(1.0f/128.0f)+EPSM);
  asm volatile("s_waitcnt vmcnt(0) lgkmcnt(0)\n\ts_barrier":::"memory");
#if defined(TSPROBE)
  if(prep&&threadIdx.x==0) atomicMax((unsigned long long*)tsdbg+19,(unsigned long long)__builtin_amdgcn_s_memrealtime());
#endif
  float m=-1e30f,l=0.f; f32x16 o[4]; o[0]=f32x16{};o[1]=f32x16{};o[2]=f32x16{};o[3]=f32x16{};
  const lds_cptr kp0=shm3+MEM_K+hi*4096+r32*16;
  const lds_cptr vp0=shm3+MEM_V+((lane>>4)&1)*32+(lane&3)*8+(4*hi+((lane&15)>>2))*64;
  #pragma unroll 1
  for(int t=0;t<4;++t){
    f32x16 p0=f32x16{},p1=f32x16{};
    { bf16x8 kf[16];
      #pragma unroll
      for(int d0=0;d0<8;++d0){ kf[2*d0]=*(const __attribute__((address_space(3))) bf16x8*)(kp0+d0*8192+t*1024); kf[2*d0+1]=*(const __attribute__((address_space(3))) bf16x8*)(kp0+d0*8192+t*1024+512); }
      SBAR();
      #pragma unroll
      for(int d0=0;d0<8;++d0){ p0=__builtin_amdgcn_mfma_f32_32x32x16_bf16(kf[2*d0],qr[d0],p0,0,0,0); p1=__builtin_amdgcn_mfma_f32_32x32x16_bf16(kf[2*d0+1],qr[d0],p1,0,0,0); }
      SBAR(); }
    #pragma unroll
    for(int r=0;r<16;++r){p0[r]*=sc;p1[r]*=sc;}
    const float rm=rowmax(p0,p1);
    const bool mv=(t==0)||__any(rm>m+8.0f);
    float alpha=1.0f;
    if(mv){ const float mn=__builtin_fmaxf(m,rm); alpha=__builtin_amdgcn_exp2f(m-mn); m=mn; }
    float rs=0.f;
    #pragma unroll
    for(int r=0;r<16;++r){p0[r]=__builtin_amdgcn_exp2f(p0[r]-m);p1[r]=__builtin_amdgcn_exp2f(p1[r]-m);rs+=p0[r]+p1[r];}
    l=l*alpha+rs;
    if(mv&&t!=0){
      if(hi==0)wsf[r32]=alpha;
      #pragma unroll
      for(int r=0;r<16;++r){ const float a=wsf[crow(r,hi)]; o[0][r]*=a;o[1][r]*=a;o[2][r]*=a;o[3][r]*=a; } }
    u32x4 pw0,pw1,pw2,pw3;
    pw0=(u32x4){cvtpk_s(p0[0],p0[1]),cvtpk_s(p0[2],p0[3]),cvtpk_s(p0[4],p0[5]),cvtpk_s(p0[6],p0[7])};
    pw1=(u32x4){cvtpk_s(p0[8],p0[9]),cvtpk_s(p0[10],p0[11]),cvtpk_s(p0[12],p0[13]),cvtpk_s(p0[14],p0[15])};
    pw2=(u32x4){cvtpk_s(p1[0],p1[1]),cvtpk_s(p1[2],p1[3]),cvtpk_s(p1[4],p1[5]),cvtpk_s(p1[6],p1[7])};
    pw3=(u32x4){cvtpk_s(p1[8],p1[9]),cvtpk_s(p1[10],p1[11]),cvtpk_s(p1[12],p1[13]),cvtpk_s(p1[14],p1[15])};
    const lds_cptr vp=vp0+t*16384;
    s16x4 va[8],vb[8];
    #define MEM_VRD(V,db) do{ _Pragma("unroll") for(int ks=0;ks<4;++ks){ V[2*ks]=vtr(vp+(db)*4096+ks*1024); V[2*ks+1]=vtr(vp+(db)*4096+ks*1024+512); } }while(0)
    #define MEM_VF(V,ks) (bf16x8){V[2*(ks)][0],V[2*(ks)][1],V[2*(ks)][2],V[2*(ks)][3],V[2*(ks)+1][0],V[2*(ks)+1][1],V[2*(ks)+1][2],V[2*(ks)+1][3]}
    #define MEM_PV(V,db) do{ o[db]=__builtin_amdgcn_mfma_f32_32x32x16_bf16(__builtin_bit_cast(bf16x8,pw0),MEM_VF(V,0),o[db],0,0,0); o[db]=__builtin_amdgcn_mfma_f32_32x32x16_bf16(__builtin_bit_cast(bf16x8,pw1),MEM_VF(V,1),o[db],0,0,0); \
        o[db]=__builtin_amdgcn_mfma_f32_32x32x16_bf16(__builtin_bit_cast(bf16x8,pw2),MEM_VF(V,2),o[db],0,0,0); o[db]=__builtin_amdgcn_mfma_f32_32x32x16_bf16(__builtin_bit_cast(bf16x8,pw3),MEM_VF(V,3),o[db],0,0,0); }while(0)
    MEM_VRD(va,0); SBAR();
    MEM_VRD(vb,1); MEM_PV(va,0); SBAR();
    MEM_VRD(va,2); MEM_PV(vb,1); SBAR();
    MEM_VRD(vb,3); MEM_PV(va,2); SBAR();
    MEM_PV(vb,3); SBAR();
    #undef MEM_VRD
    #undef MEM_VF
    #undef MEM_PV
  }
  { auto rr=__builtin_amdgcn_permlane32_swap(__float_as_uint(l),__float_as_uint(l),false,false); l=__uint_as_float(rr[0])+__uint_as_float(rr[1]); }
  if(hi==0)wsf[32+r32]=l;
  bf16*Ow=OM+(size_t)(b*SEQ+qb*QB+wid*QBLK)*PQ+h*128;
  { bf16*stg=(bf16*)stgbase+wid*1024;
    #pragma unroll
    for(int g=0;g<4;++g){
      #pragma unroll
      for(int j=0;j<4;++j){ const int r=4*g+j; const float rl=__builtin_amdgcn_rcpf(wsf[32+crow(r,hi)]);
        #pragma unroll
        for(int db=0;db<4;++db) stg[(4*hi+j)*128+32*db+r32]=__float2bfloat16(o[db][r]*rl); }
      #pragma unroll
      for(int i=0;i<2;++i){ const int row=i*4+(lane>>4),ch=lane&15; const u32x4 v=*(const u32x4*)(stg+row*128+ch*8); *(u32x4*)(Ow+(size_t)(8*g+row)*PQ+ch*8)=v; } } }
  __syncthreads();
}
#undef SBAR
#undef WAIT_BAR
#undef MX3
}

constexpr int NWAVES = 8;
constexpr int SEQ = 4096, NBATCH = 8, MTOK = NBATCH * SEQ, MMEM = NBATCH * 256;
constexpr int NIN_ARGS = 23;
enum InIdx { I_X = 0, I_MEM, I_GMIX, I_WIN, I_BGATE, I_BFORGET, I_QNSWA, I_KNSWA, I_SINK, I_RELBIAS, I_QNFOX, I_KNFOX, I_GMEM, I_WMEMKV, I_QNMEM, I_KNMEM, I_WOSWA, I_WOFOX, I_WOMEM, I_WOUT, I_GMLP, I_WUP, I_WDN };
constexpr size_t MiB = 1u << 20;
#if defined(TSPROBE) || (defined(DETPROBE) && DETPROBE)
constexpr size_t WS_CTL = 0, CTL_ZERO_BYTES = 128 * 1024;
#else
constexpr size_t WS_CTL = 0, CTL_ZERO_BYTES = 32 * 1024;
#endif
constexpr size_t WS_WIN = 2 * MiB, WS_WKV = 14 * MiB, WS_WO = 16 * MiB, WS_WOUT = 19 * MiB, WS_WUP = 25 * MiB, WS_WD = 33 * MiB;
constexpr size_t WS_LOGF = 41 * MiB, WS_G2 = 42 * MiB, WS_SSQ = 43 * MiB, WS_MEMN = 45 * MiB, WS_MKV = 49 * MiB, WS_RINV = 57 * MiB;
constexpr size_t WS_MRG = 160 * MiB;
constexpr size_t WS_GT = 64 * MiB;
constexpr size_t WS_H = 256 * MiB;
constexpr size_t WS_U = 64 * MiB;
constexpr size_t WS_QCAT = 320 * MiB, WS_KA = 416 * MiB, WS_VA = 424 * MiB, WS_KF = 432 * MiB, WS_VF = 464 * MiB;
constexpr size_t WS_X1B = 320 * MiB;
constexpr size_t WS_END = 496 * MiB;
constexpr int CW_FOXQ = 2048;
constexpr int CW_BAR = 4096;
constexpr int RING_OFF = 0, RING_BYTES = 131072;
constexpr int ATT_EXTRA_OFF = RING_BYTES;
constexpr int LDSCTL_OFF = 159744, MISC_OFF = LDSCTL_OFF + 320, MEMWS_OFF = LDSCTL_OFF + 1024, DUMP_OFF = LDSCTL_OFF + 3072;
constexpr int LDS_BYTES = 163840;
static_assert((CW_BAR + 3456) * 4 <= (int)CTL_ZERO_BYTES && DUMP_OFF + 256 <= LDS_BYTES && pg8::STAGE_BYTES == RING_BYTES && MEMWS_OFF + 2048 <= DUMP_OFF && attn_body::LDS_BYTES <= RING_BYTES && attn_body::SWA_LDS_BYTES + 2048 + 32768 <= LDSCTL_OFF && ATT_EXTRA_OFF + 92 * 64 * 4 + 4096 <= LDSCTL_OFF, "LDS map");
#define GAS __attribute__((address_space(1)))
#define LAS __attribute__((address_space(3)))
typedef unsigned short bf16;
typedef unsigned v4u __attribute__((ext_vector_type(4)));
typedef float f32x4 __attribute__((ext_vector_type(4)));
typedef short bf16x8 __attribute__((ext_vector_type(8)));
typedef GAS unsigned gu32;
typedef GAS unsigned long long gu64;
#define RLX_AGENT __ATOMIC_RELAXED, __HIP_MEMORY_SCOPE_AGENT
#define LDS_WAIT() asm volatile("s_waitcnt lgkmcnt(0)" ::: "memory")
#define VM_WAIT() asm volatile("s_waitcnt vmcnt(0)" ::: "memory")
__device__ __forceinline__ unsigned long long rt() { return __builtin_amdgcn_s_memrealtime(); }
__device__ __forceinline__ unsigned f2bf(float f) { unsigned u = __builtin_bit_cast(unsigned, f); return (u + 0x7fffu + ((u >> 16) & 1u)) >> 16; }
__device__ __forceinline__ unsigned pk2(float lo, float hi) { return f2bf(lo) | (f2bf(hi) << 16); }

#define XB_TMO      128
#define XB_XCNT(j)  (256  + 64 * (j))
#define XB_XSUB(j)  (1280 + 64 * (j))
#define XB_XGEN(j)  (2304 + 64 * (j))
#define XB_TOP      3328
#define XB_TOPGEN   3392
#define XCD_BAR_WORDS 3456
#define XB_SPIN_CAP (1u << 18)

__device__ __forceinline__ unsigned xb_ld(unsigned* p)              { return __hip_atomic_load(p, __ATOMIC_RELAXED, __HIP_MEMORY_SCOPE_AGENT); }
__device__ __forceinline__ unsigned xb_add(unsigned* p, unsigned v) { return __hip_atomic_fetch_add(p, v, __ATOMIC_RELAXED, __HIP_MEMORY_SCOPE_AGENT); }
__device__ __forceinline__ unsigned xb_xcc_id() { return (unsigned)__builtin_amdgcn_s_getreg((3 << 11) | 20) & 0xFu; }
#define XB_SPIN(cond, bar) do { unsigned _sp = 0; while (cond) { __builtin_amdgcn_s_sleep(1); \
    if ((++_sp & 255u) == 0u) { if (xb_ld(&(bar)[XB_TMO])) break; if (_sp > XB_SPIN_CAP) { atomicAdd(&(bar)[XB_TMO], 1u); break; } } } } while (0)

struct XcdBarrier {
    unsigned* bar; unsigned x;
    volatile LAS unsigned* st;
};

__device__ __forceinline__ XcdBarrier xcd_barrier_post(unsigned* bar, volatile LAS unsigned* st) {
    XcdBarrier b; b.bar = bar; b.x = xb_xcc_id(); b.st = st;
    if (threadIdx.x == 0) (void)xb_add(&bar[XB_XCNT(b.x)], 1u);
    return b;
}
__device__ __forceinline__ void xcd_barrier_complete(unsigned* bar, unsigned x, unsigned& nloc, unsigned& nx) {
    const unsigned G = gridDim.x * gridDim.y * gridDim.z;
    unsigned sum, cnt, mine, sp = 0u;
    for (;;) {
        sum = 0u; cnt = 0u; mine = 0u;
#pragma unroll
        for (unsigned j = 0; j < 16; ++j) { const unsigned c = xb_ld(&bar[XB_XCNT(j)]); sum += c; cnt += (c > 0u) ? 1u : 0u; mine = (j == x) ? c : mine; }
        if (sum == G) break;
        __builtin_amdgcn_s_sleep(1);
        if ((++sp & 255u) == 0u) { if (xb_ld(&bar[XB_TMO])) break; if (sp > XB_SPIN_CAP) { atomicAdd(&bar[XB_TMO], 1u); break; } }
    }
    nloc = mine > 0u ? mine : 1u; nx = cnt > 0u ? cnt : 1u;
}

__device__ __forceinline__ void xcd_barrier(const XcdBarrier& b) {
    asm volatile("s_waitcnt vmcnt(0)" ::: "memory");
    __syncthreads();
    if (threadIdx.x == 0) {
        unsigned* bar = b.bar;
        __builtin_amdgcn_s_waitcnt(0);
        unsigned nloc = b.st[0], nx = b.st[1];
        if (nloc == 0u) { xcd_barrier_complete(bar, b.x, nloc, nx); b.st[0] = nloc; b.st[1] = nx; }
        const unsigned old = xb_add(&bar[XB_XSUB(b.x)], 1u);
        const unsigned gen = old / nloc;
        if (old + 1u == (gen + 1u) * nloc) {
            __builtin_amdgcn_fence(__ATOMIC_RELEASE, "agent");
            asm volatile("s_waitcnt vmcnt(0)" ::: "memory");
            const unsigned og = xb_add(&bar[XB_TOP], 1u);
            const unsigned tg = og / nx;
            if (og + 1u == (tg + 1u) * nx) xb_add(&bar[XB_TOPGEN], 1u);
            else XB_SPIN(xb_ld(&bar[XB_TOPGEN]) == tg, bar);
            __builtin_amdgcn_fence(__ATOMIC_ACQUIRE, "agent");
            xb_add(&bar[XB_XGEN(b.x)], 1u);
            asm volatile("s_waitcnt vmcnt(0)" ::: "memory");
        } else {
            XB_SPIN(xb_ld(&bar[XB_XGEN(b.x)]) == gen, bar);
            __builtin_amdgcn_fence(__ATOMIC_ACQUIRE, "agent");
            asm volatile("s_waitcnt vmcnt(0)" ::: "memory");
        }
    }
    __syncthreads();
}

#if defined(DETPROBE) && DETPROBE
constexpr size_t WS_CHK = 57 * MiB;
__global__ void chk_sum(const unsigned* p, size_t nwords, unsigned long long* dst) {
    unsigned long long s = 0; const size_t stride = (size_t)gridDim.x * blockDim.x;
    for (size_t i = (size_t)blockIdx.x * blockDim.x + threadIdx.x; i < nwords; i += stride) s += (unsigned long long)p[i] * (unsigned long long)((i & 1023) + 1);
#pragma unroll
    for (int o = 32; o > 0; o >>= 1) s += __shfl_xor(s, o);
    if ((threadIdx.x & 63) == 0) atomicAdd(dst, s);
}
__global__ void chk_report(const unsigned long long* chk, float* out, int nslots, size_t n) {
    float mk = 0.f; for (int s = 0; s < nslots; ++s) if (chk[s] != chk[64 + s]) { mk = 1000.0f * (float)(s + 1); break; }
    const size_t stride = (size_t)gridDim.x * blockDim.x;
    for (size_t i = (size_t)blockIdx.x * blockDim.x + threadIdx.x; i < n; i += stride) out[i] = (i == 0) ? mk : 0.f;
}
#endif


struct Frame {
    LAS unsigned char* lds;
    volatile LAS unsigned* MISC;
    gu32* ctl;
    int tid, lane, wave;
    int vcu, G;
    const float *x, *mem, *w_in, *w_mem_kv, *w_o_swa, *w_o_fox, *w_o_mem, *w_out, *w_up, *w_dn, *g_mix, *g_mlp, *g_mem, *b_forget;
    float* out; unsigned char* ws;
};

__device__ __forceinline__ float wave_sum(float v) {
#pragma unroll
    for (int o = 1; o < 64; o <<= 1) v += __shfl_xor(v, o);
    return v;
}
typedef float f32x2_t __attribute__((ext_vector_type(2))); typedef __bf16 bf16x2_t __attribute__((ext_vector_type(2)));
__device__ __forceinline__ unsigned pkc(float lo, float hi) { f32x2_t v = {lo, hi}; bf16x2_t b = __builtin_convertvector(v, bf16x2_t); return __builtin_bit_cast(unsigned, b); }
__device__ __forceinline__ void p0_tr_item(const float* __restrict__ W, int ldw, int k0, int n0, bf16* WT, int ldt, int drow_lane, int dk0, const float* __restrict__ kscale, int lane) {
    const int c4 = lane & 7, kg = lane >> 3;
    const float* src = W + (size_t)(k0 + 8 * kg) * ldw + n0 + 4 * c4;
    f32x4 r[8];
#pragma unroll
    for (int i = 0; i < 8; ++i) r[i] = *(const GAS f32x4*)(src + (size_t)i * ldw);
    if (kscale) { const f32x4 s0 = *(const GAS f32x4*)(kscale + k0 + 8 * kg), s1 = *(const GAS f32x4*)(kscale + k0 + 8 * kg + 4);
#pragma unroll
        for (int i = 0; i < 4; ++i) { r[i] = r[i] * s0[i]; r[4 + i] = r[4 + i] * s1[i]; } }
    bf16* dst = WT + (size_t)drow_lane * ldt + dk0 + k0 + 8 * kg;
#pragma unroll
    for (int e = 0; e < 4; ++e) { v4u o; o.x = pkc(r[0][e], r[1][e]); o.y = pkc(r[2][e], r[3][e]); o.z = pkc(r[4][e], r[5][e]); o.w = pkc(r[6][e], r[7][e]); *(GAS v4u*)(dst + (size_t)e * ldt) = o; }
}
__device__ __forceinline__ int in_srcbase(int g) {
    return g < 8 ? 64 * g : g < 10 ? 512 + 64 * (g - 8) : g < 12 ? 640 + 64 * (g - 10) : g < 20 ? 768 + 64 * (g - 12) : g < 28 ? 1280 + 64 * (g - 20) : g < 36 ? 1792 + 64 * (g - 28) : g < 44 ? 2312 + 64 * (g - 36) : 2824 + 64 * (g - 44);
}
__device__ __forceinline__ float rms_row_to_bf16(const f32x4 (&v)[4], const f32x4 (&gn)[4], bf16* orow, int lane, f32x4 (&vg)[4], float* rinv) {
    float s = 0.f;
#pragma unroll
    for (int j = 0; j < 4; ++j) s += (v[j].x * v[j].x + v[j].y * v[j].y) + (v[j].z * v[j].z + v[j].w * v[j].w);
    const float rt2 = sqrtf(wave_sum(s) * (1.f / 1024.f) + 1e-6f); const float r = 1.f / rt2;
    if (rinv && lane == 0) *rinv = rt2;
    GAS unsigned long long* o8 = (GAS unsigned long long*)orow + lane;
#pragma unroll
    for (int j = 0; j < 4; ++j) { vg[j] = v[j] * gn[j]; const f32x4 y = vg[j] * r; o8[64 * j] = (unsigned long long)pkc(y.x, y.y) | ((unsigned long long)pkc(y.z, y.w) << 32); }
    return r;
}
__device__ __forceinline__ int adj_row(int n) { return 128 * ((n >> 3) & 1) + 32 * (n >> 6) + 8 * ((n & 63) >> 4) + (n & 7); }
constexpr int I_IN = 16 * 184, I_KV = 16 * 32, I_O1 = 8 * 32, I_OUT = 16 * 32, I_UP = 16 * 128, I_DN = 64 * 32;
constexpr int I_EARLY = I_IN + I_KV, NITEMS = I_IN + I_KV + 3 * I_O1 + I_OUT + I_UP + I_DN;
__device__ __forceinline__ void weight_items(Frame& F, int lo, int hi, int widx, int nw) {
    bf16* Win_t = (bf16*)(F.ws + WS_WIN); bf16* Wkv_t = (bf16*)(F.ws + WS_WKV); bf16* Wo_t = (bf16*)(F.ws + WS_WO); bf16* Wout_t = (bf16*)(F.ws + WS_WOUT); bf16* Wup_t = (bf16*)(F.ws + WS_WUP); bf16* Wd_t = (bf16*)(F.ws + WS_WD);
    const int c4 = F.lane & 7;
    for (int it = lo + widx; it < hi; it += nw) {
        int r = it;
        if (r < I_IN) { const int kb = r / 184, gg = r % 184, g = gg >> 1, bj = gg & 1;
            const int drow = 256 * (g >> 2) + ((g >= 44) ? adj_row(64 * (g & 3) + 32 * bj + 4 * c4) : 128 * bj + 32 * (g & 3) + 4 * c4);
            p0_tr_item(F.w_in, 5896, 64 * kb, in_srcbase(g) + 32 * bj, Win_t, 1024, drow, 0, nullptr, F.lane); continue; } r -= I_IN;
        if (r < I_KV) { p0_tr_item(F.w_mem_kv, 1024, 64 * (r / 32), 32 * (r % 32), Wkv_t, 1024, 32 * (r % 32) + 4 * c4, 0, nullptr, F.lane); continue; } r -= I_KV;
        if (r < I_O1) { p0_tr_item(F.w_o_swa, 1024, 64 * (r / 32), 32 * (r % 32), Wo_t, 1536, 256 * ((r % 32) >> 3) + adj_row(32 * ((r % 32) & 7) + 4 * c4), 0, nullptr, F.lane); continue; } r -= I_O1;
        if (r < I_O1) { p0_tr_item(F.w_o_fox, 1024, 64 * (r / 32), 32 * (r % 32), Wo_t, 1536, 256 * ((r % 32) >> 3) + adj_row(32 * ((r % 32) & 7) + 4 * c4), 512, nullptr, F.lane); continue; } r -= I_O1;
        if (r < I_O1) { p0_tr_item(F.w_o_mem, 1024, 64 * (r / 32), 32 * (r % 32), Wo_t, 1536, 256 * ((r % 32) >> 3) + adj_row(32 * ((r % 32) & 7) + 4 * c4), 1024, nullptr, F.lane); continue; } r -= I_O1;
        if (r < I_OUT) { p0_tr_item(F.w_out, 1024, 64 * (r / 32), 32 * (r % 32), Wout_t, 1024, 32 * (r % 32) + 4 * c4, 0, nullptr, F.lane); continue; } r -= I_OUT;
        if (r < I_UP) { p0_tr_item(F.w_up, 4096, 64 * (r / 128), 32 * (r % 128), Wup_t, 1024, 32 * (r % 128) + 4 * c4, 0, F.g_mlp, F.lane); continue; } r -= I_UP;
        p0_tr_item(F.w_dn, 1024, 64 * (r / 32), 32 * (r % 32), Wd_t, 4096, 32 * (r % 32) + 4 * c4, 0, nullptr, F.lane);
    }
}
__device__ __forceinline__ void p0_prologue(Frame& F) {
    const float* x = F.x; const float* mem = F.mem; const float* w_in = F.w_in;
    const int gw = F.vcu * NWAVES + F.wave, NGW = F.G * NWAVES;
    weight_items(F, 0, (F.G == 256) ? I_EARLY : NITEMS, gw, NGW);
#if defined(TSPROBE)
    if (threadIdx.x == 0) atomicMax((unsigned long long*)(F.ws + 65536) + 8, rt());
#endif
    {
        bf16* H = (bf16*)(F.ws + WS_H); float* LOGF = (float*)(F.ws + WS_LOGF); float* RINV = (float*)(F.ws + WS_RINV);
        f32x4 gn[4];
#pragma unroll
        for (int j = 0; j < 4; ++j) gn[j] = ((const GAS f32x4*)F.g_mix)[F.lane + 64 * j];
        f32x4 wf[4][4][2];
#pragma unroll
        for (int j = 0; j < 4; ++j)
#pragma unroll
            for (int e = 0; e < 4; ++e) { const GAS f32x4* wp = (const GAS f32x4*)(w_in + (size_t)(4 * F.lane + 256 * j + e) * 5896 + 2304); wf[j][e][0] = wp[0]; wf[j][e][1] = wp[1]; }
        const f32x4 bf0 = ((const GAS f32x4*)F.b_forget)[0], bf1 = ((const GAS f32x4*)F.b_forget)[1];
#define P0_ROW(m_, v_) do { f32x4 vg[4]; const float r = rms_row_to_bf16(v_, gn, H + (size_t)(m_) * 1024, F.lane, vg, RINV + (m_)); \
            f32x4 p0 = (f32x4){0.f, 0.f, 0.f, 0.f}, p1 = p0; \
            _Pragma("unroll") for (int j = 0; j < 4; ++j) _Pragma("unroll") for (int e = 0; e < 4; ++e) { p0 += wf[j][e][0] * vg[j][e]; p1 += wf[j][e][1] * vg[j][e]; } \
            _Pragma("unroll") for (int cidx = 0; cidx < 4; ++cidx) { p0[cidx] = wave_sum(p0[cidx]); p1[cidx] = wave_sum(p1[cidx]); } \
            f32x4 z0 = p0 * r + bf0, z1 = p1 * r + bf1; \
            _Pragma("unroll") for (int cidx = 0; cidx < 4; ++cidx) { z0[cidx] = fminf(z0[cidx], 0.f) - log1pf(expf(-fabsf(z0[cidx]))); z1[cidx] = fminf(z1[cidx], 0.f) - log1pf(expf(-fabsf(z1[cidx]))); } \
            if (F.lane == 0) { GAS f32x4* lp = (GAS f32x4*)(LOGF + (size_t)(m_) * 8); lp[0] = z0; lp[1] = z1; } } while (0)
        for (int m = gw; m < MTOK; m += 2 * NGW) {
            const int m2 = m + NGW; const bool two = m2 < MTOK;
            f32x4 va[4], vb[4];
#pragma unroll
            for (int j = 0; j < 4; ++j) { va[j] = ((const GAS f32x4*)(x + (size_t)m * 1024))[F.lane + 64 * j]; vb[j] = ((const GAS f32x4*)(x + (size_t)(two ? m2 : m) * 1024))[F.lane + 64 * j]; }
            P0_ROW(m, va);
            if (two) P0_ROW(m2, vb);
        }
#undef P0_ROW
    }
#if defined(TSPROBE)
    if (threadIdx.x == 0) atomicMax((unsigned long long*)(F.ws + 65536) + 9, rt());
#endif
    {
        bf16* MEMN = (bf16*)(F.ws + WS_MEMN);
        f32x4 gn[4];
#pragma unroll
        for (int j = 0; j < 4; ++j) gn[j] = ((const GAS f32x4*)F.g_mem)[F.lane + 64 * j];
        for (int m = gw; m < MMEM; m += NGW) { f32x4 v[4], vg[4];
#pragma unroll
            for (int j = 0; j < 4; ++j) v[j] = ((const GAS f32x4*)(mem + (size_t)m * 1024))[F.lane + 64 * j];
            (void)rms_row_to_bf16(v, gn, MEMN + (size_t)m * 1024, F.lane, vg, nullptr); }
    }
}
__device__ __forceinline__ void p1_scan(Frame& F) {
    if (F.vcu >= 64) return;
    const int seq = F.vcu;
    const float* LOGF = (const float*)(F.ws + WS_LOGF); float* G2 = (float*)(F.ws + WS_G2);
    const int b = seq >> 3, h = seq & 7, s0 = 8 * F.tid;
    float a[8]; float run = 0.f;
#pragma unroll
    for (int i = 0; i < 8; ++i) { run += LOGF[((size_t)(b * SEQ + s0 + i)) * 8 + h]; a[i] = run; }
    float sc = run;
#pragma unroll
    for (int o = 1; o < 64; o <<= 1) { const float y = __shfl_up(sc, o); if (F.lane >= o) sc += y; }
    volatile LAS float* wt = (volatile LAS float*)(F.MISC + 16);
    if (F.lane == 63) wt[F.wave] = sc;
    __syncthreads();
    float woff = 0.f;
#pragma unroll
    for (int w = 0; w < NWAVES; ++w) woff += (w < F.wave) ? wt[w] : 0.f;
    const float off = woff + (sc - run);
    f32x4 o0, o1;
#pragma unroll
    for (int i = 0; i < 4; ++i) { o0[i] = -(a[i] + off) * 1.4426950408889634f; o1[i] = -(a[4 + i] + off) * 1.4426950408889634f; }
    GAS f32x4* gp = (GAS f32x4*)(G2 + (size_t)seq * SEQ + s0); gp[0] = o0; gp[1] = o1;
    __syncthreads();
}

struct Args { const float* in[NIN_ARGS]; float* out; unsigned char* ws; int ph_lo, ph_hi; };
__global__ void __launch_bounds__(NWAVES * 64, 2) mega_fwd(Args args) {
    extern __shared__ __attribute__((aligned(16))) unsigned char lds[];
    Frame F;
    F.lds = (LAS unsigned char*)lds;
    F.MISC = (volatile LAS unsigned*)(F.lds + MISC_OFF);
    F.tid = threadIdx.x; F.lane = F.tid & 63; F.wave = __builtin_amdgcn_readfirstlane(F.tid >> 6);
    F.G = gridDim.x; { const int bx = blockIdx.x; F.vcu = (F.G % 8 == 0) ? (bx % 8) * (F.G / 8) + bx / 8 : bx; }
    unsigned char* ws = args.ws; F.ws = ws; F.out = args.out;
    F.x = args.in[I_X]; F.mem = args.in[I_MEM]; F.w_in = args.in[I_WIN]; F.w_mem_kv = args.in[I_WMEMKV]; F.w_o_swa = args.in[I_WOSWA]; F.w_o_fox = args.in[I_WOFOX]; F.w_o_mem = args.in[I_WOMEM];
    F.w_out = args.in[I_WOUT]; F.w_up = args.in[I_WUP]; F.w_dn = args.in[I_WDN]; F.g_mix = args.in[I_GMIX]; F.g_mlp = args.in[I_GMLP]; F.g_mem = args.in[I_GMEM]; F.b_forget = args.in[I_BFORGET];
    F.ctl = (gu32*)(ws + WS_CTL);
    for (int u = F.tid; u < (LDS_BYTES - LDSCTL_OFF) / 4; u += NWAVES * 64) ((LAS unsigned*)(F.lds + LDSCTL_OFF))[u] = 0u;
    __syncthreads();
    const int lo = args.ph_lo, hi = args.ph_hi;
    const bool use_bar = (hi - lo) > 1;
    XcdBarrier bar; bar.bar = (unsigned*)(F.ctl + CW_BAR); bar.x = 0; bar.st = nullptr;
    if (use_bar) bar = xcd_barrier_post((unsigned*)(F.ctl + CW_BAR), F.MISC + 8);
#if defined(TSPROBE)
#define STAMP(k) do { if (blockIdx.x == 0 && threadIdx.x == 0) { ((unsigned long long*)(args.ws + 65536))[k] = rt(); ((unsigned long long*)(args.ws + 65536))[32 + (k)] = __builtin_amdgcn_s_memtime(); } } while (0)
#else
#define STAMP(k) do {} while (0)
#endif
    STAMP(0);
#define IN(k) (lo <= (k) && (k) < hi)
#define BOTH(k) (IN(k) && IN((k) + 1))
#define GRID_BAR() xcd_barrier(bar)

    bf16* Win_t = (bf16*)(ws + WS_WIN); bf16* Wkv_t = (bf16*)(ws + WS_WKV); bf16* Wo_t = (bf16*)(ws + WS_WO); bf16* Wout_t = (bf16*)(ws + WS_WOUT); bf16* Wup_t = (bf16*)(ws + WS_WUP); bf16* Wd_t = (bf16*)(ws + WS_WD);
    bf16* H = (bf16*)(ws + WS_H); bf16* GT = (bf16*)(ws + WS_GT); bf16* U = (bf16*)(ws + WS_U); bf16* X1B = (bf16*)(ws + WS_X1B); bf16* MEMN = (bf16*)(ws + WS_MEMN);
    bf16* QCAT = (bf16*)(ws + WS_QCAT); bf16* QA = QCAT; bf16* QF = QCAT + 512; bf16* QM = QCAT + 1024; bf16* MRG = (bf16*)(ws + WS_MRG);
    bf16* KA = (bf16*)(ws + WS_KA); bf16* VA = (bf16*)(ws + WS_VA); bf16* KF = (bf16*)(ws + WS_KF); bf16* VF = (bf16*)(ws + WS_VF);
    unsigned char* MIMG = ws + WS_MKV; float* SSQ = (float*)(ws + WS_SSQ); float* G2 = (float*)(ws + WS_G2);

    if (IN(0)) { p0_prologue(F); if (BOTH(0)) GRID_BAR(); STAMP(1); }

    if (IN(1)) {
        p1_scan(F);
        pg8::Sched S; S.init(MTOK, 5888, 1024, F.G, (int)blockIdx.x, H, Win_t); S.tsbase = (void*)(ws + 65536);
        { LAS float* tab = (LAS float*)(F.lds + ATT_EXTRA_OFF);
          for (int i = F.tid; i < 92 * 64; i += NWAVES * 64) { const int g = i >> 6, c = i & 63; float v = 0.f;
              if (g < 8) v = args.in[I_QNSWA][c] * pg8::kC2_64; else if (g < 10) v = args.in[I_KNSWA][c]; else if (g >= 12 && g < 20) v = args.in[I_QNFOX][c] * pg8::kC2_64; else if (g >= 20 && g < 28) v = args.in[I_KNFOX][c];
              else if (g == 28 || g == 29) v = args.in[I_KNMEM][i - 28 * 64] * args.in[I_QNMEM][i - 28 * 64] * (0.08838834764831845f * 1.4426950408889634f);
              else if (g >= 44) v = args.in[I_BGATE][i - 44 * 64];
              tab[i] = v; }
          __syncthreads(); }
        pg8::EpiInProj E{QA, KA, VA, QF, KF, VF, QM, (unsigned char*)GT, (LAS const float*)(F.lds + ATT_EXTRA_OFF)};
        pg8::gemm_phase<pg8::EpiInProj, pg8::Sched, true, true>(F.lds + RING_OFF, 1024, S, E);
        { pg8::Sched S2; S2.init(MMEM, 1024, 1024, F.G, (blockIdx.x >= 128) ? (int)blockIdx.x - 128 : (1 << 20), MEMN, Wkv_t); S2.tsbase = (void*)(ws + 65536);
          if (F.G <= 128) S2.c = (int)blockIdx.x;
          pg8::EpiMemKV E2{MIMG, (LAS const float*)(F.lds + ATT_EXTRA_OFF), (LAS float*)(F.lds + ATT_EXTRA_OFF + 92 * 64 * 4)};
          pg8::gemm_phase<pg8::EpiMemKV, pg8::Sched, true, true>(F.lds + RING_OFF, 1024, S2, E2); }
        if (F.G == 256 && blockIdx.x >= 160) weight_items(F, I_EARLY, NITEMS, ((int)blockIdx.x - 160) * NWAVES + F.wave, 96 * NWAVES);
        if (BOTH(1)) GRID_BAR();
        STAMP(2);
    }

    if (IN(2)) {
        using ab = attn_body::bf16;
        char* shm = (char*)lds + RING_OFF;
        float fox_margin;
        { const float gq = fabsf(args.in[I_QNFOX][F.lane]), gk = fabsf(args.in[I_KNFOX][F.lane]); float mq = gq, mk = gk;
#pragma unroll
          for (int o = 1; o < 64; o <<= 1) { mq = fmaxf(mq, __shfl_xor(mq, o)); mk = fmaxf(mk, __shfl_xor(mk, o)); }
          fox_margin = 2.0f * (8.0f * mq * mk * 1.4426950408889634f * 1.02f) + 40.0f; }
        for (;;) {
            if (F.tid == 0) F.MISC[24] = atomicAdd((unsigned*)(F.ctl + CW_FOXQ), 1u);
            __syncthreads();
            const int id = (int)F.MISC[24];
            __syncthreads();
            if (id >= 1024) break;
            const int bh = id & 63, qb = 15 - (id >> 6);
            const int b = bh >> 3, h = bh & 7; const size_t rb = (size_t)b * SEQ; const float* g2 = G2 + (size_t)bh * SEQ; const int NT = 4 * qb + 4;
            const float thr = g2[qb * 256] - fox_margin;
            const bool far = (F.lane < NT - 4) && (g2[64 * F.lane + 63] <= thr);
            const int t0 = __builtin_amdgcn_readfirstlane(__popcll(__ballot(far))) & ~1;
            attn_body::attn_unit<0, 512, 8>((const ab*)QF + (rb + qb * 256) * 1536 + h * 64, (const ab*)KF + (rb + 64 * t0) * 512 + h * 64, (const ab*)VF + (rb + 64 * t0) * 512 + h * 64, (ab*)QF + (rb + qb * 256) * 1536 + h * 64,
                                              NT - t0, qb * 256 - 64 * t0, 0, 0.f, g2 + 64 * t0, nullptr, shm); }
#if defined(TSPROBE)
        if (threadIdx.x == 0) { atomicMax((unsigned long long*)(ws + 65536) + 10, rt()); atomicMin((unsigned long long*)(ws + 65536) + 13, rt() ^ 0xffffffffffffffffull); }
#endif
        for (int id = F.vcu; id < 256; id += F.G)
            attn_body::swa_unit(id >> 5, (id >> 4) & 1, id & 15, (ab*)QA, (const ab*)KA, (const ab*)VA, args.in[I_SINK], args.in[I_RELBIAS], shm);
#if defined(TSPROBE)
        if (threadIdx.x == 0) atomicMax((unsigned long long*)(ws + 65536) + 11, rt());
#endif
        for (int i = 0, prev_bh = -1;; ++i) { const int id = (F.G == 256) ? F.vcu * 2 + i : i * F.G + F.vcu; if (id >= 512 || (F.G == 256 && i >= 2)) break;
            const bool prep = (id >> 4) != prev_bh; prev_bh = id >> 4;
            attn_body::mem_unit(id >> 6, (id >> 4) & 3, id & 15, prep, MIMG, (const ab*)QM, (ab*)QM, shm, (char*)lds + MEMWS_OFF, (char*)lds + ATT_EXTRA_OFF, (void*)(ws + 65536)); }
#if defined(TSPROBE)
        if (threadIdx.x == 0) atomicMax((unsigned long long*)(ws + 65536) + 12, rt());
#endif
        if (BOTH(2)) GRID_BAR();
        STAMP(3);
    }

    if (IN(3)) {
        pg8::Sched S; S.init(MTOK, 1024, 1536, F.G, (int)blockIdx.x, QCAT, Wo_t); S.tsbase = (void*)(ws + 65536);
        pg8::EpiMerge E{(const unsigned char*)GT, MRG, (void*)(ws + 65536)};
        pg8::gemm_phase<pg8::EpiMerge, pg8::Sched, true, true>(F.lds + RING_OFF, 1536, S, E);
        if (BOTH(3)) GRID_BAR();
        STAMP(4);
    }

    if (IN(4)) {
        pg8::Sched S; S.init(MTOK, 1024, 1024, F.G, (int)blockIdx.x, MRG, Wout_t); S.tsbase = (void*)(ws + 65536);
        { LAS float* tab = (LAS float*)(F.lds + ATT_EXTRA_OFF); for (int i = F.tid; i < 1024; i += NWAVES * 64) tab[i] = 1.0f / F.g_mix[i]; __syncthreads(); }
        pg8::EpiOutProj E{H, (const float*)(ws + WS_RINV), (LAS const float*)(F.lds + ATT_EXTRA_OFF), X1B, SSQ};
        pg8::gemm_phase<pg8::EpiOutProj, pg8::Sched, true, true>(F.lds + RING_OFF, 1024, S, E);
        if (BOTH(4)) GRID_BAR();
        STAMP(5);
    }

    if (IN(5)) {
        pg8::Sched S; S.init(MTOK, 4096, 1024, F.G, (int)blockIdx.x, X1B, Wup_t); S.tsbase = (void*)(ws + 65536);
#if defined(EXPER_NOSTORE)
        { pg8::EpiUpT<true> E0{SSQ, U, (PG8_LAS float*)(F.lds + ATT_EXTRA_OFF)}; pg8::gemm_phase<pg8::EpiUpT<true>, pg8::Sched, true, true>(F.lds + RING_OFF, 1024, S, E0); GRID_BAR(); STAMP(18); }
#endif
#if defined(EXPER_VARIANT)
        { pg8::EpiUp E0{SSQ, U, (PG8_LAS float*)(F.lds + ATT_EXTRA_OFF)}; pg8::gemm_phase<pg8::EpiUp, pg8::Sched, EXPER_ALIGN, EXPER_SP2>(F.lds + RING_OFF, 1024, S, E0); GRID_BAR(); STAMP(18); }
#endif
        pg8::EpiUp E{SSQ, U, (PG8_LAS float*)(F.lds + ATT_EXTRA_OFF)};
        pg8::gemm_phase<pg8::EpiUp, pg8::Sched, true, true>(F.lds + RING_OFF, 1024, S, E);
        if (BOTH(5)) GRID_BAR();
        STAMP(6);
    }

    if (IN(6)) {
        pg8::Sched S; S.init(MTOK, 1024, 4096, F.G, (int)blockIdx.x, U, Wd_t); S.tsbase = (void*)(ws + 65536);
        pg8::EpiDown E{X1B, F.out};
        pg8::gemm_phase<pg8::EpiDown, pg8::Sched, true, true>(F.lds + RING_OFF, 4096, S, E);
        STAMP(7);
    }
#if defined(TSPROBE)
    if (blockIdx.x == 0 && threadIdx.x == 0) { const unsigned long long* tsb = (const unsigned long long*)(args.ws + 65536);
#if defined(TS_CYCLES)
        const unsigned long long span = (tsb[32 + TS_B] - tsb[32 + TS_A]) / 25ull, t0 = rt();
#else
        const unsigned long long span = (tsb[TS_B] - tsb[TS_A]) * 8ull, t0 = rt();
#endif
        while (rt() - t0 < span) __builtin_amdgcn_s_sleep(32); }
#endif
#undef IN
#undef BOTH
#undef GRID_BAR
}

extern "C" void kernel_launch(void* const* d_in, const int* in_sizes, int n_in, void* d_out, int out_size, void* d_ws, size_t ws_size, hipStream_t stream) {
    static int grid = 0;
    if (grid == 0) {
        if (n_in != NIN_ARGS || in_sizes[0] != MTOK * 1024 || out_size != MTOK * 1024 || ws_size < WS_END) { fprintf(stderr, "kernel_launch: unexpected shapes (n_in %d, in0 %d, out %d, ws %zu < %zu); nothing launched\n", n_in, n_in > 0 ? in_sizes[0] : -1, out_size, ws_size, (size_t)WS_END); grid = -1; return; }
        int dev = 0, cus = 0, per_cu = 0;
        if (hipGetDevice(&dev) != hipSuccess || hipDeviceGetAttribute(&cus, hipDeviceAttributeMultiprocessorCount, dev) != hipSuccess) { fprintf(stderr, "kernel_launch: hipGetDevice / hipDeviceGetAttribute failed\n"); grid = -1; return; }
        if (hipFuncSetAttribute((const void*)mega_fwd, hipFuncAttributeMaxDynamicSharedMemorySize, LDS_BYTES) != hipSuccess) { fprintf(stderr, "kernel_launch: hipFuncSetAttribute failed\n"); grid = -1; return; }
        if (hipOccupancyMaxActiveBlocksPerMultiprocessor(&per_cu, (const void*)mega_fwd, NWAVES * 64, LDS_BYTES) != hipSuccess || per_cu < 1) { fprintf(stderr, "kernel_launch: occupancy query says %d workgroups per CU\n", per_cu); per_cu = 1; }
        (void)hipGetLastError();
        if (per_cu > 1) per_cu = 1;
        grid = cus * per_cu;
    }
    if (grid < 0) return;
    if (hipMemsetAsync((char*)d_ws + WS_CTL, 0, CTL_ZERO_BYTES, stream) != hipSuccess) { fprintf(stderr, "kernel_launch: hipMemsetAsync failed\n"); return; }
    Args a{};
    for (int i = 0; i < NIN_ARGS; ++i) a.in[i] = (const float*)d_in[i];
    a.out = (float*)d_out; a.ws = (unsigned char*)d_ws;
#if defined(DETPROBE) && DETPROBE
    {   unsigned char* w = (unsigned char*)d_ws; unsigned long long* chk = (unsigned long long*)(w + WS_CHK);
        (void)hipMemsetAsync(chk, 0, 2 * 64 * 8, stream);
        struct Slot { int phase; size_t off; size_t bytes; bool in_out; };
        const Slot slots[] = { {0, WS_WIN, 39 * MiB, false}, {0, WS_LOGF, 1 * MiB, false}, {0, WS_MEMN, 4 * MiB, false}, {0, WS_H, 64 * MiB, false},
            {1, WS_G2, 1 * MiB, false}, {1, WS_MKV, 4 * MiB, false}, {1, WS_GT, 192 * MiB, false}, {1, WS_QCAT, 96 * MiB, false}, {1, WS_KA, 8 * MiB, false}, {1, WS_VA, 8 * MiB, false}, {1, WS_KF, 32 * MiB, false}, {1, WS_VF, 32 * MiB, false},
            {2, WS_QCAT, 96 * MiB, false},
            {3, WS_MRG, 64 * MiB, false}, {4, WS_X1B, 64 * MiB, false}, {4, WS_SSQ, 2 * MiB, false}, {5, WS_U, 256 * MiB, false}, {6, 0, 128 * MiB, true} };
        const int nslots = (int)(sizeof(slots) / sizeof(slots[0]));
        for (int run = 0; run < 2; ++run)
            for (int p = 0; p < 7; ++p) { a.ph_lo = p; a.ph_hi = p + 1; if (p == 1) (void)hipMemsetAsync(w + WS_GT, 0, 192 * MiB, stream); if (p == 1) (void)hipMemsetAsync(w + WS_QCAT, 0, 176 * MiB, stream);
                hipLaunchKernelGGL(mega_fwd, dim3(grid), dim3(NWAVES * 64), LDS_BYTES, stream, a);
                for (int s = 0; s < nslots; ++s) if (slots[s].phase == p) { const unsigned* src = slots[s].in_out ? (const unsigned*)d_out : (const unsigned*)(w + slots[s].off);
                    hipLaunchKernelGGL(chk_sum, dim3(2048), dim3(256), 0, stream, src, slots[s].bytes / 4, chk + run * 64 + s); } }
        hipLaunchKernelGGL(chk_report, dim3(2048), dim3(256), 0, stream, (const unsigned long long*)chk, (float*)d_out, nslots, (size_t)out_size);
    }
#elif N_LAUNCHES == 1
#if defined(EXPER_P0TWICE)
    a.ph_lo = 0; a.ph_hi = 1; hipLaunchKernelGGL(mega_fwd, dim3(grid), dim3(NWAVES * 64), LDS_BYTES, stream, a);
    (void)hipMemsetAsync((char*)d_ws + WS_CTL, 0, CTL_ZERO_BYTES, stream);
#endif
    a.ph_lo = 0; a.ph_hi = 7;
    hipLaunchKernelGGL(mega_fwd, dim3(grid), dim3(NWAVES * 64), LDS_BYTES, stream, a);
#else
    for (int p = 0; p < 7; ++p) { a.ph_lo = p; a.ph_hi = p + 1; hipLaunchKernelGGL(mega_fwd, dim3(grid), dim3(NWAVES * 64), LDS_BYTES, stream, a); }
#endif
    const hipError_t le = hipPeekAtLastError();
    if (le != hipSuccess) fprintf(stderr, "kernel_launch: launch failed: %s\n", hipGetErrorName(le));
}
```

```cpp
#include <hip/hip_runtime.h>
#include <hip/hip_bf16.h>
#include <cstdio>
#include <cstdint>
#include <cmath>
#ifndef N_LAUNCHES
#define N_LAUNCHES 1
#endif
#if defined(TSPROBE) && !defined(TS_A)
#define TS_A TSPROBE
#define TS_B (TSPROBE + 1)
#endif
namespace pg8 {
#define PG8_LAS __attribute__((address_space(3)))
typedef unsigned short bf16_t;
typedef short bf16x8 __attribute__((ext_vector_type(8)));
typedef float f32x4 __attribute__((ext_vector_type(4)));
typedef unsigned u32x4 __attribute__((ext_vector_type(4)));
constexpr int BM = 256, BK = 64, HALF = 128, HTB = HALF * BK * 2  , STAGE_BYTES = 8 * HTB, NXCD = 8, WGM = 8;

__host__ __device__ __forceinline__ int lds_byte(int r, int c) { const int st = (r >> 4) * 2 + (c >> 5), rr = r & 15, cc = c & 31, ob = rr * 64 + cc * 2; return st * 1024 + (ob ^ (((ob >> 9) & 1) << 5)); }
__host__ __device__ __forceinline__ void stage_rc(int b, int& R, int& C) { const int st = b / 1024, sb = b % 1024, swz = sb ^ (((sb >> 9) & 1) << 5); R = (st >> 1) * 16 + swz / 64; C = (st & 1) * 32 + (swz % 64) / 2; }
__host__ __device__ __forceinline__ int perm32(int rho) { const int n = rho >> 4, i = rho & 15; return 8 * (i >> 2) + 4 * n + (i & 3); }

#if defined(NO_EPI_RETIRE)
#define EPI_RETIRE do {} while (0)
#else
#define EPI_RETIRE asm volatile("s_waitcnt vmcnt(0)" ::: "memory")
#endif
struct Unit { int pm, pn; };
typedef float f32x2_t __attribute__((ext_vector_type(2))); typedef __bf16 bf16x2_t __attribute__((ext_vector_type(2)));
__device__ __forceinline__ unsigned cvt_pk_bf16(float lo, float hi) { f32x2_t v = {lo, hi}; bf16x2_t b = __builtin_convertvector(v, bf16x2_t); return __builtin_bit_cast(unsigned, b); }
typedef unsigned u32x2 __attribute__((ext_vector_type(2)));

struct Sched {
    int nM, nN, nwg, G, c, nx, asel;
    const char *A0, *Bt, *Ax, *Bx; size_t tstep, astride; void* tsbase;
    __device__ __forceinline__ void init(int M, int N, int K, int G_, int c_, const void* a0, const void* bt) {
        nM = M / BM; nN = N / BM; nwg = nM * nN; G = G_; c = c_; nx = 0; asel = 0; astride = 0; tsbase = nullptr; A0 = (const char*)a0; Bt = (const char*)bt; Ax = Bx = (const char*)a0; tstep = (size_t)BM * K * 2; }
    __device__ __forceinline__ bool next(int i, Unit& u) const {
        const long L = (long)i * G + c;
        if (L >= nwg) { const long e = L - nwg; if (e >= nx) return false; u.pm = nM + (int)(e >> 2); u.pn = (int)(e & 3); return true; }
        int wgid = (int)L; { const int q = nwg / NXCD, r = nwg % NXCD, xcd = wgid % NXCD, off = wgid / NXCD; wgid = (xcd < r ? xcd * (q + 1) : r * (q + 1) + (xcd - r) * q) + off; }
        const int nig = WGM * nN, gid = wgid / nig, fm = gid * WGM, gsz = (nM - fm) < WGM ? (nM - fm) : WGM;
        u.pm = fm + ((wgid % nig) % gsz); u.pn = (wgid % nig) / gsz; return true;
    }
    __device__ __forceinline__ const char* a_ptr(const Unit& u) const {
        if (u.pm >= nM) return Ax + (size_t)(u.pm - nM) * tstep;
        return A0 + (size_t)(asel ? (u.pn >> 2) : 0) * astride + (size_t)u.pm * tstep; }
    __device__ __forceinline__ const char* b_ptr(const Unit& u) const { return ((u.pm >= nM) ? Bx : Bt) + (size_t)u.pn * tstep; }
    __device__ __forceinline__ void a_ready(const Unit&) const {}
    __device__ __forceinline__ void done(const Unit&) const {}
};

__device__ __forceinline__ float dot4(const f32x4 a) { return (a[0] * a[0] + a[1] * a[1]) + (a[2] * a[2] + a[3] * a[3]); }
__device__ __forceinline__ u32x4 pack8(const f32x4 a, const f32x4 b) { u32x4 w; w.x = cvt_pk_bf16(a[0], a[1]); w.y = cvt_pk_bf16(a[2], a[3]); w.z = cvt_pk_bf16(b[0], b[1]); w.w = cvt_pk_bf16(b[2], b[3]); return w; }

__device__ __forceinline__ int quad_src_idx(int lane) { return ((((lane & 3) << 4) | (lane >> 2)) << 2); }
__device__ __forceinline__ u32x4 quad_gather(const u32x4 w, int pidx) { u32x4 o; o.x = (unsigned)__builtin_amdgcn_ds_bpermute(pidx, (int)w.x); o.y = (unsigned)__builtin_amdgcn_ds_bpermute(pidx, (int)w.y);
    o.z = (unsigned)__builtin_amdgcn_ds_bpermute(pidx, (int)w.z); o.w = (unsigned)__builtin_amdgcn_ds_bpermute(pidx, (int)w.w); return o; }
constexpr float kLog2e = 1.4426950408889634f;
constexpr float kEps = 1e-6f;
constexpr float kC2_64 = 0.125f * 1.4426950408889634f;

struct EpiInProj {
    static constexpr bool PERM = true, AFTER_DRAIN = false, HAS_MID = false;
    bf16_t *QA, *KA, *VA, *QF, *KF, *VF, *QM; unsigned char* GT8;
    PG8_LAS const float* tab;
    __device__ __forceinline__ void operator()(const f32x4 (&acc)[2][2][4][2], const Unit& u, int wr, int wc, int fr, int fq) const {
        const int g = u.pn * 4 + wc;
        bf16_t* dst; int pitch, dcol, mode;
        if (g < 8)       { dst = QA; pitch = 1536; dcol = 64 * g;        mode = 1; }
        else if (g < 10) { dst = KA; pitch = 128;  dcol = 64 * (g - 8);  mode = 1; }
        else if (g < 12) { dst = VA; pitch = 128;  dcol = 64 * (g - 10); mode = 0; }
        else if (g < 20) { dst = QF; pitch = 1536; dcol = 64 * (g - 12); mode = 1; }
        else if (g < 28) { dst = KF; pitch = 512;  dcol = 64 * (g - 20); mode = 1; }
        else if (g < 36) { dst = VF; pitch = 512;  dcol = 64 * (g - 28); mode = 0; }
        else if (g < 44) { dst = QM; pitch = 1536; dcol = 64 * (g - 36); mode = 0; }
        else             { dst = nullptr; pitch = 0; dcol = 64 * (g - 44); mode = 2; }
        const int row0 = u.pm * BM + wr * 64 + fr;
        bf16_t* base = dst + dcol + 8 * fq;
        f32x4 cv[2][2];
#pragma unroll
        for (int bj = 0; bj < 2; ++bj)
#pragma unroll
            for (int n = 0; n < 2; ++n) cv[bj][n] = *(PG8_LAS const f32x4*)(tab + g * 64 + ((g >= 44) ? 16 * fq + 8 * bj : 32 * bj + 8 * fq) + 4 * n);
        if (mode == 1) {
#pragma unroll
            for (int ai = 0; ai < 2; ++ai)
#pragma unroll
                for (int m = 0; m < 4; ++m) { bf16_t* rowp = base + (size_t)(row0 + ai * HALF + m * 16) * pitch;
                    float ss = (dot4(acc[ai][0][m][0]) + dot4(acc[ai][0][m][1])) + (dot4(acc[ai][1][m][0]) + dot4(acc[ai][1][m][1]));
                    ss += __shfl_xor(ss, 16); ss += __shfl_xor(ss, 32);
                    const float r = 1.0f / sqrtf(ss * (1.0f / 64.0f) + kEps);
                    if (ai == 0 && m == 0) EPI_RETIRE;
#pragma unroll
                    for (int bj = 0; bj < 2; ++bj) *(u32x4*)(rowp + 32 * bj) = pack8(acc[ai][bj][m][0] * r * cv[bj][0], acc[ai][bj][m][1] * r * cv[bj][1]); }
        } else if (mode == 2) {
            unsigned char* gbase = (unsigned char*)GT8 + dcol + 16 * fq;
#pragma unroll
            for (int ai = 0; ai < 2; ++ai)
#pragma unroll
                for (int m = 0; m < 4; ++m) { u32x4 w;
#pragma unroll
                    for (int bj = 0; bj < 2; ++bj)
#pragma unroll
                        for (int n = 0; n < 2; ++n) { const f32x4 z = (acc[ai][bj][m][n] + cv[bj][n]) * (-kLog2e); unsigned q = 0;
#pragma unroll
                            for (int j = 0; j < 4; ++j) { const float g = __builtin_amdgcn_rcpf(1.0f + __builtin_amdgcn_exp2f(z[j])); unsigned b8 = (unsigned)(g * 255.0f + 0.5f); b8 = b8 < 1u ? 1u : b8; q |= b8 << (8 * j); }
                            w[2 * bj + n] = q; }
                    if (ai == 0 && m == 0) EPI_RETIRE;
                    *(u32x4*)(gbase + (size_t)(row0 + ai * HALF + m * 16) * 3072) = w; asm volatile("" ::: "memory"); }
        } else {
            EPI_RETIRE;
#pragma unroll
            for (int ai = 0; ai < 2; ++ai)
#pragma unroll
                for (int m = 0; m < 4; ++m) { bf16_t* rowp = base + (size_t)(row0 + ai * HALF + m * 16) * pitch;
#pragma unroll
                    for (int bj = 0; bj < 2; ++bj) *(u32x4*)(rowp + 32 * bj) = pack8(acc[ai][bj][m][0], acc[ai][bj][m][1]); }
        }
    }
};

struct EpiMemKV {
    static constexpr bool PERM = true, AFTER_DRAIN = false, HAS_MID = false;
    unsigned char* MIMG; PG8_LAS const float* tab; PG8_LAS float* ex;
    __device__ __forceinline__ void operator()(const f32x4 (&acc)[2][2][4][2], const Unit& u, int wr, int wc, int fr, int fq) const {
            const int b = u.pm, hp = (u.pn & 1) * 2, key0 = wr * 64 + fr;
            unsigned char* im0 = MIMG + (size_t)(b * 4 + hp) * 131072;
            if (u.pn < 2) {
                PG8_LAS const f32x4* gp = (PG8_LAS const f32x4*)(tab + 28 * 64 + 32 * wc + 8 * fq);
#pragma unroll
                for (int bj = 0; bj < 2; ++bj) {
#pragma unroll
                    for (int ai = 0; ai < 2; ++ai)
#pragma unroll
                        for (int m = 0; m < 4; ++m) { float ss = dot4(acc[ai][bj][m][0]) + dot4(acc[ai][bj][m][1]); ss += __shfl_xor(ss, 16); ss += __shfl_xor(ss, 32);
                            if (fq == 0) ex[(ai * HALF + key0 + m * 16) * 4 + wc] = ss; }
                    asm volatile("s_waitcnt lgkmcnt(0)" ::: "memory"); __builtin_amdgcn_s_barrier(); asm volatile("" ::: "memory");
                    if (bj == 0) EPI_RETIRE;
                    unsigned char* im = im0 + (size_t)bj * 131072 + (4 * wc + fq) * 4096;
#pragma unroll
                    for (int ai = 0; ai < 2; ++ai)
#pragma unroll
                        for (int m = 0; m < 4; ++m) { const int key = ai * HALF + key0 + m * 16; const f32x4 e4 = *(PG8_LAS const f32x4*)(ex + key * 4);
                            const float r = 1.0f / sqrtf(((e4[0] + e4[1]) + (e4[2] + e4[3])) * (1.0f / 128.0f) + kEps);
                            *(u32x4*)(im + key * 16) = pack8(acc[ai][bj][m][0] * r * gp[0], acc[ai][bj][m][1] * r * gp[1]); }
                    asm volatile("s_waitcnt lgkmcnt(0)" ::: "memory"); __builtin_amdgcn_s_barrier(); asm volatile("" ::: "memory");
                }
            } else {
                EPI_RETIRE;
#pragma unroll
                for (int bj = 0; bj < 2; ++bj) { unsigned char* im = im0 + (size_t)bj * 131072 + 65536 + wc * 4096 + fq * 16;
#pragma unroll
                    for (int ai = 0; ai < 2; ++ai)
#pragma unroll
                        for (int m = 0; m < 4; ++m) { const int key = ai * HALF + key0 + m * 16; *(u32x4*)(im + (key >> 6) * 16384 + (key & 63) * 64) = pack8(acc[ai][bj][m][0], acc[ai][bj][m][1]); } }
            }
    }
};

__device__ __forceinline__ void unpack8(const u32x4 w, f32x4& a, f32x4& b) {
    a[0] = __uint_as_float(w.x << 16); a[1] = __uint_as_float(w.x & 0xffff0000u); a[2] = __uint_as_float(w.y << 16); a[3] = __uint_as_float(w.y & 0xffff0000u);
    b[0] = __uint_as_float(w.z << 16); b[1] = __uint_as_float(w.z & 0xffff0000u); b[2] = __uint_as_float(w.w << 16); b[3] = __uint_as_float(w.w & 0xffff0000u); }
__device__ __forceinline__ f32x4 ub4(unsigned w) { return (f32x4){(float)(w & 0xffu), (float)((w >> 8) & 0xffu), (float)((w >> 16) & 0xffu), (float)(w >> 24)}; }
struct EpiMerge {
    static constexpr bool PERM = true, AFTER_DRAIN = false, HAS_MID = true;
    const unsigned char* GT8; bf16_t* MRG; void* tsbase;
    static __device__ __forceinline__ void scale16(f32x4& a00, f32x4& a01, f32x4& a10, f32x4& a11, const u32x4 nw, const u32x4 dw) {
        const f32x4 n0 = ub4(nw.x), n1 = ub4(nw.y), n2 = ub4(nw.z), n3 = ub4(nw.w), d0 = ub4(dw.x), d1 = ub4(dw.y), d2 = ub4(dw.z), d3 = ub4(dw.w);
#pragma unroll
        for (int j = 0; j < 4; ++j) { a00[j] *= n0[j] * __builtin_amdgcn_rcpf(d0[j]); a01[j] *= n1[j] * __builtin_amdgcn_rcpf(d1[j]); a10[j] *= n2[j] * __builtin_amdgcn_rcpf(d2[j]); a11[j] *= n3[j] * __builtin_amdgcn_rcpf(d3[j]); } }
    __device__ __forceinline__ void mid(f32x4 (&acc)[2][2][4][2], const Unit& u, int t, int wr, int wc, int fr, int fq) const {
        const unsigned char* base = GT8 + (size_t)(u.pm * BM + wr * 64 + fr) * 3072 + u.pn * BM + wc * 64 + 16 * fq + ((t == 8) ? 0 : 1024);
        u32x4 nA, dA, nB, dB, nC, dC;
#define MID_LOAD(N, D, g) do { const unsigned char* rp_ = base + (size_t)(((g) >> 2) * HALF + ((g) & 3) * 16) * 3072; N = *(const u32x4*)(rp_); D = *(const u32x4*)(rp_ + 1024); } while (0)
#define MID_APPLY(N, D, g) do { scale16(acc[(g) >> 2][0][(g) & 3][0], acc[(g) >> 2][0][(g) & 3][1], acc[(g) >> 2][1][(g) & 3][0], acc[(g) >> 2][1][(g) & 3][1], N, D); \
        asm volatile("" : "+v"(acc[(g) >> 2][0][(g) & 3][0]), "+v"(acc[(g) >> 2][0][(g) & 3][1]), "+v"(acc[(g) >> 2][1][(g) & 3][0]), "+v"(acc[(g) >> 2][1][(g) & 3][1]) :: "memory"); } while (0)
        MID_LOAD(nA, dA, 0); MID_LOAD(nB, dB, 1);
        MID_LOAD(nC, dC, 2); MID_APPLY(nA, dA, 0);
        MID_LOAD(nA, dA, 3); MID_APPLY(nB, dB, 1);
        MID_LOAD(nB, dB, 4); MID_APPLY(nC, dC, 2);
        MID_LOAD(nC, dC, 5); MID_APPLY(nA, dA, 3);
        MID_LOAD(nA, dA, 6); MID_APPLY(nB, dB, 4);
        MID_LOAD(nB, dB, 7); MID_APPLY(nC, dC, 5);
        MID_APPLY(nA, dA, 6);
        MID_APPLY(nB, dB, 7);
#undef MID_LOAD
#undef MID_APPLY
    }
    __device__ __forceinline__ void operator()(const f32x4 (&acc)[2][2][4][2], const Unit& u, int wr, int wc, int fr, int fq) const {
        const int row0 = u.pm * BM + wr * 64 + fr, col0 = u.pn * BM + wc * 64 + 16 * fq;
        u32x4 gw[2][4];
#pragma unroll
        for (int ai = 0; ai < 2; ++ai)
#pragma unroll
            for (int m = 0; m < 4; ++m) gw[ai][m] = *(const u32x4*)(GT8 + (size_t)(row0 + ai * HALF + m * 16) * 3072 + 2048 + col0);
        EPI_RETIRE;
#pragma unroll
        for (int ai = 0; ai < 2; ++ai)
#pragma unroll
            for (int m = 0; m < 4; ++m) { bf16_t* op = MRG + (size_t)(row0 + ai * HALF + m * 16) * 1024 + col0; const float k = 1.0f / 255.0f;
                *(u32x4*)(op) = pack8(acc[ai][0][m][0] * (ub4(gw[ai][m].x) * k), acc[ai][0][m][1] * (ub4(gw[ai][m].y) * k));
                *(u32x4*)(op + 8) = pack8(acc[ai][1][m][0] * (ub4(gw[ai][m].z) * k), acc[ai][1][m][1] * (ub4(gw[ai][m].w) * k)); }
    }
};

struct EpiOutProj {
    static constexpr bool PERM = true, AFTER_DRAIN = false, HAS_MID = false;
    const bf16_t* Hn; const float* RINV; PG8_LAS const float* ginv; bf16_t* X1B; float* SSQ;
    __device__ __forceinline__ void operator()(const f32x4 (&acc)[2][2][4][2], const Unit& u, int wr, int wc, int fr, int fq) const {
        const int row0 = u.pm * BM + wr * 64 + fr, col0 = u.pn * BM + wc * 32 + 8 * fq;
        f32x4 gi[2][2];
#pragma unroll
        for (int bj = 0; bj < 2; ++bj)
#pragma unroll
            for (int n = 0; n < 2; ++n) gi[bj][n] = *(PG8_LAS const f32x4*)(ginv + col0 + bj * HALF + 4 * n);
#pragma unroll
        for (int ai = 0; ai < 2; ++ai) {
            u32x4 hw[4][2]; float ri[4];
#pragma unroll
            for (int m = 0; m < 4; ++m) { const int row = row0 + ai * HALF + m * 16; ri[m] = RINV[row]; hw[m][0] = *(const u32x4*)(Hn + (size_t)row * 1024 + col0); hw[m][1] = *(const u32x4*)(Hn + (size_t)row * 1024 + col0 + HALF); }
            if (ai == 0) EPI_RETIRE;
#pragma unroll
            for (int m = 0; m < 4; ++m) { const int row = row0 + ai * HALF + m * 16; const size_t off = (size_t)row * 1024 + col0; float ss = 0.f;
#pragma unroll
                for (int bj = 0; bj < 2; ++bj) { f32x4 h0, h1; unpack8(hw[m][bj], h0, h1);
                    const f32x4 v0 = h0 * ri[m] * gi[bj][0] + acc[ai][bj][m][0], v1 = h1 * ri[m] * gi[bj][1] + acc[ai][bj][m][1];
                    ss += dot4(v0) + dot4(v1); *(u32x4*)(X1B + off + bj * HALF) = pack8(v0, v1); }
                ss += __shfl_xor(ss, 16); ss += __shfl_xor(ss, 32);
                if (fq == 0) SSQ[(size_t)row * 16 + u.pn * 4 + wc] = ss; }
            asm volatile("" ::: "memory"); }
    }
};

template <bool NOSTORE = false> struct EpiUpT {
    static constexpr bool PERM = true, AFTER_DRAIN = false, HAS_MID = false;
    const float* SSQ; bf16_t* U; PG8_LAS float* rl;
    __device__ __forceinline__ void operator()(const f32x4 (&acc)[2][2][4][2], const Unit& u, int wr, int wc, int fr, int fq) const {
        const int lane_ = fq * 16 + fr, pidx = quad_src_idx(lane_);
        const int row0 = u.pm * BM + wr * 64 + (lane_ >> 2), col0 = u.pn * BM + wc * 32 + 8 * (lane_ & 3);
        { const int t = (wr * 4 + wc) * 64 + fq * 16 + fr;
          if (t < BM) { const f32x4* sp = (const f32x4*)(SSQ + (size_t)(u.pm * BM + t) * 16); const f32x4 s4 = (sp[0] + sp[1]) + (sp[2] + sp[3]);
              rl[t] = 1.0f / sqrtf(((s4[0] + s4[1]) + (s4[2] + s4[3])) * (1.0f / 1024.0f) + kEps); }
          asm volatile("s_waitcnt lgkmcnt(0)" ::: "memory"); __builtin_amdgcn_s_barrier(); asm volatile("" ::: "memory"); }
        EPI_RETIRE;
#pragma unroll
        for (int ai = 0; ai < 2; ++ai) {
#pragma unroll
            for (int m = 0; m < 4; ++m) { const float r = rl[ai * HALF + wr * 64 + m * 16 + fr];
                bf16_t* rowp = U + (size_t)(row0 + ai * HALF + m * 16) * 4096 + col0;
#pragma unroll
                for (int bj = 0; bj < 2; ++bj) { f32x4 a = acc[ai][bj][m][0] * r, b = acc[ai][bj][m][1] * r;
#pragma unroll
                    for (int j = 0; j < 4; ++j) { a[j] = fmaxf(a[j], 0.f); a[j] *= a[j]; b[j] = fmaxf(b[j], 0.f); b[j] *= b[j]; }
                    const u32x4 pk_ = quad_gather(pack8(a, b), pidx); if (NOSTORE) asm volatile("" :: "v"(pk_)); else *(u32x4*)(rowp + bj * HALF) = pk_; } } }
        asm volatile("s_waitcnt lgkmcnt(0)" ::: "memory"); __builtin_amdgcn_s_barrier(); asm volatile("" ::: "memory");
    }
};
typedef EpiUpT<false> EpiUp;

struct EpiDown {
    static constexpr bool PERM = true, AFTER_DRAIN = false, HAS_MID = false;
    const bf16_t* X1B; float* OUT;
    __device__ __forceinline__ void operator()(const f32x4 (&acc)[2][2][4][2], const Unit& u, int wr, int wc, int fr, int fq) const {
        const int row0 = u.pm * BM + wr * 64 + fr, col0 = u.pn * BM + wc * 32 + 8 * fq;
        u32x4 xw[2][4][2];
#pragma unroll
        for (int ai = 0; ai < 2; ++ai)
#pragma unroll
            for (int m = 0; m < 4; ++m) { const size_t off = (size_t)(row0 + ai * HALF + m * 16) * 1024 + col0; xw[ai][m][0] = *(const u32x4*)(X1B + off); xw[ai][m][1] = *(const u32x4*)(X1B + off + HALF); }
        EPI_RETIRE;
#pragma unroll
        for (int ai = 0; ai < 2; ++ai)
#pragma unroll
            for (int m = 0; m < 4; ++m) { const size_t off = (size_t)(row0 + ai * HALF + m * 16) * 1024 + col0;
#pragma unroll
                for (int bj = 0; bj < 2; ++bj) { f32x4 r0, r1; unpack8(xw[ai][m][bj], r0, r1);
                    *(f32x4*)(OUT + off + bj * HALF) = r0 + acc[ai][bj][m][0]; *(f32x4*)(OUT + off + bj * HALF + 4) = r1 + acc[ai][bj][m][1]; } }
    }
};

template <class Epi, class Sched, bool ALIGN_EPI = false, bool SP2 = false>
__device__ __forceinline__ void gemm_phase(PG8_LAS unsigned char* lds, const int K_, const Sched& S, const Epi& E) {
    const int tid = threadIdx.x, wid = __builtin_amdgcn_readfirstlane(tid >> 6), lane = tid & 63, wr = wid >> 2, wc = wid & 3, fr = lane & 15, fq = lane >> 4;
    const int K = K_, nt = K / BK;
    unsigned voffA[2], voffB[2];
#pragma unroll
    for (int i = 0; i < 2; ++i) { int R, C; stage_rc(tid * 16 + i * 8192, R, C); const int Rb = Epi::PERM ? ((R & ~31) + perm32(R & 31)) : R;
        voffA[i] = (unsigned)(R * K + C) * 2u; voffB[i] = (unsigned)(Rb * K + C) * 2u; }
    const size_t kstep = (size_t)(BK * 2);
    const size_t hstep = (size_t)HALF * K * 2;
    const size_t tstep = 2 * hstep;
    const unsigned ldsw = (unsigned)wid * 1024u;
    const int aoff = lds_byte(wr * 64 + fr, fq * 8), boff = lds_byte(wc * 32 + fr, fq * 8);
#define PG8_SA(b, h) (((b) * 2 + (h)) * HTB)
#define PG8_SB(b, h) ((4 + (b) * 2 + (h)) * HTB)
#define PG8_STAGE(bufoff, gbase, voff) do { _Pragma("unroll") for (int _i = 0; _i < 2; ++_i) \
        __builtin_amdgcn_global_load_lds((const unsigned*)((const char*)(gbase) + (voff)[_i]), (PG8_LAS unsigned*)(lds + (bufoff) + ldsw + _i * 8192), 16, 0, 0); } while (0)
#define PG8_LDA(dst, b, h) do { _Pragma("unroll") for (int m = 0; m < 4; ++m) _Pragma("unroll") for (int k = 0; k < 2; ++k) dst[m][k] = *(const PG8_LAS bf16x8*)(lds + PG8_SA(b, h) + aoff + m * 2048 + k * 1024); } while (0)
#define PG8_LDB(dst, b, h) do { _Pragma("unroll") for (int n = 0; n < 2; ++n) _Pragma("unroll") for (int k = 0; k < 2; ++k) dst[n][k] = *(const PG8_LAS bf16x8*)(lds + PG8_SB(b, h) + boff + n * 2048 + k * 1024); } while (0)
#define PG8_MMA(ai, bj, At, Bt) do { __builtin_amdgcn_s_setprio(1); _Pragma("unroll") for (int m = 0; m < 4; ++m) _Pragma("unroll") for (int n = 0; n < 2; ++n) _Pragma("unroll") for (int k = 0; k < 2; ++k) \
        acc[ai][bj][m][n] = __builtin_amdgcn_mfma_f32_16x16x32_bf16(Bt[n][k], At[m][k], acc[ai][bj][m][n], 0, 0, 0); __builtin_amdgcn_s_setprio(0); } while (0)
#define PG8_WAIT_V(n) asm volatile("s_waitcnt vmcnt(" #n ")" ::: "memory")
#define PG8_WAIT_L(n) asm volatile("s_waitcnt lgkmcnt(" #n ")" ::: "memory")
#if defined(NO_TZ)
#define PG8_WAIT_V8_T(tz) PG8_WAIT_V(8)
#else
#define PG8_WAIT_V8_T(tz) asm volatile("s_cmp_eq_u32 %0, 0\n\ts_cbranch_scc1 .Lpg8w_%=\n\ts_waitcnt vmcnt(8)\n.Lpg8w_%=:" :: "s"(tz) : "memory", "scc")
#endif
#define PG8_BAR __builtin_amdgcn_s_barrier()
#define PG8_SCHED __builtin_amdgcn_sched_barrier(0)
    Unit cur, nxt; int ui = 0;
    if (!S.next(0, cur)) return;
    f32x4 acc[2][2][4][2];
#pragma unroll
    for (int a = 0; a < 2; ++a)
#pragma unroll
        for (int b = 0; b < 2; ++b)
#pragma unroll
            for (int m = 0; m < 4; ++m)
#pragma unroll
                for (int n = 0; n < 2; ++n) acc[a][b][m][n] = (f32x4){0.f, 0.f, 0.f, 0.f};
    bf16x8 At[4][2], B0[2][2], B1[2][2];
    const char* cA = S.a_ptr(cur); const char* cB = S.b_ptr(cur);
    S.a_ready(cur);
    if constexpr (SP2) {
        PG8_STAGE(PG8_SB(0, 0), cB, voffB); PG8_STAGE(PG8_SB(0, 1), cB + hstep, voffB); PG8_STAGE(PG8_SA(0, 0), cA, voffA); PG8_STAGE(PG8_SA(0, 1), cA + hstep, voffA);
        if (wr == 1) PG8_BAR;
        PG8_WAIT_V(2); PG8_BAR;
        PG8_STAGE(PG8_SB(1, 0), cB + kstep, voffB); PG8_STAGE(PG8_SA(1, 0), cA + kstep, voffA); PG8_STAGE(PG8_SB(1, 1), cB + hstep + kstep, voffB); PG8_STAGE(PG8_SA(1, 1), cA + hstep + kstep, voffA);
        PG8_WAIT_V(0); PG8_BAR;
    } else {
        PG8_STAGE(PG8_SB(0, 0), cB, voffB); PG8_STAGE(PG8_SA(0, 0), cA, voffA); PG8_STAGE(PG8_SB(0, 1), cB + hstep, voffB); PG8_STAGE(PG8_SA(0, 1), cA + hstep, voffA);
        if (wr == 1) PG8_BAR;
        PG8_WAIT_V(4); PG8_BAR;
        PG8_STAGE(PG8_SB(1, 0), cB + kstep, voffB); PG8_STAGE(PG8_SA(1, 0), cA + kstep, voffA); PG8_STAGE(PG8_SB(1, 1), cB + hstep + kstep, voffB);
        PG8_WAIT_V(6); PG8_BAR;
    }
    for (;;) {
        const bool has_next = S.next(ui + 1, nxt);
        const char* nA = has_next ? S.a_ptr(nxt) : cA; const char* nB = has_next ? S.b_ptr(nxt) : cB;
#if defined(TSPROBE)
        const unsigned long long kc0_ = __builtin_amdgcn_s_memtime();
#endif
        for (int t = 0; t < nt; t += 2) {
            if constexpr (Epi::HAS_MID) { if (t == 8 || t == 16) {
#if defined(TSPROBE)
                const unsigned long long h0_ = __builtin_amdgcn_s_memrealtime();
#endif
                E.mid(acc, cur, t, wr, wc, fr, fq);
#if defined(TSPROBE)
                if (blockIdx.x == 0 && threadIdx.x == 0) { unsigned long long* tsp_ = (unsigned long long*)E.tsbase; tsp_[15] = tsp_[15] + (__builtin_amdgcn_s_memrealtime() - h0_); }
#endif
            } }
            const bool last = (t == nt - 2);
            const char* a1 = cA + (size_t)(t + 1) * kstep;
            const char* a2 = last ? nA : cA + (size_t)(t + 2) * kstep; const char* b2 = last ? nB : cB + (size_t)(t + 2) * kstep;
            const char* a3 = a2 + kstep; const char* b3 = b2 + kstep;
            if (last && has_next) S.a_ready(nxt);
            const int tz = __builtin_amdgcn_readfirstlane(t);
            if constexpr (SP2) {
            PG8_LDB(B0, 0, 0); PG8_LDB(B1, 0, 1); PG8_SCHED; PG8_LDA(At, 0, 0); PG8_STAGE(PG8_SA(1, 1), a1 + hstep, voffA);
            PG8_WAIT_V8_T(tz); PG8_WAIT_L(0); PG8_BAR; PG8_MMA(0, 0, At, B0); PG8_MMA(0, 1, At, B1); PG8_BAR; PG8_SCHED;
            PG8_LDA(At, 0, 1); PG8_STAGE(PG8_SB(0, 0), b2, voffB); PG8_STAGE(PG8_SB(0, 1), b2 + hstep, voffB); PG8_STAGE(PG8_SA(0, 0), a2, voffA);
            PG8_WAIT_V8_T(tz); PG8_WAIT_L(0); PG8_BAR; PG8_MMA(1, 0, At, B0); PG8_MMA(1, 1, At, B1); PG8_BAR; PG8_SCHED;
            PG8_LDB(B0, 1, 0); PG8_LDB(B1, 1, 1); PG8_SCHED; PG8_LDA(At, 1, 0); PG8_STAGE(PG8_SA(0, 1), a2 + hstep, voffA);
            PG8_WAIT_V8_T(tz); PG8_WAIT_L(0); PG8_BAR; PG8_MMA(0, 0, At, B0); PG8_MMA(0, 1, At, B1); PG8_BAR; PG8_SCHED;
            PG8_LDA(At, 1, 1); PG8_STAGE(PG8_SB(1, 0), b3, voffB); PG8_STAGE(PG8_SB(1, 1), b3 + hstep, voffB); PG8_STAGE(PG8_SA(1, 0), a3, voffA);
            PG8_WAIT_V(8); PG8_WAIT_L(0); PG8_BAR; PG8_MMA(1, 0, At, B0); PG8_MMA(1, 1, At, B1); PG8_BAR; PG8_SCHED;
            } else {
            PG8_LDB(B0, 0, 0); PG8_SCHED; PG8_LDA(At, 0, 0); PG8_STAGE(PG8_SA(1, 1), a1 + hstep, voffA);
            PG8_WAIT_L(8); PG8_BAR; PG8_WAIT_L(0); PG8_MMA(0, 0, At, B0); PG8_BAR; PG8_SCHED;
            PG8_LDB(B1, 0, 1); PG8_STAGE(PG8_SB(0, 0), b2, voffB);
            PG8_BAR; PG8_WAIT_L(0); PG8_MMA(0, 1, At, B1); PG8_BAR;
            PG8_LDA(At, 0, 1); PG8_STAGE(PG8_SA(0, 0), a2, voffA);
            PG8_BAR; PG8_WAIT_L(0); PG8_MMA(1, 0, At, B0); PG8_BAR; PG8_SCHED;
            PG8_STAGE(PG8_SB(0, 1), b2 + hstep, voffB);
            PG8_WAIT_V(6); PG8_BAR; PG8_MMA(1, 1, At, B1); PG8_BAR;
            PG8_LDB(B0, 1, 0); PG8_SCHED; PG8_LDA(At, 1, 0); PG8_STAGE(PG8_SA(0, 1), a2 + hstep, voffA);
            PG8_WAIT_L(8); PG8_BAR; PG8_WAIT_L(0); PG8_MMA(0, 0, At, B0); PG8_BAR; PG8_SCHED;
            PG8_LDB(B1, 1, 1); PG8_STAGE(PG8_SB(1, 0), b3, voffB);
            PG8_BAR; PG8_WAIT_L(0); PG8_MMA(0, 1, At, B1); PG8_BAR;
            PG8_LDA(At, 1, 1); PG8_STAGE(PG8_SA(1, 0), a3, voffA);
            PG8_BAR; PG8_WAIT_L(0); PG8_MMA(1, 0, At, B0); PG8_BAR; PG8_SCHED;
            PG8_STAGE(PG8_SB(1, 1), b3 + hstep, voffB);
            PG8_WAIT_V(6); PG8_BAR; PG8_MMA(1, 1, At, B1); PG8_BAR;
            }
        }
#if defined(TSPROBE)
        if (blockIdx.x == 0 && threadIdx.x == 0) { unsigned long long* tsp_ = (unsigned long long*)S.tsbase; tsp_[42] = tsp_[42] + (__builtin_amdgcn_s_memtime() - kc0_); tsp_[44] = tsp_[44] + (unsigned long long)nt; }
#endif
#if !defined(NO_PRESTAGE)
        if constexpr (SP2) PG8_STAGE(PG8_SA(1, 1), nA + kstep + hstep, voffA);
#endif
        if constexpr (ALIGN_EPI) { if (wr == 0) PG8_BAR; }
#if defined(TSPROBE)
        const unsigned long long e0_ = __builtin_amdgcn_s_memrealtime();
#endif
        if constexpr (!Epi::AFTER_DRAIN) { E(acc, cur, wr, wc, fr, fq); S.done(cur); }
#if defined(TSPROBE)
        if (blockIdx.x == 0 && threadIdx.x == 0) { unsigned long long* tsp_ = (unsigned long long*)S.tsbase; tsp_[17] = tsp_[17] + (__builtin_amdgcn_s_memrealtime() - e0_); }
#endif
        if (!has_next) break;
#pragma unroll
        for (int a = 0; a < 2; ++a)
#pragma unroll
            for (int b = 0; b < 2; ++b)
#pragma unroll
                for (int m = 0; m < 4; ++m)
#pragma unroll
                    for (int n = 0; n < 2; ++n) acc[a][b][m][n] = (f32x4){0.f, 0.f, 0.f, 0.f};
        cur = nxt; cA = nA; cB = nB; ++ui;
        if constexpr (ALIGN_EPI) { if (wr == 1) PG8_BAR; }
    }
    PG8_WAIT_V(0);
    if constexpr (!ALIGN_EPI) { if (wr == 0) PG8_BAR; }
    PG8_BAR;
    if constexpr (Epi::AFTER_DRAIN) { E.fused(acc, cur, wr, wc, fr, fq, lds, wid, lane); S.done(cur); }
#undef PG8_SA
#undef PG8_SB
#undef PG8_STAGE
#undef PG8_LDA
#undef PG8_LDB
#undef PG8_MMA
#undef PG8_WAIT_V
#undef PG8_WAIT_L
#undef PG8_BAR
#undef PG8_SCHED
}
}
namespace attn_body {
using bf16=__hip_bfloat16;
using bf16x8=__attribute__((ext_vector_type(8)))short;
using s16x4=__attribute__((ext_vector_type(4)))short;
using f32x16=__attribute__((ext_vector_type(16)))float;
using f32x4=__attribute__((ext_vector_type(4)))float;
using u32x4=__attribute__((ext_vector_type(4)))unsigned;
constexpr int SEQ=4096,D=64,PQ=1536;
constexpr int NW=8,QBLK=32,QB=QBLK*NW,KVBLK=64;
__device__ __forceinline__ int crow(int r,int hi){return (r&3)+8*(r>>2)+4*hi;}
#define SBAR() __builtin_amdgcn_sched_barrier(0)
__device__ __forceinline__ void cmask(f32x16&p0,f32x16&p1,int jb,int qrel,int hi){
  const float NEG=-INFINITY; int kb=64*jb+4*hi;
  #pragma unroll
  for(int r=0;r<16;++r){int kv=kb+(r&3)+8*(r>>2); if(kv>qrel)p0[r]=NEG; if(kv+32>qrel)p1[r]=NEG;}
}
constexpr int NSLOT=3, SLOTB=8192;
constexpr int LDS_K=0, LDS_V=NSLOT*SLOTB, LDS_WS=2*NSLOT*SLOTB, LDS_OST=LDS_WS+NW*64*4, LDS_GL=LDS_OST+NW*4096+2048  , LDS_TB=LDS_GL+16384  , LDS_BYTES=LDS_TB+2560;
constexpr float LOG2E=1.4426950408889634f;
__device__ __forceinline__ void glds16(const void*gsrc,unsigned lds_dst){unsigned keep;
  asm volatile("s_mov_b32 %0, m0\n\ts_mov_b32 m0, %2\n\ts_nop 0\n\tglobal_load_lds_dwordx4 %1, off\n\ts_mov_b32 m0, %0":"=&s"(keep):"v"(gsrc),"s"(lds_dst):"memory");}
typedef float f32x2_t __attribute__((ext_vector_type(2))); typedef __bf16 bf16x2_t __attribute__((ext_vector_type(2)));
__device__ __forceinline__ unsigned cvtpk_s(float lo,float hi){f32x2_t v={lo,hi};bf16x2_t b=__builtin_convertvector(v,bf16x2_t);return __builtin_bit_cast(unsigned,b);}
#define WAIT_BAR(N) asm volatile("s_waitcnt vmcnt(" #N ") lgkmcnt(0)\n\ts_barrier":::"memory")
typedef __attribute__((address_space(3))) const char* lds_cptr;
typedef __attribute__((address_space(3))) float* lds_fptr;
typedef __attribute__((address_space(3))) f32x4* lds_f4ptr;
typedef short v4i16_t __attribute__((ext_vector_type(4)));
#define MX3(a,b,c) __builtin_fmaxf(__builtin_fmaxf((a),(b)),(c))
__device__ __forceinline__ void qkt(f32x16&p0,f32x16&p1,const char*Kslot,const bf16x8*qr,int r32,int hi){
  const char*kb=Kslot+hi*1024+r32*16;
  #pragma unroll
  for(int d0=0;d0<4;++d0){
    const bf16x8 b0=*reinterpret_cast<const bf16x8*>(kb+d0*2048);
    const bf16x8 b1=*reinterpret_cast<const bf16x8*>(kb+d0*2048+512);
    p0=__builtin_amdgcn_mfma_f32_32x32x16_bf16(b0,qr[d0],p0,0,0,0);p1=__builtin_amdgcn_mfma_f32_32x32x16_bf16(b1,qr[d0],p1,0,0,0);}
}
__device__ __forceinline__ void kload8(bf16x8*kf,lds_cptr kp){
  kf[0]=*(const __attribute__((address_space(3))) bf16x8*)(kp);      kf[1]=*(const __attribute__((address_space(3))) bf16x8*)(kp+512);
  kf[2]=*(const __attribute__((address_space(3))) bf16x8*)(kp+2048); kf[3]=*(const __attribute__((address_space(3))) bf16x8*)(kp+2560);
  kf[4]=*(const __attribute__((address_space(3))) bf16x8*)(kp+4096); kf[5]=*(const __attribute__((address_space(3))) bf16x8*)(kp+4608);
  kf[6]=*(const __attribute__((address_space(3))) bf16x8*)(kp+6144); kf[7]=*(const __attribute__((address_space(3))) bf16x8*)(kp+6656);
}
__device__ __forceinline__ void kload2(bf16x8*kf,lds_cptr kp,int j){ kf[2*j]=*(const __attribute__((address_space(3))) bf16x8*)(kp+j*2048); kf[2*j+1]=*(const __attribute__((address_space(3))) bf16x8*)(kp+j*2048+512); }
__device__ __forceinline__ s16x4 vtr(lds_cptr p){ return __builtin_bit_cast(s16x4,__builtin_amdgcn_ds_read_tr16_b64_v4i16((__attribute__((address_space(3))) v4i16_t*)p)); }
__device__ __forceinline__ float rowmax(const f32x16&p0,const f32x16&p1){
  float a=MX3(p0[0],p0[1],p1[0]),b=MX3(p0[2],p0[3],p1[1]);a=MX3(a,p1[2],p1[3]);
  #pragma unroll
  for(int r=4;r<16;r+=4){a=MX3(a,p0[r],p0[r+1]);b=MX3(b,p0[r+2],p0[r+3]);a=MX3(a,p1[r],p1[r+1]);b=MX3(b,p1[r+2],p1[r+3]);}
  float m=__builtin_fmaxf(a,b);
  auto rr=__builtin_amdgcn_permlane32_swap(__float_as_uint(m),__float_as_uint(m),false,false);
  return __builtin_fmaxf(__uint_as_float(rr[0]),__uint_as_float(rr[1]));
}
__device__ __forceinline__ void pv(f32x16*o,int vb,bf16x8 pa0,bf16x8 pa1,bf16x8 pa2,bf16x8 pa3){
  #pragma unroll
  for(int d0=0;d0<2;++d0){s16x4 lo[4],hi[4];
    #pragma unroll
    for(int ks=0;ks<4;++ks){
      asm volatile("ds_read_b64_tr_b16 %0,%1 offset:%c2":"=&v"(lo[ks]):"v"(vb),"i"(d0*4096+ks*1024):"memory");
      asm volatile("ds_read_b64_tr_b16 %0,%1 offset:%c2":"=&v"(hi[ks]):"v"(vb),"i"(d0*4096+ks*1024+512):"memory");}
    asm volatile("s_waitcnt lgkmcnt(0)":::"memory");SBAR();
    #define PK(k) (bf16x8){lo[k][0],lo[k][1],lo[k][2],lo[k][3],hi[k][0],hi[k][1],hi[k][2],hi[k][3]}
    o[d0]=__builtin_amdgcn_mfma_f32_32x32x16_bf16(pa0,PK(0),o[d0],0,0,0);
    o[d0]=__builtin_amdgcn_mfma_f32_32x32x16_bf16(pa1,PK(1),o[d0],0,0,0);
    o[d0]=__builtin_amdgcn_mfma_f32_32x32x16_bf16(pa2,PK(2),o[d0],0,0,0);
    o[d0]=__builtin_amdgcn_mfma_f32_32x32x16_bf16(pa3,PK(3),o[d0],0,0,0);
    #undef PK
  }
}

#define ATTN_STORE16(p,v) (*(u32x4*)(p)=(v))
template<int MODE,int PKV,int THRL> __device__ __forceinline__ void attn_unit(const bf16*Qw0,const bf16*__restrict__ Kh,const bf16*__restrict__ Vh,bf16*Ow0,const int NT,const int q0,const int dq,const float l0,const float*__restrict__ gsrc,const float*__restrict__ rb,char*shm){
  int tid_=threadIdx.x; asm volatile("":"+v"(tid_));
  static_assert(MODE==0,"only the FoX form is instantiated: the phase-B C-init interleave reads the g copy (the window-table form is swa_unit)");
  const int tid=tid_,lane=tid&63,r32=lane&31,hi=lane>>5; const int wid=__builtin_amdgcn_readfirstlane(tid>>6);
  const bf16*Qw=Qw0+(long)(wid*QBLK)*PQ;
  const unsigned lds0=(unsigned)(uintptr_t)shm;
  float*wsf=(float*)(shm+LDS_WS)+wid*64;
  const lds_cptr shm3=(lds_cptr)shm;
  const lds_fptr gl=(lds_fptr)(shm3+LDS_GL); const lds_fptr tb=(lds_fptr)(shm3+LDS_TB);
  const bf16*ksrc=Kh+(long)lane*PKV+wid*8;
  const bf16*vsrc=Vh+(long)(16*(wid&3)+(lane>>2))*PKV+(wid>>2)*32+(lane&3)*8;
  const unsigned kdst=lds0+LDS_K+wid*1024, vdst=lds0+LDS_V+wid*1024;
  #define DMA_K(t,slot) glds16(ksrc+(long)(t)*KVBLK*PKV,(unsigned)__builtin_amdgcn_readfirstlane(kdst+(slot)))
  #define DMA_V(t,slot) glds16(vsrc+(long)(t)*KVBLK*PKV,(unsigned)__builtin_amdgcn_readfirstlane(vdst+(slot)))
  const int vb0=(int)(lds0+LDS_V)+((lane>>4)&1)*32+(lane&3)*8+(4*hi+((lane&15)>>2))*64;
  const char*Kbase=shm+LDS_K; bf16x8 kf[8];
  const lds_cptr kp0=shm3+LDS_K+hi*1024+r32*16; const lds_cptr vp0=shm3+LDS_V+((lane>>4)&1)*32+(lane&3)*8+(4*hi+((lane&15)>>2))*64;
  DMA_K(0,0);DMA_V(0,0);DMA_K(1,SLOTB);
  if(MODE==0){ const int n4=(q0+QB)>>2; for(int i=tid;i<n4;i+=NW*64) ((lds_f4ptr)gl)[i]=((const f32x4*)gsrc)[i]; }
  else{ for(int i=tid;i<640;i+=NW*64){ const int d=i-256; float v=-1e30f;
      if(d>=0&&d<128){ int bk=d; if(d>=16){ bk=16+(int)(__logf((float)d*(1.0f/16.0f))*(16.0f/2.0794415416798357f)); bk=bk>31?31:bk; } v=rb[bk*8]*LOG2E; }
      tb[i]=v; } }
  bf16x8 qr[4];
  #pragma unroll
  for(int d0=0;d0<4;++d0)qr[d0]=*reinterpret_cast<const bf16x8*>(&Qw[(long)r32*PQ+d0*16+hi*8]);
  const int qrel=wid*QBLK+r32;
  float mhat=(MODE==0)?gsrc[q0+qrel]:0.f; float l_reg=(MODE==0)?0.f:((hi==0)?l0:0.f);
  f32x16 o[2];o[0]=f32x16{};o[1]=f32x16{};
  #define CMASK(P0,P1,t) do{ if(MODE==0){int jb_=(t)-(NT-4); if(jb_>=0)cmask(P0,P1,jb_,qrel,hi);} }while(0)
  #define CINIT(X0,X1,tt) do{ if(MODE==0){ const lds_f4ptr gp_=(lds_f4ptr)(gl+64*(tt)+4*hi); \
        _Pragma("unroll") for(int g4=0;g4<4;++g4){ const f32x4 a_=gp_[2*g4], b_=gp_[8+2*g4]; \
          X0[4*g4]=a_[0]-mhat;X0[4*g4+1]=a_[1]-mhat;X0[4*g4+2]=a_[2]-mhat;X0[4*g4+3]=a_[3]-mhat; X1[4*g4]=b_[0]-mhat;X1[4*g4+1]=b_[1]-mhat;X1[4*g4+2]=b_[2]-mhat;X1[4*g4+3]=b_[3]-mhat; } } \
      else{ const lds_fptr tp_=tb+(dq+qrel-4*hi+256-64*(tt)); \
        _Pragma("unroll") for(int r=0;r<16;++r){ X0[r]=tp_[-((r&3)+8*(r>>2))]-mhat; X1[r]=tp_[-32-((r&3)+8*(r>>2))]-mhat; } } }while(0)
  bool resc=false;
  #define RESC() do{ if(resc){ asm volatile("s_waitcnt lgkmcnt(0)":::"memory"); \
      _Pragma("unroll") for(int d_=0;d_<2;++d_) _Pragma("unroll") for(int r=0;r<16;++r)o[d_][r]*=wsf[crow(r,hi)]; } }while(0)
  f32x16 pA0,pA1,pB0,pB1;
  int sl_prev=0,sl_cur=0,sl_next=SLOTB;
  #define ROT() do{sl_prev=sl_cur;sl_cur=sl_next;sl_next=(sl_next==(NSLOT-1)*SLOTB)?0:sl_next+SLOTB;}while(0)
  DMA_K(2,2*SLOTB);
  WAIT_BAR(3);
  CINIT(pA0,pA1,0);
  qkt(pA0,pA1,Kbase,qr,r32,hi);CMASK(pA0,pA1,0);
  { const float rm=rowmax(pA0,pA1);
    if(__any(rm>(float)THRL)){ const float dl=__builtin_fmaxf(rm,0.f); mhat+=dl;
      _Pragma("unroll") for(int r=0;r<16;++r){pA0[r]-=dl;pA1[r]-=dl;}
      l_reg*=__builtin_amdgcn_exp2f(-dl); }
    _Pragma("unroll") for(int r=0;r<16;++r){pA0[r]=__builtin_amdgcn_exp2f(pA0[r]);pA1[r]=__builtin_amdgcn_exp2f(pA1[r]);} }
  WAIT_BAR(0);
  DMA_K(3,0);DMA_V(1,SLOTB);
  ROT();
  kload8(kf,kp0+sl_cur);
  CINIT(pB0,pB1,1);
  WAIT_BAR(2);
  s16x4 vlo[8],vhi[8]; u32x4 pw0,pw1,pw2,pw3;
  #define PKW(P,B) cvtpk_s(P[B],P[B+1])
  #define PAF(k) __builtin_bit_cast(bf16x8,pw##k)
  #define VFR(i) (bf16x8){vlo[i][0],vlo[i][1],vlo[i][2],vlo[i][3],vhi[i][0],vhi[i][1],vhi[i][2],vhi[i][3]}
  #define PIN(x) asm volatile("":"+v"(x))
  #define GAPA(MF,A0,A1,A2,A3,W0,W1,PW) do{ MF; sacc+=A0; sacc+=A1; sacc+=A2; sacc+=A3; PIN(sacc); W0; W1; PIN(PW); SBAR(); }while(0)
  #define EX(v) __builtin_amdgcn_exp2f(v)
  #define GAPB(MF,X,B) do{ MF; X[B]=EX(X[B]); X[B+1]=EX(X[B+1]); X[B+2]=EX(X[B+2]); X[B+3]=EX(X[B+3]); PIN(X); SBAR(); }while(0)
  #define GAPB2(MF,X,B,G,LD,Y,YB,CI) do{ if(G){ LD; } MF; X[B]=EX(X[B]); X[B+1]=EX(X[B+1]); X[B+2]=EX(X[B+2]); X[B+3]=EX(X[B+3]); PIN(X); if(G){ Y[YB]=CI[0]-mhat; Y[YB+1]=CI[1]-mhat; Y[YB+2]=CI[2]-mhat; Y[YB+3]=CI[3]-mhat; PIN(Y); } SBAR(); }while(0)
  #define VRD(i) do{ vlo[i]=vtr(vp_+(((i)>>2)*4096+((i)&3)*1024)); vhi[i]=vtr(vp_+(((i)>>2)*4096+((i)&3)*1024+512)); }while(0)
  #define KRD(G,j) do{ if(G){ kload2(kf,kp0+sl_next,j); SBAR(); } }while(0)
  #define STEP(C0,C1,P0,P1,t,GK,GV,GL) do{ SBAR(); \
    const lds_cptr vp_=vp0+sl_prev; \
    VRD(0); SBAR(); float sacc=(P0[0]+P0[1]); \
    GAPA(C0=__builtin_amdgcn_mfma_f32_32x32x16_bf16(kf[0],qr[0],C0,0,0,0), P0[2],P0[3],P0[4],P0[5],     pw0[0]=PKW(P0,0), pw0[1]=PKW(P0,2), pw0); \
    VRD(4); SBAR(); GAPA(C1=__builtin_amdgcn_mfma_f32_32x32x16_bf16(kf[1],qr[0],C1,0,0,0), P0[6],P0[7],P0[8],P0[9],     pw0[2]=PKW(P0,4), pw0[3]=PKW(P0,6), pw0); \
    VRD(1); SBAR(); GAPA(C0=__builtin_amdgcn_mfma_f32_32x32x16_bf16(kf[2],qr[1],C0,0,0,0),   P0[10],P0[11],P0[12],P0[13], pw1[0]=PKW(P0,8), pw1[1]=PKW(P0,10), pw1); \
    VRD(5); SBAR(); GAPA(C1=__builtin_amdgcn_mfma_f32_32x32x16_bf16(kf[3],qr[1],C1,0,0,0),   P0[14],P0[15],P1[0],P1[1],   pw1[2]=PKW(P0,12),pw1[3]=PKW(P0,14), pw1); \
    VRD(2); SBAR(); GAPA(C0=__builtin_amdgcn_mfma_f32_32x32x16_bf16(kf[4],qr[2],C0,0,0,0),   P1[2],P1[3],P1[4],P1[5],     pw2[0]=PKW(P1,0), pw2[1]=PKW(P1,2), pw2); \
    VRD(6); SBAR(); GAPA(C1=__builtin_amdgcn_mfma_f32_32x32x16_bf16(kf[5],qr[2],C1,0,0,0),   P1[6],P1[7],P1[8],P1[9],     pw2[2]=PKW(P1,4), pw2[3]=PKW(P1,6), pw2); \
    VRD(3); SBAR(); GAPA(C0=__builtin_amdgcn_mfma_f32_32x32x16_bf16(kf[6],qr[3],C0,0,0,0),   P1[10],P1[11],P1[12],P1[13], pw3[0]=PKW(P1,8), pw3[1]=PKW(P1,10), pw3); \
    VRD(7); SBAR(); GAPA(C1=__builtin_amdgcn_mfma_f32_32x32x16_bf16(kf[7],qr[3],C1,0,0,0),   P1[14],P1[15],0.f,0.f,       pw3[2]=PKW(P1,12),pw3[3]=PKW(P1,14), pw3); \
    l_reg+=sacc; \
    if(GK){DMA_K((t)+3,sl_cur);} if(GV){DMA_V((t)+1,sl_next);} \
    CMASK(C0,C1,t); \
    { float a=MX3(C0[0],C0[1],C1[0]),b=MX3(C0[2],C0[3],C1[1]); a=MX3(a,C1[2],C1[3]); \
      _Pragma("unroll") for(int r=4;r<16;r+=4){a=MX3(a,C0[r],C0[r+1]);b=MX3(b,C0[r+2],C0[r+3]);a=MX3(a,C1[r],C1[r+1]);b=MX3(b,C1[r+2],C1[r+3]);} \
      float rm=__builtin_fmaxf(a,b); { auto rr=__builtin_amdgcn_permlane32_swap(__float_as_uint(rm),__float_as_uint(rm),false,false); rm=__builtin_fmaxf(__uint_as_float(rr[0]),__uint_as_float(rr[1])); } \
      resc=false; \
      if(__builtin_expect(__any(rm>(float)THRL),0)){ const float dl=__builtin_fmaxf(rm,0.f); mhat+=dl; \
        _Pragma("unroll") for(int r=0;r<16;++r){C0[r]-=dl;C1[r]-=dl;} \
        const float f=__builtin_amdgcn_exp2f(-dl); l_reg*=f; if(hi==0)wsf[r32]=f; resc=true; } } \
    SBAR(); \
      \
    const lds_f4ptr cig_=(lds_f4ptr)(gl+64*((t)+1)+4*hi); f32x4 cia_,cib_; \
    if(GV){ cia_=cig_[0]; } \
    GAPB2(o[0]=__builtin_amdgcn_mfma_f32_32x32x16_bf16(PAF(0),VFR(0),o[0],0,0,0), C0,0,  GV, cib_=cig_[8],  P0,0, cia_); \
    GAPB2(o[1]=__builtin_amdgcn_mfma_f32_32x32x16_bf16(PAF(0),VFR(4),o[1],0,0,0), C0,4,  GV, cia_=cig_[2],  P1,0, cib_); \
    KRD(GL,0); GAPB2(o[0]=__builtin_amdgcn_mfma_f32_32x32x16_bf16(PAF(1),VFR(1),o[0],0,0,0), C0,8,  GV, cib_=cig_[10], P0,4, cia_); \
    KRD(GL,1); GAPB2(o[1]=__builtin_amdgcn_mfma_f32_32x32x16_bf16(PAF(1),VFR(5),o[1],0,0,0), C0,12, GV, cia_=cig_[4],  P1,4, cib_); \
    KRD(GL,2); GAPB2(o[0]=__builtin_amdgcn_mfma_f32_32x32x16_bf16(PAF(2),VFR(2),o[0],0,0,0), C1,0,  GV, cib_=cig_[12], P0,8, cia_); \
    KRD(GL,3); GAPB2(o[1]=__builtin_amdgcn_mfma_f32_32x32x16_bf16(PAF(2),VFR(6),o[1],0,0,0), C1,4,  GV, cia_=cig_[6],  P1,8, cib_); \
    GAPB2(o[0]=__builtin_amdgcn_mfma_f32_32x32x16_bf16(PAF(3),VFR(3),o[0],0,0,0), C1,8,  GV, cib_=cig_[14], P0,12, cia_); \
    GAPB2(o[1]=__builtin_amdgcn_mfma_f32_32x32x16_bf16(PAF(3),VFR(7),o[1],0,0,0), C1,12, GV, (void)0,         P1,12, cib_); \
    }while(0)
  int t=1;
  #undef CMASK
  #define CMASK(P0,P1,t) do{}while(0)
  for(;t+5<NT;t+=2){
    STEP(pB0,pB1,pA0,pA1,t,true,true,true);     WAIT_BAR(2); RESC(); ROT();
    STEP(pA0,pA1,pB0,pB1,t+1,true,true,true);   WAIT_BAR(2); RESC(); ROT();
  }
  #undef CMASK
  #define CMASK(P0,P1,t) do{ if(MODE==0){int jb_=(t)-(NT-4); if(jb_>=0)cmask(P0,P1,jb_,qrel,hi);} }while(0)
  #define ENDW(tt) do{ if((tt)+3<NT){WAIT_BAR(2);} else if((tt)+2<NT){WAIT_BAR(1);} else {WAIT_BAR(0);} }while(0)
  for(;t+1<NT;t+=2){
    STEP(pB0,pB1,pA0,pA1,t,(t+3<NT),(t+1<NT),(t+1<NT));       ENDW(t);   RESC(); ROT();
    STEP(pA0,pA1,pB0,pB1,t+1,(t+4<NT),(t+2<NT),(t+2<NT));     ENDW(t+1); RESC(); ROT();
  }
  STEP(pB0,pB1,pA0,pA1,NT-1,false,false,false); RESC();
  { float sacc=pB0[0]+pB0[1]; _Pragma("unroll") for(int r=2;r<16;++r)sacc+=pB0[r]; _Pragma("unroll") for(int r=0;r<16;++r)sacc+=pB1[r]; l_reg+=sacc;
    pw0=(u32x4){PKW(pB0,0),PKW(pB0,2),PKW(pB0,4),PKW(pB0,6)};pw1=(u32x4){PKW(pB0,8),PKW(pB0,10),PKW(pB0,12),PKW(pB0,14)};pw2=(u32x4){PKW(pB1,0),PKW(pB1,2),PKW(pB1,4),PKW(pB1,6)};pw3=(u32x4){PKW(pB1,8),PKW(pB1,10),PKW(pB1,12),PKW(pB1,14)};
    SBAR(); pv(o,vb0+sl_cur,PAF(0),PAF(1),PAF(2),PAF(3)); }
  #undef PKW
  #undef PAF
  #undef VFR
  #undef PIN
  #undef GAPA
  #undef GAPB
  #undef GAPB2
  #undef EX
  #undef VRD
  #undef KRD
  #undef STEP
  #undef ENDW
  {auto rr=__builtin_amdgcn_permlane32_swap(__float_as_uint(l_reg),__float_as_uint(l_reg),false,false);l_reg=__uint_as_float(rr[0])+__uint_as_float(rr[1]);}
  if(hi==0)wsf[32+r32]=l_reg;asm volatile("s_waitcnt lgkmcnt(0)":::"memory");
  float rli[16];
  #pragma unroll
  for(int r=0;r<16;++r)rli[r]=__builtin_amdgcn_rcpf(wsf[32+crow(r,hi)]);
  bf16*Ow=Ow0+(long)(wid*QBLK)*PQ;
  { bf16*stg=(bf16*)(shm+LDS_OST)+wid*2048;
    #pragma unroll
    for(int r=0;r<16;++r){const int orow=crow(r,hi);
      #pragma unroll
      for(int d0=0;d0<2;++d0)stg[orow*64+d0*32+r32]=__float2bfloat16(o[d0][r]*rli[r]);}
    asm volatile("s_waitcnt lgkmcnt(0)":::"memory");
    #pragma unroll
    for(int i=0;i<4;++i){const int row=i*8+(lane>>3),ch=lane&7; const u32x4 v=*(const u32x4*)(stg+row*64+ch*8); ATTN_STORE16(Ow+(long)row*PQ+ch*8,v);} }
  asm volatile("s_waitcnt lgkmcnt(0)\n\ts_barrier":::"memory");
  #undef DMA_K
  #undef DMA_V
  #undef CMASK
  #undef CINIT
  #undef RESC
  #undef ROT
}

constexpr int SWA_K=0, SWA_V=49152, SWA_TB=98304, SWA_LDS_BYTES=SWA_TB+4*640*4;
__device__ __forceinline__ void swa_unit(int b,int kvh,int qb,bf16*QA,const bf16*__restrict__ KA,const bf16*__restrict__ VA,const float*__restrict__ sink,const float*__restrict__ rel_bias,char*shm){
  int tid_=threadIdx.x; asm volatile("":"+v"(tid_));
  const int tid=tid_,lane=tid&63,r32=lane&31,hi=lane>>5; const int wid=__builtin_amdgcn_readfirstlane(tid>>6);
  const lds_cptr shm3=(lds_cptr)shm; const unsigned lds0=(unsigned)(uintptr_t)shm;
  const lds_fptr tb=(lds_fptr)(shm3+SWA_TB);
  const int q0=qb*QB, T0=(qb==0)?0:4*qb-2, NT=4*qb+4-T0, dq=q0-64*T0; const size_t rb=(size_t)b*SEQ;
  { const bf16*ksrc=KA+(rb+64*T0+lane)*128+kvh*64+wid*8;
    const bf16*vsrc=VA+(rb+64*T0+16*(wid&3)+(lane>>2))*128+kvh*64+(wid>>2)*32+(lane&3)*8;
    for(int t=0;t<NT;++t){ glds16(ksrc+(long)t*KVBLK*128,(unsigned)__builtin_amdgcn_readfirstlane(lds0+SWA_K+t*SLOTB+wid*1024)); glds16(vsrc+(long)t*KVBLK*128,(unsigned)__builtin_amdgcn_readfirstlane(lds0+SWA_V+t*SLOTB+wid*1024)); } }
  for(int i=tid;i<640;i+=NW*64){ const int d=i-256; const bool in=(d>=0&&d<128); int bk=d<0?0:d; if(d>=16){ bk=16+(int)(__logf((float)d*(1.0f/16.0f))*(16.0f/2.0794415416798357f)); bk=bk>31?31:bk; }
    const float*rp=rel_bias+bk*8+4*kvh;
    #pragma unroll
    for(int hh=0;hh<4;++hh) tb[hh*640+i]=in?rp[hh]*LOG2E:-1e30f; }
  asm volatile("s_waitcnt vmcnt(0) lgkmcnt(0)\n\ts_barrier":::"memory");
  const int qrel=wid*QBLK+r32, off=dq+QBLK*wid;
  const int t_lo=(off>127)?((off-127)>>6):0, t_hi=(off+31)>>6;
  const lds_cptr kp0=shm3+SWA_K+hi*1024+r32*16; const lds_cptr vp0=shm3+SWA_V+((lane>>4)&1)*32+(lane&3)*8+(4*hi+((lane&15)>>2))*64;
  bf16x8 qn[4];
  { const bf16*Q0=QA+(rb+q0+wid*QBLK)*PQ+(4*kvh)*64;
    #pragma unroll
    for(int d0=0;d0<4;++d0)qn[d0]=*reinterpret_cast<const bf16x8*>(&Q0[(long)r32*PQ+d0*16+hi*8]); }
  #pragma unroll 1
  for(int hh=0;hh<4;++hh){
    const int hq=4*kvh+hh; bf16*Qw=QA+(rb+q0+wid*QBLK)*PQ+hq*64;
    bf16x8 qr[4];
    #pragma unroll
    for(int d0=0;d0<4;++d0)qr[d0]=qn[d0];
    { const bf16*Q1=Qw+((hh<3)?64:0);
      #pragma unroll
      for(int d0=0;d0<4;++d0)qn[d0]=*reinterpret_cast<const bf16x8*>(&Q1[(long)r32*PQ+d0*16+hi*8]); }
    const lds_fptr tp=tb+hh*640+(dq+qrel-4*hi+256);
    f32x16 s[3][2];
    #pragma unroll
    for(int k=0;k<3;++k){ const int t=t_lo+k;
      if(t<=t_hi){ const lds_fptr tq=tp-64*t;
        #pragma unroll
        for(int r=0;r<16;++r){ s[k][0][r]=tq[-((r&3)+8*(r>>2))]; s[k][1][r]=tq[-32-((r&3)+8*(r>>2))]; }
        const lds_cptr kp=kp0+t*SLOTB;
        #pragma unroll
        for(int d0=0;d0<4;++d0){ const bf16x8 a0=*(const __attribute__((address_space(3))) bf16x8*)(kp+d0*2048), a1=*(const __attribute__((address_space(3))) bf16x8*)(kp+d0*2048+512);
          s[k][0]=__builtin_amdgcn_mfma_f32_32x32x16_bf16(a0,qr[d0],s[k][0],0,0,0); s[k][1]=__builtin_amdgcn_mfma_f32_32x32x16_bf16(a1,qr[d0],s[k][1],0,0,0); } }
      else{
        #pragma unroll
        for(int r=0;r<16;++r){ s[k][0][r]=-1e30f; s[k][1][r]=-1e30f; } } }
    const float sk2=sink[hq]*LOG2E;
    float m=__builtin_fmaxf(__builtin_fmaxf(rowmax(s[0][0],s[0][1]),rowmax(s[1][0],s[1][1])),__builtin_fmaxf(rowmax(s[2][0],s[2][1]),sk2));
    float l=0.f;
    #pragma unroll
    for(int k=0;k<3;++k)
      #pragma unroll
      for(int r=0;r<16;++r){ s[k][0][r]=__builtin_amdgcn_exp2f(s[k][0][r]-m); s[k][1][r]=__builtin_amdgcn_exp2f(s[k][1][r]-m); l+=s[k][0][r]+s[k][1][r]; }
    { auto rr=__builtin_amdgcn_permlane32_swap(__float_as_uint(l),__float_as_uint(l),false,false); l=__uint_as_float(rr[0])+__uint_as_float(rr[1]); }
    l+=__builtin_amdgcn_exp2f(sk2-m);
    f32x16 o[2]; o[0]=f32x16{}; o[1]=f32x16{};
    #pragma unroll
    for(int k=0;k<3;++k){ const int t=t_lo+k;
      if(t<=t_hi){ const lds_cptr vp=vp0+t*SLOTB;
        u32x4 pw[4];
        pw[0]=(u32x4){cvtpk_s(s[k][0][0],s[k][0][1]),cvtpk_s(s[k][0][2],s[k][0][3]),cvtpk_s(s[k][0][4],s[k][0][5]),cvtpk_s(s[k][0][6],s[k][0][7])};
        pw[1]=(u32x4){cvtpk_s(s[k][0][8],s[k][0][9]),cvtpk_s(s[k][0][10],s[k][0][11]),cvtpk_s(s[k][0][12],s[k][0][13]),cvtpk_s(s[k][0][14],s[k][0][15])};
        pw[2]=(u32x4){cvtpk_s(s[k][1][0],s[k][1][1]),cvtpk_s(s[k][1][2],s[k][1][3]),cvtpk_s(s[k][1][4],s[k][1][5]),cvtpk_s(s[k][1][6],s[k][1][7])};
        pw[3]=(u32x4){cvtpk_s(s[k][1][8],s[k][1][9]),cvtpk_s(s[k][1][10],s[k][1][11]),cvtpk_s(s[k][1][12],s[k][1][13]),cvtpk_s(s[k][1][14],s[k][1][15])};
        #pragma unroll
        for(int dh=0;dh<2;++dh)
          #pragma unroll
          for(int ks=0;ks<4;++ks){ const s16x4 lo=vtr(vp+dh*4096+ks*1024), hh2=vtr(vp+dh*4096+ks*1024+512);
            const bf16x8 vf=(bf16x8){lo[0],lo[1],lo[2],lo[3],hh2[0],hh2[1],hh2[2],hh2[3]};
            o[dh]=__builtin_amdgcn_mfma_f32_32x32x16_bf16(__builtin_bit_cast(bf16x8,pw[ks]),vf,o[dh],0,0,0); } } }
    const lds_fptr wsf=(lds_fptr)(shm3+SWA_LDS_BYTES)+wid*64;
    if(hi==0)wsf[r32]=l;
    float rli[16];
    #pragma unroll
    for(int r=0;r<16;++r)rli[r]=__builtin_amdgcn_rcpf(wsf[crow(r,hi)]);
    { bf16*stg=(bf16*)(shm+SWA_LDS_BYTES+2048)+wid*2048;
      #pragma unroll
      for(int r=0;r<16;++r){const int orow=crow(r,hi);
        #pragma unroll
        for(int d0=0;d0<2;++d0)stg[orow*64+d0*32+r32]=__float2bfloat16(o[d0][r]*rli[r]);}
      #pragma unroll
      for(int i=0;i<4;++i){const int row=i*8+(lane>>3),ch=lane&7; const u32x4 v=*(const u32x4*)(stg+row*64+ch*8); *(u32x4*)(Qw+(long)row*PQ+ch*8)=v;} }
  }
  asm volatile("s_waitcnt lgkmcnt(0)\n\ts_barrier":::"memory");
}

constexpr int MEM_K=0, MEM_V=65536;
__device__ __forceinline__ void mem_unit(int b,int h,int qb,const bool prep,const unsigned char*__restrict__ MIMG,const bf16*QM,bf16*OM,char*shm,char*wsbase,char*stgbase,void*tsdbg){
  int tid_=threadIdx.x; asm volatile("":"+v"(tid_));
  const int tid=tid_,lane=tid&63,r32=lane&31,hi=lane>>5; const int wid=__builtin_amdgcn_readfirstlane(tid>>6);
  const lds_cptr shm3=(lds_cptr)shm;
  const lds_fptr wsf=(lds_fptr)((lds_cptr)wsbase)+wid*64;
  constexpr float EPSM=1e-6f;
  if(prep){ const unsigned lds0=(unsigned)(uintptr_t)shm; const unsigned char*src=MIMG+(size_t)(b*4+h)*131072+wid*1024+lane*16;
    #pragma unroll 4
    for(int i=0;i<16;++i) glds16(src+i*8192,(unsigned)__builtin_amdgcn_readfirstlane(lds0+i*8192+wid*1024)); }
  const bf16*Qw=QM+(size_t)(b*SEQ+qb*QB+wid*QBLK+r32)*PQ+h*128+hi*8;
  bf16x8 qr[8]; float qs=0.f;
  #pragma unroll
  for(int d0=0;d0<8;++d0){ qr[d0]=*reinterpret_cast<const bf16x8*>(Qw+16*d0);
    #pragma unroll
    for(int e=0;e<8;++e){ const float f=__uint_as_float(((unsigned)(unsigned short)qr[d0][e])<<16); qs+=f*f; } }
  { auto rr=__builtin_amdgcn_permlane32_swap(__float_as_uint(qs),__float_as_uint(qs),false,false); qs=__uint_as_float(rr[0])+__uint_as_float(rr[1]); }
  const float sc=1.0f/sqrtf(qs*(1.0f/128.0f)+EPSM);
  asm volatile("s_waitcnt vmcnt(0) lgkmcnt(0)\n\ts_barrier":::"memory");
#if defined(TSPROBE)
  if(prep&&threadIdx.x==0) atomicMax((unsigned long long*)tsdbg+19,(unsigned long long)__builtin_amdgcn_s_memrealtime());
#endif
  float m=-1e30f,l=0.f; f32x16 o[4]; o[0]=f32x16{};o[1]=f32x16{};o[2]=f32x16{};o[3]=f32x16{};
  const lds_cptr kp0=shm3+MEM_K+hi*4096+r32*16;
  const lds_cptr vp0=shm3+MEM_V+((lane>>4)&1)*32+(lane&3)*8+(4*hi+((lane&15)>>2))*64;
  #pragma unroll 1
  for(int t=0;t<4;++t){
    f32x16 p0=f32x16{},p1=f32x16{};
    { bf16x8 kf[16];
      #pragma unroll
      for(int d0=0;d0<8;++d0){ kf[2*d0]=*(const __attribute__((address_space(3))) bf16x8*)(kp0+d0*8192+t*1024); kf[2*d0+1]=*(const __attribute__((address_space(3))) bf16x8*)(kp0+d0*8192+t*1024+512); }
      SBAR();
      #pragma unroll
      for(int d0=0;d0<8;++d0){ p0=__builtin_amdgcn_mfma_f32_32x32x16_bf16(kf[2*d0],qr[d0],p0,0,0,0); p1=__builtin_amdgcn_mfma_f32_32x32x16_bf16(kf[2*d0+1],qr[d0],p1,0,0,0); }
      SBAR(); }
    #pragma unroll
    for(int r=0;r<16;++r){p0[r]*=sc;p1[r]*=sc;}
    const float rm=rowmax(p0,p1);
    const bool mv=(t==0)||__any(rm>m+8.0f);
    float alpha=1.0f;
    if(mv){ const float mn=__builtin_fmaxf(m,rm); alpha=__builtin_amdgcn_exp2f(m-mn); m=mn; }
    float rs=0.f;
    #pragma unroll
    for(int r=0;r<16;++r){p0[r]=__builtin_amdgcn_exp2f(p0[r]-m);p1[r]=__builtin_amdgcn_exp2f(p1[r]-m);rs+=p0[r]+p1[r];}
    l=l*alpha+rs;
    if(mv&&t!=0){
      if(hi==0)wsf[r32]=alpha;
      #pragma unroll
      for(int r=0;r<16;++r){ const float a=wsf[crow(r,hi)]; o[0][r]*=a;o[1][r]*=a;o[2][r]*=a;o[3][r]*=a; } }
    u32x4 pw0,pw1,pw2,pw3;
    pw0=(u32x4){cvtpk_s(p0[0],p0[1]),cvtpk_s(p0[2],p0[3]),cvtpk_s(p0[4],p0[5]),cvtpk_s(p0[6],p0[7])};
    pw1=(u32x4){cvtpk_s(p0[8],p0[9]),cvtpk_s(p0[10],p0[11]),cvtpk_s(p0[12],p0[13]),cvtpk_s(p0[14],p0[15])};
    pw2=(u32x4){cvtpk_s(p1[0],p1[1]),cvtpk_s(p1[2],p1[3]),cvtpk_s(p1[4],p1[5]),cvtpk_s(p1[6],p1[7])};
    pw3=(u32x4){cvtpk_s(p1[8],p1[9]),cvtpk_s(p1[10],p1[11]),cvtpk_s(p1[12],p1[13]),cvtpk_s(p1[14],p1[15])};
    const lds_cptr vp=vp0+t*16384;
    s16x4 va[8],vb[8];
    #define MEM_VRD(V,db) do{ _Pragma("unroll") for(int ks=0;ks<4;++ks){ V[2*ks]=vtr(vp+(db)*4096+ks*1024); V[2*ks+1]=vtr(vp+(db)*4096+ks*1024+512); } }while(0)
    #define MEM_VF(V,ks) (bf16x8){V[2*(ks)][0],V[2*(ks)][1],V[2*(ks)][2],V[2*(ks)][3],V[2*(ks)+1][0],V[2*(ks)+1][1],V[2*(ks)+1][2],V[2*(ks)+1][3]}
    #define MEM_PV(V,db) do{ o[db]=__builtin_amdgcn_mfma_f32_32x32x16_bf16(__builtin_bit_cast(bf16x8,pw0),MEM_VF(V,0),o[db],0,0,0); o[db]=__builtin_amdgcn_mfma_f32_32x32x16_bf16(__builtin_bit_cast(bf16x8,pw1),MEM_VF(V,1),o[db],0,0,0); \
        o[db]=__builtin_amdgcn_mfma_f32_32x32x16_bf16(__builtin_bit_cast(bf16x8,pw2),MEM_VF(V,2),o[db],0,0,0); o[db]=__builtin_amdgcn_mfma_f32_32x32x16_bf16(__builtin_bit_cast(bf16x8,pw3),MEM_VF(V,3),o[db],0,0,0); }while(0)
    MEM_VRD(va,0); SBAR();
    MEM_VRD(vb,1); MEM_PV(va,0); SBAR();
    MEM_VRD(va,2); MEM_PV(vb,1); SBAR();
    MEM_VRD(vb,3); MEM_PV(va,2); SBAR();
    MEM_PV(vb,3); SBAR();
    #undef MEM_VRD
    #undef MEM_VF
    #undef MEM_PV
  }
  { auto rr=__builtin_amdgcn_permlane32_swap(__float_as_uint(l),__float_as_uint(l),false,false); l=__uint_as_float(rr[0])+__uint_as_float(rr[1]); }
  if(hi==0)wsf[32+r32]=l;
  bf16*Ow=OM+(size_t)(b*SEQ+qb*QB+wid*QBLK)*PQ+h*128;
  { bf16*stg=(bf16*)stgbase+wid*1024;
    #pragma unroll
    for(int g=0;g<4;++g){
      #pragma unroll
      for(int j=0;j<4;++j){ const int r=4*g+j; const float rl=__builtin_amdgcn_rcpf(wsf[32+crow(r,hi)]);
        #pragma unroll
        for(int db=0;db<4;++db) stg[(4*hi+j)*128+32*db+r32]=__float2bfloat16(o[db][r]*rl); }
      #pragma unroll
      for(int i=0;i<2;++i){ const int row=i*4+(lane>>4),ch=lane&15; const u32x4 v=*(const u32x4*)(stg+row*128+ch*8); *(u32x4*)(Ow+(size_t)(8*g+row)*PQ+ch*8)=v; } } }
  __syncthreads();
}
#undef SBAR
#undef WAIT_BAR
#undef MX3
}

constexpr int NWAVES = 8;
constexpr int SEQ = 4096, NBATCH = 8, MTOK = NBATCH * SEQ, MMEM = NBATCH * 256;
constexpr int NIN_ARGS = 23;
enum InIdx { I_X = 0, I_MEM, I_GMIX, I_WIN, I_BGATE, I_BFORGET, I_QNSWA, I_KNSWA, I_SINK, I_RELBIAS, I_QNFOX, I_KNFOX, I_GMEM, I_WMEMKV, I_QNMEM, I_KNMEM, I_WOSWA, I_WOFOX, I_WOMEM, I_WOUT, I_GMLP, I_WUP, I_WDN };
constexpr size_t MiB = 1u << 20;
#if defined(TSPROBE) || (defined(DETPROBE) && DETPROBE)
constexpr size_t WS_CTL = 0, CTL_ZERO_BYTES = 128 * 1024;
#else
constexpr size_t WS_CTL = 0, CTL_ZERO_BYTES = 32 * 1024;
#endif
constexpr size_t WS_WIN = 2 * MiB, WS_WKV = 14 * MiB, WS_WO = 16 * MiB, WS_WOUT = 19 * MiB, WS_WUP = 25 * MiB, WS_WD = 33 * MiB;
constexpr size_t WS_LOGF = 41 * MiB, WS_G2 = 42 * MiB, WS_SSQ = 43 * MiB, WS_MEMN = 45 * MiB, WS_MKV = 49 * MiB, WS_RINV = 57 * MiB;
constexpr size_t WS_MRG = 160 * MiB;
constexpr size_t WS_GT = 64 * MiB;
constexpr size_t WS_H = 256 * MiB;
constexpr size_t WS_U = 64 * MiB;
constexpr size_t WS_QCAT = 320 * MiB, WS_KA = 416 * MiB, WS_VA = 424 * MiB, WS_KF = 432 * MiB, WS_VF = 464 * MiB;
constexpr size_t WS_X1B = 320 * MiB;
constexpr size_t WS_END = 496 * MiB;
constexpr int CW_FOXQ = 2048;
constexpr int CW_BAR = 4096;
constexpr int RING_OFF = 0, RING_BYTES = 131072;
constexpr int ATT_EXTRA_OFF = RING_BYTES;
constexpr int LDSCTL_OFF = 159744, MISC_OFF = LDSCTL_OFF + 320, MEMWS_OFF = LDSCTL_OFF + 1024, DUMP_OFF = LDSCTL_OFF + 3072;
constexpr int LDS_BYTES = 163840;
static_assert((CW_BAR + 3456) * 4 <= (int)CTL_ZERO_BYTES && DUMP_OFF + 256 <= LDS_BYTES && pg8::STAGE_BYTES == RING_BYTES && MEMWS_OFF + 2048 <= DUMP_OFF && attn_body::LDS_BYTES <= RING_BYTES && attn_body::SWA_LDS_BYTES + 2048 + 32768 <= LDSCTL_OFF && ATT_EXTRA_OFF + 92 * 64 * 4 + 4096 <= LDSCTL_OFF, "LDS map");
#define GAS __attribute__((address_space(1)))
#define LAS __attribute__((address_space(3)))
typedef unsigned short bf16;
typedef unsigned v4u __attribute__((ext_vector_type(4)));
typedef float f32x4 __attribute__((ext_vector_type(4)));
typedef short bf16x8 __attribute__((ext_vector_type(8)));
typedef GAS unsigned gu32;
typedef GAS unsigned long long gu64;
#define RLX_AGENT __ATOMIC_RELAXED, __HIP_MEMORY_SCOPE_AGENT
#define LDS_WAIT() asm volatile("s_waitcnt lgkmcnt(0)" ::: "memory")
#define VM_WAIT() asm volatile("s_waitcnt vmcnt(0)" ::: "memory")
__device__ __forceinline__ unsigned long long rt() { return __builtin_amdgcn_s_memrealtime(); }
__device__ __forceinline__ unsigned f2bf(float f) { unsigned u = __builtin_bit_cast(unsigned, f); return (u + 0x7fffu + ((u >> 16) & 1u)) >> 16; }
__device__ __forceinline__ unsigned pk2(float lo, float hi) { return f2bf(lo) | (f2bf(hi) << 16); }

#define XB_TMO      128
#define XB_XCNT(j)  (256  + 64 * (j))
#define XB_XSUB(j)  (1280 + 64 * (j))
#define XB_XGEN(j)  (2304 + 64 * (j))
#define XB_TOP      3328
#define XB_TOPGEN   3392
#define XCD_BAR_WORDS 3456
#define XB_SPIN_CAP (1u << 18)

__device__ __forceinline__ unsigned xb_ld(unsigned* p)              { return __hip_atomic_load(p, __ATOMIC_RELAXED, __HIP_MEMORY_SCOPE_AGENT); }
__device__ __forceinline__ unsigned xb_add(unsigned* p, unsigned v) { return __hip_atomic_fetch_add(p, v, __ATOMIC_RELAXED, __HIP_MEMORY_SCOPE_AGENT); }
__device__ __forceinline__ unsigned xb_xcc_id() { return (unsigned)__builtin_amdgcn_s_getreg((3 << 11) | 20) & 0xFu; }
#define XB_SPIN(cond, bar) do { unsigned _sp = 0; while (cond) { __builtin_amdgcn_s_sleep(1); \
    if ((++_sp & 255u) == 0u) { if (xb_ld(&(bar)[XB_TMO])) break; if (_sp > XB_SPIN_CAP) { atomicAdd(&(bar)[XB_TMO], 1u); break; } } } } while (0)

struct XcdBarrier {
    unsigned* bar; unsigned x;
    volatile LAS unsigned* st;
};

__device__ __forceinline__ XcdBarrier xcd_barrier_post(unsigned* bar, volatile LAS unsigned* st) {
    XcdBarrier b; b.bar = bar; b.x = xb_xcc_id(); b.st = st;
    if (threadIdx.x == 0) (void)xb_add(&bar[XB_XCNT(b.x)], 1u);
    return b;
}
__device__ __forceinline__ void xcd_barrier_complete(unsigned* bar, unsigned x, unsigned& nloc, unsigned& nx) {
    const unsigned G = gridDim.x * gridDim.y * gridDim.z;
    unsigned sum, cnt, mine, sp = 0u;
    for (;;) {
        sum = 0u; cnt = 0u; mine = 0u;
#pragma unroll
        for (unsigned j = 0; j < 16; ++j) { const unsigned c = xb_ld(&bar[XB_XCNT(j)]); sum += c; cnt += (c > 0u) ? 1u : 0u; mine = (j == x) ? c : mine; }
        if (sum == G) break;
        __builtin_amdgcn_s_sleep(1);
        if ((++sp & 255u) == 0u) { if (xb_ld(&bar[XB_TMO])) break; if (sp > XB_SPIN_CAP) { atomicAdd(&bar[XB_TMO], 1u); break; } }
    }
    nloc = mine > 0u ? mine : 1u; nx = cnt > 0u ? cnt : 1u;
}

__device__ __forceinline__ void xcd_barrier(const XcdBarrier& b) {
    asm volatile("s_waitcnt vmcnt(0)" ::: "memory");
    __syncthreads();
    if (threadIdx.x == 0) {
        unsigned* bar = b.bar;
        __builtin_amdgcn_s_waitcnt(0);
        unsigned nloc = b.st[0], nx = b.st[1];
        if (nloc == 0u) { xcd_barrier_complete(bar, b.x, nloc, nx); b.st[0] = nloc; b.st[1] = nx; }
        const unsigned old = xb_add(&bar[XB_XSUB(b.x)], 1u);
        const unsigned gen = old / nloc;
        if (old + 1u == (gen + 1u) * nloc) {
            __builtin_amdgcn_fence(__ATOMIC_RELEASE, "agent");
            asm volatile("s_waitcnt vmcnt(0)" ::: "memory");
            const unsigned og = xb_add(&bar[XB_TOP], 1u);
            const unsigned tg = og / nx;
            if (og + 1u == (tg + 1u) * nx) xb_add(&bar[XB_TOPGEN], 1u);
            else XB_SPIN(xb_ld(&bar[XB_TOPGEN]) == tg, bar);
            __builtin_amdgcn_fence(__ATOMIC_ACQUIRE, "agent");
            xb_add(&bar[XB_XGEN(b.x)], 1u);
            asm volatile("s_waitcnt vmcnt(0)" ::: "memory");
        } else {
            XB_SPIN(xb_ld(&bar[XB_XGEN(b.x)]) == gen, bar);
            __builtin_amdgcn_fence(__ATOMIC_ACQUIRE, "agent");
            asm volatile("s_waitcnt vmcnt(0)" ::: "memory");
        }
    }
    __syncthreads();
}

#if defined(DETPROBE) && DETPROBE
constexpr size_t WS_CHK = 57 * MiB;
__global__ void chk_sum(const unsigned* p, size_t nwords, unsigned long long* dst) {
    unsigned long long s = 0; const size_t stride = (size_t)gridDim.x * blockDim.x;
    for (size_t i = (size_t)blockIdx.x * blockDim.x + threadIdx.x; i < nwords; i += stride) s += (unsigned long long)p[i] * (unsigned long long)((i & 1023) + 1);
#pragma unroll
    for (int o = 32; o > 0; o >>= 1) s += __shfl_xor(s, o);
    if ((threadIdx.x & 63) == 0) atomicAdd(dst, s);
}
__global__ void chk_report(const unsigned long long* chk, float* out, int nslots, size_t n) {
    float mk = 0.f; for (int s = 0; s < nslots; ++s) if (chk[s] != chk[64 + s]) { mk = 1000.0f * (float)(s + 1); break; }
    const size_t stride = (size_t)gridDim.x * blockDim.x;
    for (size_t i = (size_t)blockIdx.x * blockDim.x + threadIdx.x; i < n; i += stride) out[i] = (i == 0) ? mk : 0.f;
}
#endif


struct Frame {
    LAS unsigned char* lds;
    volatile LAS unsigned* MISC;
    gu32* ctl;
    int tid, lane, wave;
    int vcu, G;
    const float *x, *mem, *w_in, *w_mem_kv, *w_o_swa, *w_o_fox, *w_o_mem, *w_out, *w_up, *w_dn, *g_mix, *g_mlp, *g_mem, *b_forget;
    float* out; unsigned char* ws;
};

__device__ __forceinline__ float wave_sum(float v) {
#pragma unroll
    for (int o = 1; o < 64; o <<= 1) v += __shfl_xor(v, o);
    return v;
}
typedef float f32x2_t __attribute__((ext_vector_type(2))); typedef __bf16 bf16x2_t __attribute__((ext_vector_type(2)));
__device__ __forceinline__ unsigned pkc(float lo, float hi) { f32x2_t v = {lo, hi}; bf16x2_t b = __builtin_convertvector(v, bf16x2_t); return __builtin_bit_cast(unsigned, b); }
__device__ __forceinline__ void p0_tr_item(const float* __restrict__ W, int ldw, int k0, int n0, bf16* WT, int ldt, int drow_lane, int dk0, const float* __restrict__ kscale, int lane) {
    const int c4 = lane & 7, kg = lane >> 3;
    const float* src = W + (size_t)(k0 + 8 * kg) * ldw + n0 + 4 * c4;
    f32x4 r[8];
#pragma unroll
    for (int i = 0; i < 8; ++i) r[i] = *(const GAS f32x4*)(src + (size_t)i * ldw);
    if (kscale) { const f32x4 s0 = *(const GAS f32x4*)(kscale + k0 + 8 * kg), s1 = *(const GAS f32x4*)(kscale + k0 + 8 * kg + 4);
#pragma unroll
        for (int i = 0; i < 4; ++i) { r[i] = r[i] * s0[i]; r[4 + i] = r[4 + i] * s1[i]; } }
    bf16* dst = WT + (size_t)drow_lane * ldt + dk0 + k0 + 8 * kg;
#pragma unroll
    for (int e = 0; e < 4; ++e) { v4u o; o.x = pkc(r[0][e], r[1][e]); o.y = pkc(r[2][e], r[3][e]); o.z = pkc(r[4][e], r[5][e]); o.w = pkc(r[6][e], r[7][e]); *(GAS v4u*)(dst + (size_t)e * ldt) = o; }
}
__device__ __forceinline__ int in_srcbase(int g) {
    return g < 8 ? 64 * g : g < 10 ? 512 + 64 * (g - 8) : g < 12 ? 640 + 64 * (g - 10) : g < 20 ? 768 + 64 * (g - 12) : g < 28 ? 1280 + 64 * (g - 20) : g < 36 ? 1792 + 64 * (g - 28) : g < 44 ? 2312 + 64 * (g - 36) : 2824 + 64 * (g - 44);
}
__device__ __forceinline__ float rms_row_to_bf16(const f32x4 (&v)[4], const f32x4 (&gn)[4], bf16* orow, int lane, f32x4 (&vg)[4], float* rinv) {
    float s = 0.f;
#pragma unroll
    for (int j = 0; j < 4; ++j) s += (v[j].x * v[j].x + v[j].y * v[j].y) + (v[j].z * v[j].z + v[j].w * v[j].w);
    const float rt2 = sqrtf(wave_sum(s) * (1.f / 1024.f) + 1e-6f); const float r = 1.f / rt2;
    if (rinv && lane == 0) *rinv = rt2;
    GAS unsigned long long* o8 = (GAS unsigned long long*)orow + lane;
#pragma unroll
    for (int j = 0; j < 4; ++j) { vg[j] = v[j] * gn[j]; const f32x4 y = vg[j] * r; o8[64 * j] = (unsigned long long)pkc(y.x, y.y) | ((unsigned long long)pkc(y.z, y.w) << 32); }
    return r;
}
__device__ __forceinline__ int adj_row(int n) { return 128 * ((n >> 3) & 1) + 32 * (n >> 6) + 8 * ((n & 63) >> 4) + (n & 7); }
constexpr int I_IN = 16 * 184, I_KV = 16 * 32, I_O1 = 8 * 32, I_OUT = 16 * 32, I_UP = 16 * 128, I_DN = 64 * 32;
constexpr int I_EARLY = I_IN + I_KV, NITEMS = I_IN + I_KV + 3 * I_O1 + I_OUT + I_UP + I_DN;
struct WItem { size_t dst; int ldt, ksc; };
__device__ __forceinline__ WItem witem_fetch(const Frame& F, int it, f32x4 (&rr)[8]) {
    const int c4 = F.lane & 7, kg = F.lane >> 3;
    WItem w; w.ksc = -1;
#define WI_LOAD(Wp_, ldw_, k0_, n0_) do { const float* sp_ = (Wp_) + (size_t)((k0_) + 8 * kg) * (ldw_) + (n0_) + 4 * c4; _Pragma("unroll") for (int i = 0; i < 8; ++i) rr[i] = *(const GAS f32x4*)(sp_ + (size_t)i * (ldw_)); } while (0)
#define WI_DST(ws_off_, ldt_, drow_, dk_) do { w.ldt = (ldt_); w.dst = (size_t)(ws_off_) / 2 + (size_t)(drow_) * (ldt_) + (dk_) + 8 * kg; } while (0)
    int r = it;
    if (r < I_IN) { const int kb = r / 184, gg = r % 184, g = gg >> 1, bj = gg & 1;
        const int drow = 256 * (g >> 2) + ((g >= 44) ? adj_row(64 * (g & 3) + 32 * bj + 4 * c4) : 128 * bj + 32 * (g & 3) + 4 * c4);
        WI_LOAD(F.w_in, 5896, 64 * kb, in_srcbase(g) + 32 * bj); WI_DST(WS_WIN, 1024, drow, 64 * kb); return w; } r -= I_IN;
    if (r < I_KV) { WI_LOAD(F.w_mem_kv, 1024, 64 * (r / 32), 32 * (r % 32)); WI_DST(WS_WKV, 1024, 32 * (r % 32) + 4 * c4, 64 * (r / 32)); return w; } r -= I_KV;
    if (r < I_O1) { WI_LOAD(F.w_o_swa, 1024, 64 * (r / 32), 32 * (r % 32)); WI_DST(WS_WO, 1536, 256 * ((r % 32) >> 3) + adj_row(32 * ((r % 32) & 7) + 4 * c4), 64 * (r / 32)); return w; } r -= I_O1;
    if (r < I_O1) { WI_LOAD(F.w_o_fox, 1024, 64 * (r / 32), 32 * (r % 32)); WI_DST(WS_WO, 1536, 256 * ((r % 32) >> 3) + adj_row(32 * ((r % 32) & 7) + 4 * c4), 512 + 64 * (r / 32)); return w; } r -= I_O1;
    if (r < I_O1) { WI_LOAD(F.w_o_mem, 1024, 64 * (r / 32), 32 * (r % 32)); WI_DST(WS_WO, 1536, 256 * ((r % 32) >> 3) + adj_row(32 * ((r % 32) & 7) + 4 * c4), 1024 + 64 * (r / 32)); return w; } r -= I_O1;
    if (r < I_OUT) { WI_LOAD(F.w_out, 1024, 64 * (r / 32), 32 * (r % 32)); WI_DST(WS_WOUT, 1024, 32 * (r % 32) + 4 * c4, 64 * (r / 32)); return w; } r -= I_OUT;
    if (r < I_UP) { WI_LOAD(F.w_up, 4096, 64 * (r / 128), 32 * (r % 128)); WI_DST(WS_WUP, 1024, 32 * (r % 128) + 4 * c4, 64 * (r / 128)); w.ksc = 64 * (r / 128) + 8 * kg; return w; } r -= I_UP;
    WI_LOAD(F.w_dn, 1024, 64 * (r / 32), 32 * (r % 32)); WI_DST(WS_WD, 4096, 32 * (r % 32) + 4 * c4, 64 * (r / 32));
#undef WI_LOAD
#undef WI_DST
    return w;
}
__device__ __forceinline__ void witem_store(const Frame& F, const WItem& w, f32x4 (&r)[8]) {
    if (w.ksc >= 0) { const f32x4 s0 = *(const GAS f32x4*)(F.g_mlp + w.ksc), s1 = *(const GAS f32x4*)(F.g_mlp + w.ksc + 4);
#pragma unroll
        for (int i = 0; i < 4; ++i) { r[i] = r[i] * s0[i]; r[4 + i] = r[4 + i] * s1[i]; } }
    bf16* dst = (bf16*)F.ws + w.dst;
#pragma unroll
    for (int e = 0; e < 4; ++e) { v4u o; o.x = pkc(r[0][e], r[1][e]); o.y = pkc(r[2][e], r[3][e]); o.z = pkc(r[4][e], r[5][e]); o.w = pkc(r[6][e], r[7][e]); *(GAS v4u*)(dst + (size_t)e * w.ldt) = o; }
}
__device__ __forceinline__ void weight_items(Frame& F, int lo, int hi, int widx, int nw) {
    for (int it = lo + widx; it < hi; it += 2 * nw) {
        const int it2 = it + nw; const bool two = it2 < hi;
        f32x4 ra[8], rb[8];
        const WItem a = witem_fetch(F, it, ra), b = witem_fetch(F, two ? it2 : it, rb);
        witem_store(F, a, ra);
        if (two) witem_store(F, b, rb);
    }
}
__device__ __forceinline__ float lane_xor(float v, int d) { return __shfl_xor(v, d); }
__device__ __forceinline__ void p0_trip(const Frame& F, f32x4 (&v)[4][4], const f32x4 (&gn)[4], int m0, int mstep, int msafe, LAS const f32x4* wl, float bsel, bf16* H, float* LOGF, float* RINV) {
    const int lane = F.lane; const bool h5 = (lane & 32) != 0, h4 = (lane & 16) != 0, h3 = (lane & 8) != 0, h2 = (lane & 4) != 0, h1 = (lane & 2) != 0;
    float r[4];
    {   float s[4];
#pragma unroll
        for (int q = 0; q < 4; ++q) { s[q] = 0.f;
#pragma unroll
            for (int j = 0; j < 4; ++j) s[q] += (v[q][j].x * v[q][j].x + v[q][j].y * v[q][j].y) + (v[q][j].z * v[q][j].z + v[q][j].w * v[q][j].w); }
        float k0 = (h5 ? s[2] : s[0]) + lane_xor(h5 ? s[0] : s[2], 32), k1 = (h5 ? s[3] : s[1]) + lane_xor(h5 ? s[1] : s[3], 32);
        float k = (h4 ? k1 : k0) + lane_xor(h4 ? k0 : k1, 16);
        k += lane_xor(k, 8); k += lane_xor(k, 4); k += lane_xor(k, 2); k += lane_xor(k, 1);
#pragma unroll
        for (int q = 0; q < 4; ++q) { const float tot = __int_as_float(__builtin_amdgcn_readlane(__float_as_int(k), 16 * q)); const float rt2 = sqrtf(tot * (1.f / 1024.f) + 1e-6f); r[q] = 1.f / rt2;
            const int mq = m0 + q * mstep; const bool ok = mq < MTOK;
            if (ok && lane == 0) RINV[mq] = rt2;
            GAS unsigned long long* o8 = (GAS unsigned long long*)(H + (size_t)(ok ? mq : msafe) * 1024) + lane;
#pragma unroll
            for (int j = 0; j < 4; ++j) { v[q][j] = v[q][j] * gn[j]; const f32x4 y = v[q][j] * r[q]; if (ok) o8[64 * j] = (unsigned long long)pkc(y.x, y.y) | ((unsigned long long)pkc(y.z, y.w) << 32); } }
    }
    float val[32];
#pragma unroll
    for (int i = 0; i < 32; ++i) val[i] = 0.f;
    LAS const f32x4* wl_ = wl + lane; asm volatile("" : "+v"(wl_));
#pragma unroll
    for (int j = 0; j < 4; ++j) {
#pragma unroll
        for (int e = 0; e < 4; ++e) { const f32x4 wa = wl_[(j * 4 + e) * 64], wb = wl_[1024 + (j * 4 + e) * 64];
#pragma unroll
            for (int q = 0; q < 4; ++q) { const float xv = v[q][j][e];
#pragma unroll
                for (int c = 0; c < 4; ++c) { val[8 * q + c] += wa[c] * xv; val[8 * q + 4 + c] += wb[c] * xv; } } }
        asm volatile("" ::: "memory");
    }
#define P0_RS(n_, h_, d_) do { _Pragma("unroll") for (int i = 0; i < (n_); ++i) val[i] = ((h_) ? val[i + (n_)] : val[i]) + lane_xor((h_) ? val[i] : val[i + (n_)], (d_)); } while (0)
    P0_RS(16, h5, 32); P0_RS(8, h4, 16); P0_RS(4, h3, 8); P0_RS(2, h2, 4); P0_RS(1, h1, 2);
#undef P0_RS
    float z = val[0] + lane_xor(val[0], 1);
    const float rsel = h5 ? (h4 ? r[3] : r[2]) : (h4 ? r[1] : r[0]);
    z = z * rsel + bsel;
    z = fminf(z, 0.f) - log1pf(expf(-fabsf(z)));
    const int mq = m0 + (lane >> 4) * mstep;
    if (mq < MTOK && (lane & 1) == 0) LOGF[(size_t)mq * 8 + ((lane >> 1) & 7)] = z;
}
__device__ __forceinline__ void p0_prologue(Frame& F) {
    const float* x = F.x; const float* mem = F.mem; const float* w_in = F.w_in;
    const int gw = F.vcu * NWAVES + F.wave, NGW = F.G * NWAVES;
    bf16* H = (bf16*)(F.ws + WS_H); float* LOGF = (float*)(F.ws + WS_LOGF); float* RINV = (float*)(F.ws + WS_RINV); bf16* MEMN = (bf16*)(F.ws + WS_MEMN);
    LAS f32x4* wl = (LAS f32x4*)(F.lds + RING_OFF);
    f32x4 wreg[4];
#pragma unroll
    for (int q = 0; q < 4; ++q) { const int i = F.tid + NWAVES * 64 * q, h = i >> 10, je = (i >> 6) & 15, l = i & 63, k = 4 * l + 256 * (je >> 2) + (je & 3); wreg[q] = *(const GAS f32x4*)(w_in + (size_t)k * 5896 + 2304 + 4 * h); }
    f32x4 va[4][4], vb[4][4];
#define P0_LOAD(v_, m0_) do { _Pragma("unroll") for (int q = 0; q < 4; ++q) { const int mq_ = (m0_) + q * NGW; const GAS f32x4* xp_ = (const GAS f32x4*)(x + (size_t)(mq_ < MTOK ? mq_ : gw) * 1024) + F.lane; \
        _Pragma("unroll") for (int j = 0; j < 4; ++j) v_[q][j] = xp_[64 * j]; } } while (0)
    f32x4 gn[4];
#pragma unroll
    for (int j = 0; j < 4; ++j) gn[j] = ((const GAS f32x4*)F.g_mix)[F.lane + 64 * j];
#pragma unroll
    for (int q = 0; q < 4; ++q) wl[F.tid + NWAVES * 64 * q] = wreg[q];
    {
        f32x4 gm[4];
#pragma unroll
        for (int j = 0; j < 4; ++j) gm[j] = ((const GAS f32x4*)F.g_mem)[F.lane + 64 * j];
        for (int m = gw; m < MMEM; m += NGW) { f32x4 v[4], vg[4];
#pragma unroll
            for (int j = 0; j < 4; ++j) v[j] = ((const GAS f32x4*)(mem + (size_t)m * 1024))[F.lane + 64 * j];
            (void)rms_row_to_bf16(v, gm, MEMN + (size_t)m * 1024, F.lane, vg, nullptr); }
    }
    weight_items(F, 0, (F.G == 256) ? I_EARLY : NITEMS, gw, NGW);
#if defined(TSPROBE)
    if (threadIdx.x == 0) atomicMax((unsigned long long*)(F.ws + 65536) + 8, rt());
#endif
    P0_LOAD(va, gw);
    __syncthreads();
    const float bsel = F.b_forget[(F.lane >> 1) & 7];
    for (int m = gw; m < MTOK; m += 8 * NGW) {
        const int m2 = m + 4 * NGW;
        if (m2 < MTOK) P0_LOAD(vb, m2);
        p0_trip(F, va, gn, m, NGW, gw, wl, bsel, H, LOGF, RINV);
        if (m2 >= MTOK) break;
        const int m3 = m2 + 4 * NGW;
        if (m3 < MTOK) P0_LOAD(va, m3);
        p0_trip(F, vb, gn, m2, NGW, gw, wl, bsel, H, LOGF, RINV);
    }
#undef P0_LOAD
#if defined(TSPROBE)
    if (threadIdx.x == 0) atomicMax((unsigned long long*)(F.ws + 65536) + 9, rt());
#endif
    __syncthreads();
}
__device__ __forceinline__ void p1_scan(Frame& F) {
    if (F.vcu >= 64) return;
    const int seq = F.vcu;
    const float* LOGF = (const float*)(F.ws + WS_LOGF); float* G2 = (float*)(F.ws + WS_G2);
    const int b = seq >> 3, h = seq & 7, s0 = 8 * F.tid;
    float a[8]; float run = 0.f;
#pragma unroll
    for (int i = 0; i < 8; ++i) { run += LOGF[((size_t)(b * SEQ + s0 + i)) * 8 + h]; a[i] = run; }
    float sc = run;
#pragma unroll
    for (int o = 1; o < 64; o <<= 1) { const float y = __shfl_up(sc, o); if (F.lane >= o) sc += y; }
    volatile LAS float* wt = (volatile LAS float*)(F.MISC + 16);
    if (F.lane == 63) wt[F.wave] = sc;
    __syncthreads();
    float woff = 0.f;
#pragma unroll
    for (int w = 0; w < NWAVES; ++w) woff += (w < F.wave) ? wt[w] : 0.f;
    const float off = woff + (sc - run);
    f32x4 o0, o1;
#pragma unroll
    for (int i = 0; i < 4; ++i) { o0[i] = -(a[i] + off) * 1.4426950408889634f; o1[i] = -(a[4 + i] + off) * 1.4426950408889634f; }
    GAS f32x4* gp = (GAS f32x4*)(G2 + (size_t)seq * SEQ + s0); gp[0] = o0; gp[1] = o1;
    __syncthreads();
}

struct Args { const float* in[NIN_ARGS]; float* out; unsigned char* ws; int ph_lo, ph_hi; };
__global__ void __launch_bounds__(NWAVES * 64, 2) mega_fwd(Args args) {
    extern __shared__ __attribute__((aligned(16))) unsigned char lds[];
    Frame F;
    F.lds = (LAS unsigned char*)lds;
    F.MISC = (volatile LAS unsigned*)(F.lds + MISC_OFF);
    F.tid = threadIdx.x; F.lane = F.tid & 63; F.wave = __builtin_amdgcn_readfirstlane(F.tid >> 6);
    F.G = gridDim.x; { const int bx = blockIdx.x; F.vcu = (F.G % 8 == 0) ? (bx % 8) * (F.G / 8) + bx / 8 : bx; }
    unsigned char* ws = args.ws; F.ws = ws; F.out = args.out;
    F.x = args.in[I_X]; F.mem = args.in[I_MEM]; F.w_in = args.in[I_WIN]; F.w_mem_kv = args.in[I_WMEMKV]; F.w_o_swa = args.in[I_WOSWA]; F.w_o_fox = args.in[I_WOFOX]; F.w_o_mem = args.in[I_WOMEM];
    F.w_out = args.in[I_WOUT]; F.w_up = args.in[I_WUP]; F.w_dn = args.in[I_WDN]; F.g_mix = args.in[I_GMIX]; F.g_mlp = args.in[I_GMLP]; F.g_mem = args.in[I_GMEM]; F.b_forget = args.in[I_BFORGET];
    F.ctl = (gu32*)(ws + WS_CTL);
    for (int u = F.tid; u < (LDS_BYTES - LDSCTL_OFF) / 4; u += NWAVES * 64) ((LAS unsigned*)(F.lds + LDSCTL_OFF))[u] = 0u;
    __syncthreads();
    const int lo = args.ph_lo, hi = args.ph_hi;
    const bool use_bar = (hi - lo) > 1;
    XcdBarrier bar; bar.bar = (unsigned*)(F.ctl + CW_BAR); bar.x = 0; bar.st = nullptr;
    if (use_bar) bar = xcd_barrier_post((unsigned*)(F.ctl + CW_BAR), F.MISC + 8);
#if defined(TSPROBE)
#define STAMP(k) do { if (blockIdx.x == 0 && threadIdx.x == 0) { ((unsigned long long*)(args.ws + 65536))[k] = rt(); ((unsigned long long*)(args.ws + 65536))[32 + (k)] = __builtin_amdgcn_s_memtime(); } } while (0)
#else
#define STAMP(k) do {} while (0)
#endif
    STAMP(0);
#define IN(k) (lo <= (k) && (k) < hi)
#define BOTH(k) (IN(k) && IN((k) + 1))
#define GRID_BAR() xcd_barrier(bar)

    bf16* Win_t = (bf16*)(ws + WS_WIN); bf16* Wkv_t = (bf16*)(ws + WS_WKV); bf16* Wo_t = (bf16*)(ws + WS_WO); bf16* Wout_t = (bf16*)(ws + WS_WOUT); bf16* Wup_t = (bf16*)(ws + WS_WUP); bf16* Wd_t = (bf16*)(ws + WS_WD);
    bf16* H = (bf16*)(ws + WS_H); bf16* GT = (bf16*)(ws + WS_GT); bf16* U = (bf16*)(ws + WS_U); bf16* X1B = (bf16*)(ws + WS_X1B); bf16* MEMN = (bf16*)(ws + WS_MEMN);
    bf16* QCAT = (bf16*)(ws + WS_QCAT); bf16* QA = QCAT; bf16* QF = QCAT + 512; bf16* QM = QCAT + 1024; bf16* MRG = (bf16*)(ws + WS_MRG);
    bf16* KA = (bf16*)(ws + WS_KA); bf16* VA = (bf16*)(ws + WS_VA); bf16* KF = (bf16*)(ws + WS_KF); bf16* VF = (bf16*)(ws + WS_VF);
    unsigned char* MIMG = ws + WS_MKV; float* SSQ = (float*)(ws + WS_SSQ); float* G2 = (float*)(ws + WS_G2);

    if (IN(0)) { p0_prologue(F); if (BOTH(0)) GRID_BAR(); STAMP(1); }

    if (IN(1)) {
        p1_scan(F);
        pg8::Sched S; S.init(MTOK, 5888, 1024, F.G, (int)blockIdx.x, H, Win_t); S.tsbase = (void*)(ws + 65536);
        { LAS float* tab = (LAS float*)(F.lds + ATT_EXTRA_OFF);
          for (int i = F.tid; i < 92 * 64; i += NWAVES * 64) { const int g = i >> 6, c = i & 63; float v = 0.f;
              if (g < 8) v = args.in[I_QNSWA][c] * pg8::kC2_64; else if (g < 10) v = args.in[I_KNSWA][c]; else if (g >= 12 && g < 20) v = args.in[I_QNFOX][c] * pg8::kC2_64; else if (g >= 20 && g < 28) v = args.in[I_KNFOX][c];
              else if (g == 28 || g == 29) v = args.in[I_KNMEM][i - 28 * 64] * args.in[I_QNMEM][i - 28 * 64] * (0.08838834764831845f * 1.4426950408889634f);
              else if (g >= 44) v = args.in[I_BGATE][i - 44 * 64];
              tab[i] = v; }
          __syncthreads(); }
        pg8::EpiInProj E{QA, KA, VA, QF, KF, VF, QM, (unsigned char*)GT, (LAS const float*)(F.lds + ATT_EXTRA_OFF)};
        pg8::gemm_phase<pg8::EpiInProj, pg8::Sched, true, true>(F.lds + RING_OFF, 1024, S, E);
        { pg8::Sched S2; S2.init(MMEM, 1024, 1024, F.G, (blockIdx.x >= 128) ? (int)blockIdx.x - 128 : (1 << 20), MEMN, Wkv_t); S2.tsbase = (void*)(ws + 65536);
          if (F.G <= 128) S2.c = (int)blockIdx.x;
          pg8::EpiMemKV E2{MIMG, (LAS const float*)(F.lds + ATT_EXTRA_OFF), (LAS float*)(F.lds + ATT_EXTRA_OFF + 92 * 64 * 4)};
          pg8::gemm_phase<pg8::EpiMemKV, pg8::Sched, true, true>(F.lds + RING_OFF, 1024, S2, E2); }
        if (F.G == 256 && blockIdx.x >= 160) weight_items(F, I_EARLY, NITEMS, ((int)blockIdx.x - 160) * NWAVES + F.wave, 96 * NWAVES);
        if (BOTH(1)) GRID_BAR();
        STAMP(2);
    }

    if (IN(2)) {
        using ab = attn_body::bf16;
        char* shm = (char*)lds + RING_OFF;
        float fox_margin;
        { const float gq = fabsf(args.in[I_QNFOX][F.lane]), gk = fabsf(args.in[I_KNFOX][F.lane]); float mq = gq, mk = gk;
#pragma unroll
          for (int o = 1; o < 64; o <<= 1) { mq = fmaxf(mq, __shfl_xor(mq, o)); mk = fmaxf(mk, __shfl_xor(mk, o)); }
          fox_margin = 2.0f * (8.0f * mq * mk * 1.4426950408889634f * 1.02f) + 40.0f; }
        for (;;) {
            if (F.tid == 0) F.MISC[24] = atomicAdd((unsigned*)(F.ctl + CW_FOXQ), 1u);
            __syncthreads();
            const int id = (int)F.MISC[24];
            __syncthreads();
            if (id >= 1024) break;
            const int bh = id & 63, qb = 15 - (id >> 6);
            const int b = bh >> 3, h = bh & 7; const size_t rb = (size_t)b * SEQ; const float* g2 = G2 + (size_t)bh * SEQ; const int NT = 4 * qb + 4;
            const float thr = g2[qb * 256] - fox_margin;
            const bool far = (F.lane < NT - 4) && (g2[64 * F.lane + 63] <= thr);
            const int t0 = __builtin_amdgcn_readfirstlane(__popcll(__ballot(far))) & ~1;
            attn_body::attn_unit<0, 512, 8>((const ab*)QF + (rb + qb * 256) * 1536 + h * 64, (const ab*)KF + (rb + 64 * t0) * 512 + h * 64, (const ab*)VF + (rb + 64 * t0) * 512 + h * 64, (ab*)QF + (rb + qb * 256) * 1536 + h * 64,
                                              NT - t0, qb * 256 - 64 * t0, 0, 0.f, g2 + 64 * t0, nullptr, shm); }
#if defined(TSPROBE)
        if (threadIdx.x == 0) { atomicMax((unsigned long long*)(ws + 65536) + 10, rt()); atomicMin((unsigned long long*)(ws + 65536) + 13, rt() ^ 0xffffffffffffffffull); }
#endif
        for (int id = F.vcu; id < 256; id += F.G)
            attn_body::swa_unit(id >> 5, (id >> 4) & 1, id & 15, (ab*)QA, (const ab*)KA, (const ab*)VA, args.in[I_SINK], args.in[I_RELBIAS], shm);
#if defined(TSPROBE)
        if (threadIdx.x == 0) atomicMax((unsigned long long*)(ws + 65536) + 11, rt());
#endif
        for (int i = 0, prev_bh = -1;; ++i) { const int id = (F.G == 256) ? F.vcu * 2 + i : i * F.G + F.vcu; if (id >= 512 || (F.G == 256 && i >= 2)) break;
            const bool prep = (id >> 4) != prev_bh; prev_bh = id >> 4;
            attn_body::mem_unit(id >> 6, (id >> 4) & 3, id & 15, prep, MIMG, (const ab*)QM, (ab*)QM, shm, (char*)lds + MEMWS_OFF, (char*)lds + ATT_EXTRA_OFF, (void*)(ws + 65536)); }
#if defined(TSPROBE)
        if (threadIdx.x == 0) atomicMax((unsigned long long*)(ws + 65536) + 12, rt());
#endif
        if (BOTH(2)) GRID_BAR();
        STAMP(3);
    }

    if (IN(3)) {
        pg8::Sched S; S.init(MTOK, 1024, 1536, F.G, (int)blockIdx.x, QCAT, Wo_t); S.tsbase = (void*)(ws + 65536);
        pg8::EpiMerge E{(const unsigned char*)GT, MRG, (void*)(ws + 65536)};
        pg8::gemm_phase<pg8::EpiMerge, pg8::Sched, true, true>(F.lds + RING_OFF, 1536, S, E);
        if (BOTH(3)) GRID_BAR();
        STAMP(4);
    }

    if (IN(4)) {
        pg8::Sched S; S.init(MTOK, 1024, 1024, F.G, (int)blockIdx.x, MRG, Wout_t); S.tsbase = (void*)(ws + 65536);
        { LAS float* tab = (LAS float*)(F.lds + ATT_EXTRA_OFF); for (int i = F.tid; i < 1024; i += NWAVES * 64) tab[i] = 1.0f / F.g_mix[i]; __syncthreads(); }
        pg8::EpiOutProj E{H, (const float*)(ws + WS_RINV), (LAS const float*)(F.lds + ATT_EXTRA_OFF), X1B, SSQ};
        pg8::gemm_phase<pg8::EpiOutProj, pg8::Sched, true, true>(F.lds + RING_OFF, 1024, S, E);
        if (BOTH(4)) GRID_BAR();
        STAMP(5);
    }

    if (IN(5)) {
        pg8::Sched S; S.init(MTOK, 4096, 1024, F.G, (int)blockIdx.x, X1B, Wup_t); S.tsbase = (void*)(ws + 65536);
#if defined(EXPER_NOSTORE)
        { pg8::EpiUpT<true> E0{SSQ, U, (PG8_LAS float*)(F.lds + ATT_EXTRA_OFF)}; pg8::gemm_phase<pg8::EpiUpT<true>, pg8::Sched, true, true>(F.lds + RING_OFF, 1024, S, E0); GRID_BAR(); STAMP(18); }
#endif
#if defined(EXPER_VARIANT)
        { pg8::EpiUp E0{SSQ, U, (PG8_LAS float*)(F.lds + ATT_EXTRA_OFF)}; pg8::gemm_phase<pg8::EpiUp, pg8::Sched, EXPER_ALIGN, EXPER_SP2>(F.lds + RING_OFF, 1024, S, E0); GRID_BAR(); STAMP(18); }
#endif
        pg8::EpiUp E{SSQ, U, (PG8_LAS float*)(F.lds + ATT_EXTRA_OFF)};
        pg8::gemm_phase<pg8::EpiUp, pg8::Sched, true, true>(F.lds + RING_OFF, 1024, S, E);
        if (BOTH(5)) GRID_BAR();
        STAMP(6);
    }

    if (IN(6)) {
        pg8::Sched S; S.init(MTOK, 1024, 4096, F.G, (int)blockIdx.x, U, Wd_t); S.tsbase = (void*)(ws + 65536);
        pg8::EpiDown E{X1B, F.out};
        pg8::gemm_phase<pg8::EpiDown, pg8::Sched, true, true>(F.lds + RING_OFF, 4096, S, E);
        STAMP(7);
    }
#if defined(TSPROBE)
    if (blockIdx.x == 0 && threadIdx.x == 0) { const unsigned long long* tsb = (const unsigned long long*)(args.ws + 65536);
#if defined(TS_CYCLES)
        const unsigned long long span = (tsb[32 + TS_B] - tsb[32 + TS_A]) / 25ull, t0 = rt();
#else
        const unsigned long long span = (tsb[TS_B] - tsb[TS_A]) * 8ull, t0 = rt();
#endif
        while (rt() - t0 < span) __builtin_amdgcn_s_sleep(32); }
#endif
#undef IN
#undef BOTH
#undef GRID_BAR
}

extern "C" void kernel_launch(void* const* d_in, const int* in_sizes, int n_in, void* d_out, int out_size, void* d_ws, size_t ws_size, hipStream_t stream) {
    static int grid = 0;
    if (grid == 0) {
        if (n_in != NIN_ARGS || in_sizes[0] != MTOK * 1024 || out_size != MTOK * 1024 || ws_size < WS_END) { fprintf(stderr, "kernel_launch: unexpected shapes (n_in %d, in0 %d, out %d, ws %zu < %zu); nothing launched\n", n_in, n_in > 0 ? in_sizes[0] : -1, out_size, ws_size, (size_t)WS_END); grid = -1; return; }
        int dev = 0, cus = 0, per_cu = 0;
        if (hipGetDevice(&dev) != hipSuccess || hipDeviceGetAttribute(&cus, hipDeviceAttributeMultiprocessorCount, dev) != hipSuccess) { fprintf(stderr, "kernel_launch: hipGetDevice / hipDeviceGetAttribute failed\n"); grid = -1; return; }
        if (hipFuncSetAttribute((const void*)mega_fwd, hipFuncAttributeMaxDynamicSharedMemorySize, LDS_BYTES) != hipSuccess) { fprintf(stderr, "kernel_launch: hipFuncSetAttribute failed\n"); grid = -1; return; }
        if (hipOccupancyMaxActiveBlocksPerMultiprocessor(&per_cu, (const void*)mega_fwd, NWAVES * 64, LDS_BYTES) != hipSuccess || per_cu < 1) { fprintf(stderr, "kernel_launch: occupancy query says %d workgroups per CU\n", per_cu); per_cu = 1; }
        (void)hipGetLastError();
        if (per_cu > 1) per_cu = 1;
        grid = cus * per_cu;
    }
    if (grid < 0) return;
    if (hipMemsetAsync((char*)d_ws + WS_CTL, 0, CTL_ZERO_BYTES, stream) != hipSuccess) { fprintf(stderr, "kernel_launch: hipMemsetAsync failed\n"); return; }
    Args a{};
    for (int i = 0; i < NIN_ARGS; ++i) a.in[i] = (const float*)d_in[i];
    a.out = (float*)d_out; a.ws = (unsigned char*)d_ws;
#if defined(DETPROBE) && DETPROBE
    {   unsigned char* w = (unsigned char*)d_ws; unsigned long long* chk = (unsigned long long*)(w + WS_CHK);
        (void)hipMemsetAsync(chk, 0, 2 * 64 * 8, stream);
        struct Slot { int phase; size_t off; size_t bytes; bool in_out; };
        const Slot slots[] = { {0, WS_WIN, 39 * MiB, false}, {0, WS_LOGF, 1 * MiB, false}, {0, WS_MEMN, 4 * MiB, false}, {0, WS_H, 64 * MiB, false},
            {1, WS_G2, 1 * MiB, false}, {1, WS_MKV, 4 * MiB, false}, {1, WS_GT, 192 * MiB, false}, {1, WS_QCAT, 96 * MiB, false}, {1, WS_KA, 8 * MiB, false}, {1, WS_VA, 8 * MiB, false}, {1, WS_KF, 32 * MiB, false}, {1, WS_VF, 32 * MiB, false},
            {2, WS_QCAT, 96 * MiB, false},
            {3, WS_MRG, 64 * MiB, false}, {4, WS_X1B, 64 * MiB, false}, {4, WS_SSQ, 2 * MiB, false}, {5, WS_U, 256 * MiB, false}, {6, 0, 128 * MiB, true} };
        const int nslots = (int)(sizeof(slots) / sizeof(slots[0]));
        for (int run = 0; run < 2; ++run)
            for (int p = 0; p < 7; ++p) { a.ph_lo = p; a.ph_hi = p + 1; if (p == 1) (void)hipMemsetAsync(w + WS_GT, 0, 192 * MiB, stream); if (p == 1) (void)hipMemsetAsync(w + WS_QCAT, 0, 176 * MiB, stream);
                hipLaunchKernelGGL(mega_fwd, dim3(grid), dim3(NWAVES * 64), LDS_BYTES, stream, a);
                for (int s = 0; s < nslots; ++s) if (slots[s].phase == p) { const unsigned* src = slots[s].in_out ? (const unsigned*)d_out : (const unsigned*)(w + slots[s].off);
                    hipLaunchKernelGGL(chk_sum, dim3(2048), dim3(256), 0, stream, src, slots[s].bytes / 4, chk + run * 64 + s); } }
        hipLaunchKernelGGL(chk_report, dim3(2048), dim3(256), 0, stream, (const unsigned long long*)chk, (float*)d_out, nslots, (size_t)out_size);
    }
#elif N_LAUNCHES == 1
#if defined(EXPER_P0TWICE)
    a.ph_lo = 0; a.ph_hi = 1; hipLaunchKernelGGL(mega_fwd, dim3(grid), dim3(NWAVES * 64), LDS_BYTES, stream, a);
    (void)hipMemsetAsync((char*)d_ws + WS_CTL, 0, CTL_ZERO_BYTES, stream);
#endif
    a.ph_lo = 0; a.ph_hi = 7;
    hipLaunchKernelGGL(mega_fwd, dim3(grid), dim3(NWAVES * 64), LDS_BYTES, stream, a);
#else
    for (int p = 0; p < 7; ++p) { a.ph_lo = p; a.ph_hi = p + 1; hipLaunchKernelGGL(mega_fwd, dim3(grid), dim3(NWAVES * 64), LDS_BYTES, stream, a); }
#endif
    const hipError_t le = hipPeekAtLastError();
    if (le != hipSuccess) fprintf(stderr, "kernel_launch: launch failed: %s\n", hipGetErrorName(le));
}
```

```cpp
#include <hip/hip_runtime.h>
#include <hip/hip_bf16.h>
#include <cstdio>
#include <cstdint>
#include <cmath>
#ifndef N_LAUNCHES
#define N_LAUNCHES 1
#endif
#if defined(TSPROBE) && !defined(TS_A)
#define TS_A TSPROBE
#define TS_B (TSPROBE + 1)
#endif
namespace pg8 {
#define PG8_LAS __attribute__((address_space(3)))
typedef unsigned short bf16_t;
typedef short bf16x8 __attribute__((ext_vector_type(8)));
typedef float f32x4 __attribute__((ext_vector_type(4)));
typedef unsigned u32x4 __attribute__((ext_vector_type(4)));
constexpr int BM = 256, BK = 64, HALF = 128, HTB = HALF * BK * 2  , STAGE_BYTES = 8 * HTB, NXCD = 8, WGM = 8;

__host__ __device__ __forceinline__ int lds_byte(int r, int c) { const int st = (r >> 4) * 2 + (c >> 5), rr = r & 15, cc = c & 31, ob = rr * 64 + cc * 2; return st * 1024 + (ob ^ (((ob >> 9) & 1) << 5)); }
__host__ __device__ __forceinline__ void stage_rc(int b, int& R, int& C) { const int st = b / 1024, sb = b % 1024, swz = sb ^ (((sb >> 9) & 1) << 5); R = (st >> 1) * 16 + swz / 64; C = (st & 1) * 32 + (swz % 64) / 2; }
__host__ __device__ __forceinline__ int perm32(int rho) { const int n = rho >> 4, i = rho & 15; return 8 * (i >> 2) + 4 * n + (i & 3); }

#if defined(NO_EPI_RETIRE)
#define EPI_RETIRE do {} while (0)
#else
#define EPI_RETIRE asm volatile("s_waitcnt vmcnt(0)" ::: "memory")
#endif
struct Unit { int pm, pn; };
typedef float f32x2_t __attribute__((ext_vector_type(2))); typedef __bf16 bf16x2_t __attribute__((ext_vector_type(2)));
__device__ __forceinline__ unsigned cvt_pk_bf16(float lo, float hi) { f32x2_t v = {lo, hi}; bf16x2_t b = __builtin_convertvector(v, bf16x2_t); return __builtin_bit_cast(unsigned, b); }
typedef unsigned u32x2 __attribute__((ext_vector_type(2)));

struct Sched {
    int nM, nN, nwg, G, c, nx, asel;
    const char *A0, *Bt, *Ax, *Bx; size_t tstep, astride; void* tsbase;
    __device__ __forceinline__ void init(int M, int N, int K, int G_, int c_, const void* a0, const void* bt) {
        nM = M / BM; nN = N / BM; nwg = nM * nN; G = G_; c = c_; nx = 0; asel = 0; astride = 0; tsbase = nullptr; A0 = (const char*)a0; Bt = (const char*)bt; Ax = Bx = (const char*)a0; tstep = (size_t)BM * K * 2; }
    __device__ __forceinline__ bool next(int i, Unit& u) const {
        const long L = (long)i * G + c;
        if (L >= nwg) { const long e = L - nwg; if (e >= nx) return false; u.pm = nM + (int)(e >> 2); u.pn = (int)(e & 3); return true; }
        int wgid = (int)L; { const int q = nwg / NXCD, r = nwg % NXCD, xcd = wgid % NXCD, off = wgid / NXCD; wgid = (xcd < r ? xcd * (q + 1) : r * (q + 1) + (xcd - r) * q) + off; }
        const int nig = WGM * nN, gid = wgid / nig, fm = gid * WGM, gsz = (nM - fm) < WGM ? (nM - fm) : WGM;
        u.pm = fm + ((wgid % nig) % gsz); u.pn = (wgid % nig) / gsz; return true;
    }
    __device__ __forceinline__ const char* a_ptr(const Unit& u) const {
        if (u.pm >= nM) return Ax + (size_t)(u.pm - nM) * tstep;
        return A0 + (size_t)(asel ? (u.pn >> 2) : 0) * astride + (size_t)u.pm * tstep; }
    __device__ __forceinline__ const char* b_ptr(const Unit& u) const { return ((u.pm >= nM) ? Bx : Bt) + (size_t)u.pn * tstep; }
    __device__ __forceinline__ void a_ready(const Unit&) const {}
    __device__ __forceinline__ void done(const Unit&) const {}
};

__device__ __forceinline__ float dot4(const f32x4 a) { return (a[0] * a[0] + a[1] * a[1]) + (a[2] * a[2] + a[3] * a[3]); }
__device__ __forceinline__ u32x4 pack8(const f32x4 a, const f32x4 b) { u32x4 w; w.x = cvt_pk_bf16(a[0], a[1]); w.y = cvt_pk_bf16(a[2], a[3]); w.z = cvt_pk_bf16(b[0], b[1]); w.w = cvt_pk_bf16(b[2], b[3]); return w; }

__device__ __forceinline__ int quad_src_idx(int lane) { return ((((lane & 3) << 4) | (lane >> 2)) << 2); }
__device__ __forceinline__ u32x4 quad_gather(const u32x4 w, int pidx) { u32x4 o; o.x = (unsigned)__builtin_amdgcn_ds_bpermute(pidx, (int)w.x); o.y = (unsigned)__builtin_amdgcn_ds_bpermute(pidx, (int)w.y);
    o.z = (unsigned)__builtin_amdgcn_ds_bpermute(pidx, (int)w.z); o.w = (unsigned)__builtin_amdgcn_ds_bpermute(pidx, (int)w.w); return o; }
constexpr float kLog2e = 1.4426950408889634f;
constexpr float kEps = 1e-6f;
constexpr float kC2_64 = 0.125f * 1.4426950408889634f;

struct EpiInProj {
    static constexpr bool PERM = true, AFTER_DRAIN = false, HAS_MID = false;
    bf16_t *QA, *KA, *VA, *QF, *KF, *VF, *QM; unsigned char* GT8;
    PG8_LAS const float* tab;
    __device__ __forceinline__ void operator()(const f32x4 (&acc)[2][2][4][2], const Unit& u, int wr, int wc, int fr, int fq) const {
        const int g = u.pn * 4 + wc;
        bf16_t* dst; int pitch, dcol, mode;
        if (g < 8)       { dst = QA; pitch = 1536; dcol = 64 * g;        mode = 1; }
        else if (g < 10) { dst = KA; pitch = 128;  dcol = 64 * (g - 8);  mode = 1; }
        else if (g < 12) { dst = VA; pitch = 128;  dcol = 64 * (g - 10); mode = 0; }
        else if (g < 20) { dst = QF; pitch = 1536; dcol = 64 * (g - 12); mode = 1; }
        else if (g < 28) { dst = KF; pitch = 512;  dcol = 64 * (g - 20); mode = 1; }
        else if (g < 36) { dst = VF; pitch = 512;  dcol = 64 * (g - 28); mode = 0; }
        else if (g < 44) { dst = QM; pitch = 1536; dcol = 64 * (g - 36); mode = 0; }
        else             { dst = nullptr; pitch = 0; dcol = 64 * (g - 44); mode = 2; }
        const int row0 = u.pm * BM + wr * 64 + fr;
        bf16_t* base = dst + dcol + 8 * fq;
        f32x4 cv[2][2];
#pragma unroll
        for (int bj = 0; bj < 2; ++bj)
#pragma unroll
            for (int n = 0; n < 2; ++n) cv[bj][n] = *(PG8_LAS const f32x4*)(tab + g * 64 + ((g >= 44) ? 16 * fq + 8 * bj : 32 * bj + 8 * fq) + 4 * n);
        if (mode == 1) {
#pragma unroll
            for (int ai = 0; ai < 2; ++ai)
#pragma unroll
                for (int m = 0; m < 4; ++m) { bf16_t* rowp = base + (size_t)(row0 + ai * HALF + m * 16) * pitch;
                    float ss = (dot4(acc[ai][0][m][0]) + dot4(acc[ai][0][m][1])) + (dot4(acc[ai][1][m][0]) + dot4(acc[ai][1][m][1]));
                    ss += __shfl_xor(ss, 16); ss += __shfl_xor(ss, 32);
                    const float r = 1.0f / sqrtf(ss * (1.0f / 64.0f) + kEps);
                    if (ai == 0 && m == 0) EPI_RETIRE;
#pragma unroll
                    for (int bj = 0; bj < 2; ++bj) *(u32x4*)(rowp + 32 * bj) = pack8(acc[ai][bj][m][0] * r * cv[bj][0], acc[ai][bj][m][1] * r * cv[bj][1]); }
        } else if (mode == 2) {
            unsigned char* gbase = (unsigned char*)GT8 + dcol + 16 * fq;
#pragma unroll
            for (int ai = 0; ai < 2; ++ai)
#pragma unroll
                for (int m = 0; m < 4; ++m) { u32x4 w;
#pragma unroll
                    for (int bj = 0; bj < 2; ++bj)
#pragma unroll
                        for (int n = 0; n < 2; ++n) { const f32x4 z = (acc[ai][bj][m][n] + cv[bj][n]) * (-kLog2e); unsigned q = 0;
#pragma unroll
                            for (int j = 0; j < 4; ++j) { const float g = __builtin_amdgcn_rcpf(1.0f + __builtin_amdgcn_exp2f(z[j])); unsigned b8 = (unsigned)(g * 255.0f + 0.5f); b8 = b8 < 1u ? 1u : b8; q |= b8 << (8 * j); }
                            w[2 * bj + n] = q; }
                    if (ai == 0 && m == 0) EPI_RETIRE;
                    *(u32x4*)(gbase + (size_t)(row0 + ai * HALF + m * 16) * 3072) = w; asm volatile("" ::: "memory"); }
        } else {
            EPI_RETIRE;
#pragma unroll
            for (int ai = 0; ai < 2; ++ai)
#pragma unroll
                for (int m = 0; m < 4; ++m) { bf16_t* rowp = base + (size_t)(row0 + ai * HALF + m * 16) * pitch;
#pragma unroll
                    for (int bj = 0; bj < 2; ++bj) *(u32x4*)(rowp + 32 * bj) = pack8(acc[ai][bj][m][0], acc[ai][bj][m][1]); }
        }
    }
};

struct EpiMemKV {
    static constexpr bool PERM = true, AFTER_DRAIN = false, HAS_MID = false;
    unsigned char* MIMG; PG8_LAS const float* tab; PG8_LAS float* ex;
    __device__ __forceinline__ void operator()(const f32x4 (&acc)[2][2][4][2], const Unit& u, int wr, int wc, int fr, int fq) const {
            const int b = u.pm, hp = (u.pn & 1) * 2, key0 = wr * 64 + fr;
            unsigned char* im0 = MIMG + (size_t)(b * 4 + hp) * 131072;
            if (u.pn < 2) {
                PG8_LAS const f32x4* gp = (PG8_LAS const f32x4*)(tab + 28 * 64 + 32 * wc + 8 * fq);
#pragma unroll
                for (int bj = 0; bj < 2; ++bj) {
#pragma unroll
                    for (int ai = 0; ai < 2; ++ai)
#pragma unroll
                        for (int m = 0; m < 4; ++m) { float ss = dot4(acc[ai][bj][m][0]) + dot4(acc[ai][bj][m][1]); ss += __shfl_xor(ss, 16); ss += __shfl_xor(ss, 32);
                            if (fq == 0) ex[(ai * HALF + key0 + m * 16) * 4 + wc] = ss; }
                    asm volatile("s_waitcnt lgkmcnt(0)" ::: "memory"); __builtin_amdgcn_s_barrier(); asm volatile("" ::: "memory");
                    if (bj == 0) EPI_RETIRE;
                    unsigned char* im = im0 + (size_t)bj * 131072 + (4 * wc + fq) * 4096;
#pragma unroll
                    for (int ai = 0; ai < 2; ++ai)
#pragma unroll
                        for (int m = 0; m < 4; ++m) { const int key = ai * HALF + key0 + m * 16; const f32x4 e4 = *(PG8_LAS const f32x4*)(ex + key * 4);
                            const float r = 1.0f / sqrtf(((e4[0] + e4[1]) + (e4[2] + e4[3])) * (1.0f / 128.0f) + kEps);
                            *(u32x4*)(im + key * 16) = pack8(acc[ai][bj][m][0] * r * gp[0], acc[ai][bj][m][1] * r * gp[1]); }
                    asm volatile("s_waitcnt lgkmcnt(0)" ::: "memory"); __builtin_amdgcn_s_barrier(); asm volatile("" ::: "memory");
                }
            } else {
                EPI_RETIRE;
#pragma unroll
                for (int bj = 0; bj < 2; ++bj) { unsigned char* im = im0 + (size_t)bj * 131072 + 65536 + wc * 4096 + fq * 16;
#pragma unroll
                    for (int ai = 0; ai < 2; ++ai)
#pragma unroll
                        for (int m = 0; m < 4; ++m) { const int key = ai * HALF + key0 + m * 16; *(u32x4*)(im + (key >> 6) * 16384 + (key & 63) * 64) = pack8(acc[ai][bj][m][0], acc[ai][bj][m][1]); } }
            }
    }
};

__device__ __forceinline__ void unpack8(const u32x4 w, f32x4& a, f32x4& b) {
    a[0] = __uint_as_float(w.x << 16); a[1] = __uint_as_float(w.x & 0xffff0000u); a[2] = __uint_as_float(w.y << 16); a[3] = __uint_as_float(w.y & 0xffff0000u);
    b[0] = __uint_as_float(w.z << 16); b[1] = __uint_as_float(w.z & 0xffff0000u); b[2] = __uint_as_float(w.w << 16); b[3] = __uint_as_float(w.w & 0xffff0000u); }
__device__ __forceinline__ f32x4 ub4(unsigned w) { return (f32x4){(float)(w & 0xffu), (float)((w >> 8) & 0xffu), (float)((w >> 16) & 0xffu), (float)(w >> 24)}; }
struct EpiMerge {
    static constexpr bool PERM = true, AFTER_DRAIN = false, HAS_MID = true;
    const unsigned char* GT8; bf16_t* MRG; void* tsbase;
    static __device__ __forceinline__ void scale16(f32x4& a00, f32x4& a01, f32x4& a10, f32x4& a11, const u32x4 nw, const u32x4 dw) {
        const f32x4 n0 = ub4(nw.x), n1 = ub4(nw.y), n2 = ub4(nw.z), n3 = ub4(nw.w), d0 = ub4(dw.x), d1 = ub4(dw.y), d2 = ub4(dw.z), d3 = ub4(dw.w);
#pragma unroll
        for (int j = 0; j < 4; ++j) { a00[j] *= n0[j] * __builtin_amdgcn_rcpf(d0[j]); a01[j] *= n1[j] * __builtin_amdgcn_rcpf(d1[j]); a10[j] *= n2[j] * __builtin_amdgcn_rcpf(d2[j]); a11[j] *= n3[j] * __builtin_amdgcn_rcpf(d3[j]); } }
    __device__ __forceinline__ void mid(f32x4 (&acc)[2][2][4][2], const Unit& u, int t, int wr, int wc, int fr, int fq) const {
        const unsigned char* base = GT8 + (size_t)(u.pm * BM + wr * 64 + fr) * 3072 + u.pn * BM + wc * 64 + 16 * fq + ((t == 8) ? 0 : 1024);
        u32x4 nA, dA, nB, dB, nC, dC;
#define MID_LOAD(N, D, g) do { const unsigned char* rp_ = base + (size_t)(((g) >> 2) * HALF + ((g) & 3) * 16) * 3072; N = *(const u32x4*)(rp_); D = *(const u32x4*)(rp_ + 1024); } while (0)
#define MID_APPLY(N, D, g) do { scale16(acc[(g) >> 2][0][(g) & 3][0], acc[(g) >> 2][0][(g) & 3][1], acc[(g) >> 2][1][(g) & 3][0], acc[(g) >> 2][1][(g) & 3][1], N, D); \
        asm volatile("" : "+v"(acc[(g) >> 2][0][(g) & 3][0]), "+v"(acc[(g) >> 2][0][(g) & 3][1]), "+v"(acc[(g) >> 2][1][(g) & 3][0]), "+v"(acc[(g) >> 2][1][(g) & 3][1]) :: "memory"); } while (0)
        MID_LOAD(nA, dA, 0); MID_LOAD(nB, dB, 1);
        MID_LOAD(nC, dC, 2); MID_APPLY(nA, dA, 0);
        MID_LOAD(nA, dA, 3); MID_APPLY(nB, dB, 1);
        MID_LOAD(nB, dB, 4); MID_APPLY(nC, dC, 2);
        MID_LOAD(nC, dC, 5); MID_APPLY(nA, dA, 3);
        MID_LOAD(nA, dA, 6); MID_APPLY(nB, dB, 4);
        MID_LOAD(nB, dB, 7); MID_APPLY(nC, dC, 5);
        MID_APPLY(nA, dA, 6);
        MID_APPLY(nB, dB, 7);
#undef MID_LOAD
#undef MID_APPLY
    }
    __device__ __forceinline__ void operator()(const f32x4 (&acc)[2][2][4][2], const Unit& u, int wr, int wc, int fr, int fq) const {
        const int row0 = u.pm * BM + wr * 64 + fr, col0 = u.pn * BM + wc * 64 + 16 * fq;
        u32x4 gw[2][4];
#pragma unroll
        for (int ai = 0; ai < 2; ++ai)
#pragma unroll
            for (int m = 0; m < 4; ++m) gw[ai][m] = *(const u32x4*)(GT8 + (size_t)(row0 + ai * HALF + m * 16) * 3072 + 2048 + col0);
        EPI_RETIRE;
#pragma unroll
        for (int ai = 0; ai < 2; ++ai)
#pragma unroll
            for (int m = 0; m < 4; ++m) { bf16_t* op = MRG + (size_t)(row0 + ai * HALF + m * 16) * 1024 + col0; const float k = 1.0f / 255.0f;
                *(u32x4*)(op) = pack8(acc[ai][0][m][0] * (ub4(gw[ai][m].x) * k), acc[ai][0][m][1] * (ub4(gw[ai][m].y) * k));
                *(u32x4*)(op + 8) = pack8(acc[ai][1][m][0] * (ub4(gw[ai][m].z) * k), acc[ai][1][m][1] * (ub4(gw[ai][m].w) * k)); }
    }
};

struct EpiOutProj {
    static constexpr bool PERM = true, AFTER_DRAIN = false, HAS_MID = false;
    const bf16_t* Hn; const float* RINV; PG8_LAS const float* ginv; bf16_t* X1B; float* SSQ;
    __device__ __forceinline__ void operator()(const f32x4 (&acc)[2][2][4][2], const Unit& u, int wr, int wc, int fr, int fq) const {
        const int row0 = u.pm * BM + wr * 64 + fr, col0 = u.pn * BM + wc * 32 + 8 * fq;
        f32x4 gi[2][2];
#pragma unroll
        for (int bj = 0; bj < 2; ++bj)
#pragma unroll
            for (int n = 0; n < 2; ++n) gi[bj][n] = *(PG8_LAS const f32x4*)(ginv + col0 + bj * HALF + 4 * n);
#pragma unroll
        for (int ai = 0; ai < 2; ++ai) {
            u32x4 hw[4][2]; float ri[4];
#pragma unroll
            for (int m = 0; m < 4; ++m) { const int row = row0 + ai * HALF + m * 16; ri[m] = RINV[row]; hw[m][0] = *(const u32x4*)(Hn + (size_t)row * 1024 + col0); hw[m][1] = *(const u32x4*)(Hn + (size_t)row * 1024 + col0 + HALF); }
            if (ai == 0) EPI_RETIRE;
#pragma unroll
            for (int m = 0; m < 4; ++m) { const int row = row0 + ai * HALF + m * 16; const size_t off = (size_t)row * 1024 + col0; float ss = 0.f;
#pragma unroll
                for (int bj = 0; bj < 2; ++bj) { f32x4 h0, h1; unpack8(hw[m][bj], h0, h1);
                    const f32x4 v0 = h0 * ri[m] * gi[bj][0] + acc[ai][bj][m][0], v1 = h1 * ri[m] * gi[bj][1] + acc[ai][bj][m][1];
                    ss += dot4(v0) + dot4(v1); *(u32x4*)(X1B + off + bj * HALF) = pack8(v0, v1); }
                ss += __shfl_xor(ss, 16); ss += __shfl_xor(ss, 32);
                if (fq == 0) SSQ[(size_t)row * 16 + u.pn * 4 + wc] = ss; }
            asm volatile("" ::: "memory"); }
    }
};

template <bool NOSTORE = false> struct EpiUpT {
    static constexpr bool PERM = true, AFTER_DRAIN = false, HAS_MID = false;
    const float* SSQ; bf16_t* U; PG8_LAS float* rl;
    __device__ __forceinline__ void operator()(const f32x4 (&acc)[2][2][4][2], const Unit& u, int wr, int wc, int fr, int fq) const {
        const int lane_ = fq * 16 + fr, pidx = quad_src_idx(lane_);
        const int row0 = u.pm * BM + wr * 64 + (lane_ >> 2), col0 = u.pn * BM + wc * 32 + 8 * (lane_ & 3);
        { const int t = (wr * 4 + wc) * 64 + fq * 16 + fr;
          if (t < BM) { const f32x4* sp = (const f32x4*)(SSQ + (size_t)(u.pm * BM + t) * 16); const f32x4 s4 = (sp[0] + sp[1]) + (sp[2] + sp[3]);
              rl[t] = 1.0f / sqrtf(((s4[0] + s4[1]) + (s4[2] + s4[3])) * (1.0f / 1024.0f) + kEps); }
          asm volatile("s_waitcnt lgkmcnt(0)" ::: "memory"); __builtin_amdgcn_s_barrier(); asm volatile("" ::: "memory"); }
        EPI_RETIRE;
#pragma unroll
        for (int ai = 0; ai < 2; ++ai) {
#pragma unroll
            for (int m = 0; m < 4; ++m) { const float r = rl[ai * HALF + wr * 64 + m * 16 + fr];
                bf16_t* rowp = U + (size_t)(row0 + ai * HALF + m * 16) * 4096 + col0;
#pragma unroll
                for (int bj = 0; bj < 2; ++bj) { f32x4 a = acc[ai][bj][m][0] * r, b = acc[ai][bj][m][1] * r;
#pragma unroll
                    for (int j = 0; j < 4; ++j) { a[j] = fmaxf(a[j], 0.f); a[j] *= a[j]; b[j] = fmaxf(b[j], 0.f); b[j] *= b[j]; }
                    const u32x4 pk_ = quad_gather(pack8(a, b), pidx); if (NOSTORE) asm volatile("" :: "v"(pk_)); else *(u32x4*)(rowp + bj * HALF) = pk_; } } }
        asm volatile("s_waitcnt lgkmcnt(0)" ::: "memory"); __builtin_amdgcn_s_barrier(); asm volatile("" ::: "memory");
    }
};
typedef EpiUpT<false> EpiUp;

struct EpiDown {
    static constexpr bool PERM = true, AFTER_DRAIN = false, HAS_MID = false;
    const bf16_t* X1B; float* OUT;
    __device__ __forceinline__ void operator()(const f32x4 (&acc)[2][2][4][2], const Unit& u, int wr, int wc, int fr, int fq) const {
        const int row0 = u.pm * BM + wr * 64 + fr, col0 = u.pn * BM + wc * 32 + 8 * fq;
        u32x4 xw[2][4][2];
#pragma unroll
        for (int ai = 0; ai < 2; ++ai)
#pragma unroll
            for (int m = 0; m < 4; ++m) { const size_t off = (size_t)(row0 + ai * HALF + m * 16) * 1024 + col0; xw[ai][m][0] = *(const u32x4*)(X1B + off); xw[ai][m][1] = *(const u32x4*)(X1B + off + HALF); }
        EPI_RETIRE;
#pragma unroll
        for (int ai = 0; ai < 2; ++ai)
#pragma unroll
            for (int m = 0; m < 4; ++m) { const size_t off = (size_t)(row0 + ai * HALF + m * 16) * 1024 + col0;
#pragma unroll
                for (int bj = 0; bj < 2; ++bj) { f32x4 r0, r1; unpack8(xw[ai][m][bj], r0, r1);
                    *(f32x4*)(OUT + off + bj * HALF) = r0 + acc[ai][bj][m][0]; *(f32x4*)(OUT + off + bj * HALF + 4) = r1 + acc[ai][bj][m][1]; } }
    }
};

template <class Epi, class Sched, bool ALIGN_EPI = false, bool SP2 = false>
__device__ __forceinline__ void gemm_phase(PG8_LAS unsigned char* lds, const int K_, const Sched& S, const Epi& E) {
    const int tid = threadIdx.x, wid = __builtin_amdgcn_readfirstlane(tid >> 6), lane = tid & 63, wr = wid >> 2, wc = wid & 3, fr = lane & 15, fq = lane >> 4;
    const int K = K_, nt = K / BK;
    unsigned voffA[2], voffB[2];
#pragma unroll
    for (int i = 0; i < 2; ++i) { int R, C; stage_rc(tid * 16 + i * 8192, R, C); const int Rb = Epi::PERM ? ((R & ~31) + perm32(R & 31)) : R;
        voffA[i] = (unsigned)(R * K + C) * 2u; voffB[i] = (unsigned)(Rb * K + C) * 2u; }
    const size_t kstep = (size_t)(BK * 2);
    const size_t hstep = (size_t)HALF * K * 2;
    const size_t tstep = 2 * hstep;
    const unsigned ldsw = (unsigned)wid * 1024u;
    const int aoff = lds_byte(wr * 64 + fr, fq * 8), boff = lds_byte(wc * 32 + fr, fq * 8);
#define PG8_SA(b, h) (((b) * 2 + (h)) * HTB)
#define PG8_SB(b, h) ((4 + (b) * 2 + (h)) * HTB)
#define PG8_STAGE(bufoff, gbase, voff) do { _Pragma("unroll") for (int _i = 0; _i < 2; ++_i) \
        __builtin_amdgcn_global_load_lds((const unsigned*)((const char*)(gbase) + (voff)[_i]), (PG8_LAS unsigned*)(lds + (bufoff) + ldsw + _i * 8192), 16, 0, 0); } while (0)
#define PG8_LDA(dst, b, h) do { _Pragma("unroll") for (int m = 0; m < 4; ++m) _Pragma("unroll") for (int k = 0; k < 2; ++k) dst[m][k] = *(const PG8_LAS bf16x8*)(lds + PG8_SA(b, h) + aoff + m * 2048 + k * 1024); } while (0)
#define PG8_LDB(dst, b, h) do { _Pragma("unroll") for (int n = 0; n < 2; ++n) _Pragma("unroll") for (int k = 0; k < 2; ++k) dst[n][k] = *(const PG8_LAS bf16x8*)(lds + PG8_SB(b, h) + boff + n * 2048 + k * 1024); } while (0)
#define PG8_MMA(ai, bj, At, Bt) do { __builtin_amdgcn_s_setprio(1); _Pragma("unroll") for (int m = 0; m < 4; ++m) _Pragma("unroll") for (int n = 0; n < 2; ++n) _Pragma("unroll") for (int k = 0; k < 2; ++k) \
        acc[ai][bj][m][n] = __builtin_amdgcn_mfma_f32_16x16x32_bf16(Bt[n][k], At[m][k], acc[ai][bj][m][n], 0, 0, 0); __builtin_amdgcn_s_setprio(0); } while (0)
#define PG8_WAIT_V(n) asm volatile("s_waitcnt vmcnt(" #n ")" ::: "memory")
#define PG8_WAIT_L(n) asm volatile("s_waitcnt lgkmcnt(" #n ")" ::: "memory")
#if defined(NO_TZ)
#define PG8_WAIT_V8_T(tz) PG8_WAIT_V(8)
#else
#define PG8_WAIT_V8_T(tz) asm volatile("s_cmp_eq_u32 %0, 0\n\ts_cbranch_scc1 .Lpg8w_%=\n\ts_waitcnt vmcnt(8)\n.Lpg8w_%=:" :: "s"(tz) : "memory", "scc")
#endif
#define PG8_BAR __builtin_amdgcn_s_barrier()
#define PG8_SCHED __builtin_amdgcn_sched_barrier(0)
    Unit cur, nxt; int ui = 0;
    if (!S.next(0, cur)) return;
    f32x4 acc[2][2][4][2];
#pragma unroll
    for (int a = 0; a < 2; ++a)
#pragma unroll
        for (int b = 0; b < 2; ++b)
#pragma unroll
            for (int m = 0; m < 4; ++m)
#pragma unroll
                for (int n = 0; n < 2; ++n) acc[a][b][m][n] = (f32x4){0.f, 0.f, 0.f, 0.f};
    bf16x8 At[4][2], B0[2][2], B1[2][2];
    const char* cA = S.a_ptr(cur); const char* cB = S.b_ptr(cur);
    S.a_ready(cur);
    if constexpr (SP2) {
        PG8_STAGE(PG8_SB(0, 0), cB, voffB); PG8_STAGE(PG8_SB(0, 1), cB + hstep, voffB); PG8_STAGE(PG8_SA(0, 0), cA, voffA); PG8_STAGE(PG8_SA(0, 1), cA + hstep, voffA);
        if (wr == 1) PG8_BAR;
        PG8_WAIT_V(2); PG8_BAR;
        PG8_STAGE(PG8_SB(1, 0), cB + kstep, voffB); PG8_STAGE(PG8_SA(1, 0), cA + kstep, voffA); PG8_STAGE(PG8_SB(1, 1), cB + hstep + kstep, voffB); PG8_STAGE(PG8_SA(1, 1), cA + hstep + kstep, voffA);
        PG8_WAIT_V(0); PG8_BAR;
    } else {
        PG8_STAGE(PG8_SB(0, 0), cB, voffB); PG8_STAGE(PG8_SA(0, 0), cA, voffA); PG8_STAGE(PG8_SB(0, 1), cB + hstep, voffB); PG8_STAGE(PG8_SA(0, 1), cA + hstep, voffA);
        if (wr == 1) PG8_BAR;
        PG8_WAIT_V(4); PG8_BAR;
        PG8_STAGE(PG8_SB(1, 0), cB + kstep, voffB); PG8_STAGE(PG8_SA(1, 0), cA + kstep, voffA); PG8_STAGE(PG8_SB(1, 1), cB + hstep + kstep, voffB);
        PG8_WAIT_V(6); PG8_BAR;
    }
    for (;;) {
        const bool has_next = S.next(ui + 1, nxt);
        const char* nA = has_next ? S.a_ptr(nxt) : cA; const char* nB = has_next ? S.b_ptr(nxt) : cB;
#if defined(TSPROBE)
        const unsigned long long kc0_ = __builtin_amdgcn_s_memtime();
#endif
        for (int t = 0; t < nt; t += 2) {
            if constexpr (Epi::HAS_MID) { if (t == 8 || t == 16) {
#if defined(TSPROBE)
                const unsigned long long h0_ = __builtin_amdgcn_s_memrealtime();
#endif
                E.mid(acc, cur, t, wr, wc, fr, fq);
#if defined(TSPROBE)
                if (blockIdx.x == 0 && threadIdx.x == 0) { unsigned long long* tsp_ = (unsigned long long*)E.tsbase; tsp_[15] = tsp_[15] + (__builtin_amdgcn_s_memrealtime() - h0_); }
#endif
            } }
            const bool last = (t == nt - 2);
            const char* a1 = cA + (size_t)(t + 1) * kstep;
            const char* a2 = last ? nA : cA + (size_t)(t + 2) * kstep; const char* b2 = last ? nB : cB + (size_t)(t + 2) * kstep;
            const char* a3 = a2 + kstep; const char* b3 = b2 + kstep;
            if (last && has_next) S.a_ready(nxt);
            const int tz = __builtin_amdgcn_readfirstlane(t);
            if constexpr (SP2) {
            PG8_LDB(B0, 0, 0); PG8_LDB(B1, 0, 1); PG8_SCHED; PG8_LDA(At, 0, 0); PG8_STAGE(PG8_SA(1, 1), a1 + hstep, voffA);
            PG8_WAIT_V8_T(tz); PG8_WAIT_L(0); PG8_BAR; PG8_MMA(0, 0, At, B0); PG8_MMA(0, 1, At, B1); PG8_BAR; PG8_SCHED;
            PG8_LDA(At, 0, 1); PG8_STAGE(PG8_SB(0, 0), b2, voffB); PG8_STAGE(PG8_SB(0, 1), b2 + hstep, voffB); PG8_STAGE(PG8_SA(0, 0), a2, voffA);
            PG8_WAIT_V8_T(tz); PG8_WAIT_L(0); PG8_BAR; PG8_MMA(1, 0, At, B0); PG8_MMA(1, 1, At, B1); PG8_BAR; PG8_SCHED;
            PG8_LDB(B0, 1, 0); PG8_LDB(B1, 1, 1); PG8_SCHED; PG8_LDA(At, 1, 0); PG8_STAGE(PG8_SA(0, 1), a2 + hstep, voffA);
            PG8_WAIT_V8_T(tz); PG8_WAIT_L(0); PG8_BAR; PG8_MMA(0, 0, At, B0); PG8_MMA(0, 1, At, B1); PG8_BAR; PG8_SCHED;
            PG8_LDA(At, 1, 1); PG8_STAGE(PG8_SB(1, 0), b3, voffB); PG8_STAGE(PG8_SB(1, 1), b3 + hstep, voffB); PG8_STAGE(PG8_SA(1, 0), a3, voffA);
            PG8_WAIT_V(8); PG8_WAIT_L(0); PG8_BAR; PG8_MMA(1, 0, At, B0); PG8_MMA(1, 1, At, B1); PG8_BAR; PG8_SCHED;
            } else {
            PG8_LDB(B0, 0, 0); PG8_SCHED; PG8_LDA(At, 0, 0); PG8_STAGE(PG8_SA(1, 1), a1 + hstep, voffA);
            PG8_WAIT_L(8); PG8_BAR; PG8_WAIT_L(0); PG8_MMA(0, 0, At, B0); PG8_BAR; PG8_SCHED;
            PG8_LDB(B1, 0, 1); PG8_STAGE(PG8_SB(0, 0), b2, voffB);
            PG8_BAR; PG8_WAIT_L(0); PG8_MMA(0, 1, At, B1); PG8_BAR;
            PG8_LDA(At, 0, 1); PG8_STAGE(PG8_SA(0, 0), a2, voffA);
            PG8_BAR; PG8_WAIT_L(0); PG8_MMA(1, 0, At, B0); PG8_BAR; PG8_SCHED;
            PG8_STAGE(PG8_SB(0, 1), b2 + hstep, voffB);
            PG8_WAIT_V(6); PG8_BAR; PG8_MMA(1, 1, At, B1); PG8_BAR;
            PG8_LDB(B0, 1, 0); PG8_SCHED; PG8_LDA(At, 1, 0); PG8_STAGE(PG8_SA(0, 1), a2 + hstep, voffA);
            PG8_WAIT_L(8); PG8_BAR; PG8_WAIT_L(0); PG8_MMA(0, 0, At, B0); PG8_BAR; PG8_SCHED;
            PG8_LDB(B1, 1, 1); PG8_STAGE(PG8_SB(1, 0), b3, voffB);
            PG8_BAR; PG8_WAIT_L(0); PG8_MMA(0, 1, At, B1); PG8_BAR;
            PG8_LDA(At, 1, 1); PG8_STAGE(PG8_SA(1, 0), a3, voffA);
            PG8_BAR; PG8_WAIT_L(0); PG8_MMA(1, 0, At, B0); PG8_BAR; PG8_SCHED;
            PG8_STAGE(PG8_SB(1, 1), b3 + hstep, voffB);
            PG8_WAIT_V(6); PG8_BAR; PG8_MMA(1, 1, At, B1); PG8_BAR;
            }
        }
#if defined(TSPROBE)
        if (blockIdx.x == 0 && threadIdx.x == 0) { unsigned long long* tsp_ = (unsigned long long*)S.tsbase; tsp_[42] = tsp_[42] + (__builtin_amdgcn_s_memtime() - kc0_); tsp_[44] = tsp_[44] + (unsigned long long)nt; }
#endif
#if !defined(NO_PRESTAGE)
        if constexpr (SP2) PG8_STAGE(PG8_SA(1, 1), nA + kstep + hstep, voffA);
#endif
        if constexpr (ALIGN_EPI) { if (wr == 0) PG8_BAR; }
#if defined(TSPROBE)
        const unsigned long long e0_ = __builtin_amdgcn_s_memrealtime();
#endif
        if constexpr (!Epi::AFTER_DRAIN) { E(acc, cur, wr, wc, fr, fq); S.done(cur); }
#if defined(TSPROBE)
        if (blockIdx.x == 0 && threadIdx.x == 0) { unsigned long long* tsp_ = (unsigned long long*)S.tsbase; tsp_[17] = tsp_[17] + (__builtin_amdgcn_s_memrealtime() - e0_); }
#endif
        if (!has_next) break;
#pragma unroll
        for (int a = 0; a < 2; ++a)
#pragma unroll
            for (int b = 0; b < 2; ++b)
#pragma unroll
                for (int m = 0; m < 4; ++m)
#pragma unroll
                    for (int n = 0; n < 2; ++n) acc[a][b][m][n] = (f32x4){0.f, 0.f, 0.f, 0.f};
        cur = nxt; cA = nA; cB = nB; ++ui;
        if constexpr (ALIGN_EPI) { if (wr == 1) PG8_BAR; }
    }
    PG8_WAIT_V(0);
    if constexpr (!ALIGN_EPI) { if (wr == 0) PG8_BAR; }
    PG8_BAR;
    if constexpr (Epi::AFTER_DRAIN) { E.fused(acc, cur, wr, wc, fr, fq, lds, wid, lane); S.done(cur); }
#undef PG8_SA
#undef PG8_SB
#undef PG8_STAGE
#undef PG8_LDA
#undef PG8_LDB
#undef PG8_MMA
#undef PG8_WAIT_V
#undef PG8_WAIT_L
#undef PG8_BAR
#undef PG8_SCHED
}
}
namespace attn_body {
using bf16=__hip_bfloat16;
using bf16x8=__attribute__((ext_vector_type(8)))short;
using s16x4=__attribute__((ext_vector_type(4)))short;
using f32x16=__attribute__((ext_vector_type(16)))float;
using f32x4=__attribute__((ext_vector_type(4)))float;
using u32x4=__attribute__((ext_vector_type(4)))unsigned;
constexpr int SEQ=4096,D=64,PQ=1536;
constexpr int NW=8,QBLK=32,QB=QBLK*NW,KVBLK=64;
__device__ __forceinline__ int crow(int r,int hi){return (r&3)+8*(r>>2)+4*hi;}
#define SBAR() __builtin_amdgcn_sched_barrier(0)
__device__ __forceinline__ void cmask(f32x16&p0,f32x16&p1,int jb,int qrel,int hi){
  const float NEG=-INFINITY; int kb=64*jb+4*hi;
  #pragma unroll
  for(int r=0;r<16;++r){int kv=kb+(r&3)+8*(r>>2); if(kv>qrel)p0[r]=NEG; if(kv+32>qrel)p1[r]=NEG;}
}
constexpr int NSLOT=3, SLOTB=8192;
constexpr int LDS_K=0, LDS_V=NSLOT*SLOTB, LDS_WS=2*NSLOT*SLOTB, LDS_OST=LDS_WS+NW*64*4, LDS_GL=LDS_OST+NW*4096+2048  , LDS_TB=LDS_GL+16384  , LDS_BYTES=LDS_TB+2560;
constexpr float LOG2E=1.4426950408889634f;
__device__ __forceinline__ void glds16(const void*gsrc,unsigned lds_dst){unsigned keep;
  asm volatile("s_mov_b32 %0, m0\n\ts_mov_b32 m0, %2\n\ts_nop 0\n\tglobal_load_lds_dwordx4 %1, off\n\ts_mov_b32 m0, %0":"=&s"(keep):"v"(gsrc),"s"(lds_dst):"memory");}
typedef float f32x2_t __attribute__((ext_vector_type(2))); typedef __bf16 bf16x2_t __attribute__((ext_vector_type(2)));
__device__ __forceinline__ unsigned cvtpk_s(float lo,float hi){f32x2_t v={lo,hi};bf16x2_t b=__builtin_convertvector(v,bf16x2_t);return __builtin_bit_cast(unsigned,b);}
#define WAIT_BAR(N) asm volatile("s_waitcnt vmcnt(" #N ") lgkmcnt(0)\n\ts_barrier":::"memory")
typedef __attribute__((address_space(3))) const char* lds_cptr;
typedef __attribute__((address_space(3))) float* lds_fptr;
typedef __attribute__((address_space(3))) f32x4* lds_f4ptr;
typedef short v4i16_t __attribute__((ext_vector_type(4)));
#define MX3(a,b,c) __builtin_fmaxf(__builtin_fmaxf((a),(b)),(c))
__device__ __forceinline__ void qkt(f32x16&p0,f32x16&p1,const char*Kslot,const bf16x8*qr,int r32,int hi){
  const char*kb=Kslot+hi*1024+r32*16;
  #pragma unroll
  for(int d0=0;d0<4;++d0){
    const bf16x8 b0=*reinterpret_cast<const bf16x8*>(kb+d0*2048);
    const bf16x8 b1=*reinterpret_cast<const bf16x8*>(kb+d0*2048+512);
    p0=__builtin_amdgcn_mfma_f32_32x32x16_bf16(b0,qr[d0],p0,0,0,0);p1=__builtin_amdgcn_mfma_f32_32x32x16_bf16(b1,qr[d0],p1,0,0,0);}
}
__device__ __forceinline__ void kload8(bf16x8*kf,lds_cptr kp){
  kf[0]=*(const __attribute__((address_space(3))) bf16x8*)(kp);      kf[1]=*(const __attribute__((address_space(3))) bf16x8*)(kp+512);
  kf[2]=*(const __attribute__((address_space(3))) bf16x8*)(kp+2048); kf[3]=*(const __attribute__((address_space(3))) bf16x8*)(kp+2560);
  kf[4]=*(const __attribute__((address_space(3))) bf16x8*)(kp+4096); kf[5]=*(const __attribute__((address_space(3))) bf16x8*)(kp+4608);
  kf[6]=*(const __attribute__((address_space(3))) bf16x8*)(kp+6144); kf[7]=*(const __attribute__((address_space(3))) bf16x8*)(kp+6656);
}
__device__ __forceinline__ void kload2(bf16x8*kf,lds_cptr kp,int j){ kf[2*j]=*(const __attribute__((address_space(3))) bf16x8*)(kp+j*2048); kf[2*j+1]=*(const __attribute__((address_space(3))) bf16x8*)(kp+j*2048+512); }
__device__ __forceinline__ s16x4 vtr(lds_cptr p){ return __builtin_bit_cast(s16x4,__builtin_amdgcn_ds_read_tr16_b64_v4i16((__attribute__((address_space(3))) v4i16_t*)p)); }
__device__ __forceinline__ float rowmax(const f32x16&p0,const f32x16&p1){
  float a=MX3(p0[0],p0[1],p1[0]),b=MX3(p0[2],p0[3],p1[1]);a=MX3(a,p1[2],p1[3]);
  #pragma unroll
  for(int r=4;r<16;r+=4){a=MX3(a,p0[r],p0[r+1]);b=MX3(b,p0[r+2],p0[r+3]);a=MX3(a,p1[r],p1[r+1]);b=MX3(b,p1[r+2],p1[r+3]);}
  float m=__builtin_fmaxf(a,b);
  auto rr=__builtin_amdgcn_permlane32_swap(__float_as_uint(m),__float_as_uint(m),false,false);
  return __builtin_fmaxf(__uint_as_float(rr[0]),__uint_as_float(rr[1]));
}
__device__ __forceinline__ void pv(f32x16*o,int vb,bf16x8 pa0,bf16x8 pa1,bf16x8 pa2,bf16x8 pa3){
  #pragma unroll
  for(int d0=0;d0<2;++d0){s16x4 lo[4],hi[4];
    #pragma unroll
    for(int ks=0;ks<4;++ks){
      asm volatile("ds_read_b64_tr_b16 %0,%1 offset:%c2":"=&v"(lo[ks]):"v"(vb),"i"(d0*4096+ks*1024):"memory");
      asm volatile("ds_read_b64_tr_b16 %0,%1 offset:%c2":"=&v"(hi[ks]):"v"(vb),"i"(d0*4096+ks*1024+512):"memory");}
    asm volatile("s_waitcnt lgkmcnt(0)":::"memory");SBAR();
    #define PK(k) (bf16x8){lo[k][0],lo[k][1],lo[k][2],lo[k][3],hi[k][0],hi[k][1],hi[k][2],hi[k][3]}
    o[d0]=__builtin_amdgcn_mfma_f32_32x32x16_bf16(pa0,PK(0),o[d0],0,0,0);
    o[d0]=__builtin_amdgcn_mfma_f32_32x32x16_bf16(pa1,PK(1),o[d0],0,0,0);
    o[d0]=__builtin_amdgcn_mfma_f32_32x32x16_bf16(pa2,PK(2),o[d0],0,0,0);
    o[d0]=__builtin_amdgcn_mfma_f32_32x32x16_bf16(pa3,PK(3),o[d0],0,0,0);
    #undef PK
  }
}

#define ATTN_STORE16(p,v) (*(u32x4*)(p)=(v))
template<int MODE,int PKV,int THRL> __device__ __forceinline__ void attn_unit(const bf16*Qw0,const bf16*__restrict__ Kh,const bf16*__restrict__ Vh,bf16*Ow0,const int NT,const int q0,const int dq,const float l0,const float*__restrict__ gsrc,const float*__restrict__ rb,char*shm){
  int tid_=threadIdx.x; asm volatile("":"+v"(tid_));
  static_assert(MODE==0,"only the FoX form is instantiated: the phase-B C-init interleave reads the g copy (the window-table form is swa_unit)");
  const int tid=tid_,lane=tid&63,r32=lane&31,hi=lane>>5; const int wid=__builtin_amdgcn_readfirstlane(tid>>6);
  const bf16*Qw=Qw0+(long)(wid*QBLK)*PQ;
  const unsigned lds0=(unsigned)(uintptr_t)shm;
  float*wsf=(float*)(shm+LDS_WS)+wid*64;
  const lds_cptr shm3=(lds_cptr)shm;
  const lds_fptr gl=(lds_fptr)(shm3+LDS_GL); const lds_fptr tb=(lds_fptr)(shm3+LDS_TB);
  const bf16*ksrc=Kh+(long)lane*PKV+wid*8;
  const bf16*vsrc=Vh+(long)(16*(wid&3)+(lane>>2))*PKV+(wid>>2)*32+(lane&3)*8;
  const unsigned kdst=lds0+LDS_K+wid*1024, vdst=lds0+LDS_V+wid*1024;
  #define DMA_K(t,slot) glds16(ksrc+(long)(t)*KVBLK*PKV,(unsigned)__builtin_amdgcn_readfirstlane(kdst+(slot)))
  #define DMA_V(t,slot) glds16(vsrc+(long)(t)*KVBLK*PKV,(unsigned)__builtin_amdgcn_readfirstlane(vdst+(slot)))
  const int vb0=(int)(lds0+LDS_V)+((lane>>4)&1)*32+(lane&3)*8+(4*hi+((lane&15)>>2))*64;
  const char*Kbase=shm+LDS_K; bf16x8 kf[8];
  const lds_cptr kp0=shm3+LDS_K+hi*1024+r32*16; const lds_cptr vp0=shm3+LDS_V+((lane>>4)&1)*32+(lane&3)*8+(4*hi+((lane&15)>>2))*64;
  DMA_K(0,0);DMA_V(0,0);DMA_K(1,SLOTB);
  if(MODE==0){ const int n4=(q0+QB)>>2; for(int i=tid;i<n4;i+=NW*64) ((lds_f4ptr)gl)[i]=((const f32x4*)gsrc)[i]; }
  else{ for(int i=tid;i<640;i+=NW*64){ const int d=i-256; float v=-1e30f;
      if(d>=0&&d<128){ int bk=d; if(d>=16){ bk=16+(int)(__logf((float)d*(1.0f/16.0f))*(16.0f/2.0794415416798357f)); bk=bk>31?31:bk; } v=rb[bk*8]*LOG2E; }
      tb[i]=v; } }
  bf16x8 qr[4];
  #pragma unroll
  for(int d0=0;d0<4;++d0)qr[d0]=*reinterpret_cast<const bf16x8*>(&Qw[(long)r32*PQ+d0*16+hi*8]);
  const int qrel=wid*QBLK+r32;
  float mhat=(MODE==0)?gsrc[q0+qrel]:0.f; float l_reg=(MODE==0)?0.f:((hi==0)?l0:0.f);
  f32x16 o[2];o[0]=f32x16{};o[1]=f32x16{};
  #define CMASK(P0,P1,t) do{ if(MODE==0){int jb_=(t)-(NT-4); if(jb_>=0)cmask(P0,P1,jb_,qrel,hi);} }while(0)
  #define CINIT(X0,X1,tt) do{ if(MODE==0){ const lds_f4ptr gp_=(lds_f4ptr)(gl+64*(tt)+4*hi); \
        _Pragma("unroll") for(int g4=0;g4<4;++g4){ const f32x4 a_=gp_[2*g4], b_=gp_[8+2*g4]; \
          X0[4*g4]=a_[0]-mhat;X0[4*g4+1]=a_[1]-mhat;X0[4*g4+2]=a_[2]-mhat;X0[4*g4+3]=a_[3]-mhat; X1[4*g4]=b_[0]-mhat;X1[4*g4+1]=b_[1]-mhat;X1[4*g4+2]=b_[2]-mhat;X1[4*g4+3]=b_[3]-mhat; } } \
      else{ const lds_fptr tp_=tb+(dq+qrel-4*hi+256-64*(tt)); \
        _Pragma("unroll") for(int r=0;r<16;++r){ X0[r]=tp_[-((r&3)+8*(r>>2))]-mhat; X1[r]=tp_[-32-((r&3)+8*(r>>2))]-mhat; } } }while(0)
  bool resc=false;
  #define RESC() do{ if(resc){ asm volatile("s_waitcnt lgkmcnt(0)":::"memory"); \
      _Pragma("unroll") for(int d_=0;d_<2;++d_) _Pragma("unroll") for(int r=0;r<16;++r)o[d_][r]*=wsf[crow(r,hi)]; } }while(0)
  f32x16 pA0,pA1,pB0,pB1;
  int sl_prev=0,sl_cur=0,sl_next=SLOTB;
  #define ROT() do{sl_prev=sl_cur;sl_cur=sl_next;sl_next=(sl_next==(NSLOT-1)*SLOTB)?0:sl_next+SLOTB;}while(0)
  DMA_K(2,2*SLOTB);
  WAIT_BAR(3);
  CINIT(pA0,pA1,0);
  qkt(pA0,pA1,Kbase,qr,r32,hi);CMASK(pA0,pA1,0);
  { const float rm=rowmax(pA0,pA1);
    if(__any(rm>(float)THRL)){ const float dl=__builtin_fmaxf(rm,0.f); mhat+=dl;
      _Pragma("unroll") for(int r=0;r<16;++r){pA0[r]-=dl;pA1[r]-=dl;}
      l_reg*=__builtin_amdgcn_exp2f(-dl); }
    _Pragma("unroll") for(int r=0;r<16;++r){pA0[r]=__builtin_amdgcn_exp2f(pA0[r]);pA1[r]=__builtin_amdgcn_exp2f(pA1[r]);} }
  WAIT_BAR(0);
  DMA_K(3,0);DMA_V(1,SLOTB);
  ROT();
  kload8(kf,kp0+sl_cur);
  CINIT(pB0,pB1,1);
  WAIT_BAR(2);
  s16x4 vlo[8],vhi[8]; u32x4 pw0,pw1,pw2,pw3;
  #define PKW(P,B) cvtpk_s(P[B],P[B+1])
  #define PAF(k) __builtin_bit_cast(bf16x8,pw##k)
  #define VFR(i) (bf16x8){vlo[i][0],vlo[i][1],vlo[i][2],vlo[i][3],vhi[i][0],vhi[i][1],vhi[i][2],vhi[i][3]}
  #define PIN(x) asm volatile("":"+v"(x))
  #define GAPA(MF,A0,A1,A2,A3,W0,W1,PW) do{ MF; sacc+=A0; sacc+=A1; sacc+=A2; sacc+=A3; PIN(sacc); W0; W1; PIN(PW); SBAR(); }while(0)
  #define EX(v) __builtin_amdgcn_exp2f(v)
  #define GAPB(MF,X,B) do{ MF; X[B]=EX(X[B]); X[B+1]=EX(X[B+1]); X[B+2]=EX(X[B+2]); X[B+3]=EX(X[B+3]); PIN(X); SBAR(); }while(0)
  #define GAPB2(MF,X,B,G,LD,Y,YB,CI) do{ if(G){ LD; } MF; X[B]=EX(X[B]); X[B+1]=EX(X[B+1]); X[B+2]=EX(X[B+2]); X[B+3]=EX(X[B+3]); PIN(X); if(G){ Y[YB]=CI[0]-mhat; Y[YB+1]=CI[1]-mhat; Y[YB+2]=CI[2]-mhat; Y[YB+3]=CI[3]-mhat; PIN(Y); } SBAR(); }while(0)
  #define VRD(i) do{ vlo[i]=vtr(vp_+(((i)>>2)*4096+((i)&3)*1024)); vhi[i]=vtr(vp_+(((i)>>2)*4096+((i)&3)*1024+512)); }while(0)
  #define KRD(G,j) do{ if(G){ kload2(kf,kp0+sl_next,j); SBAR(); } }while(0)
  #define STEP(C0,C1,P0,P1,t,GK,GV,GL) do{ SBAR(); \
    const lds_cptr vp_=vp0+sl_prev; \
    VRD(0); SBAR(); float sacc=(P0[0]+P0[1]); \
    GAPA(C0=__builtin_amdgcn_mfma_f32_32x32x16_bf16(kf[0],qr[0],C0,0,0,0), P0[2],P0[3],P0[4],P0[5],     pw0[0]=PKW(P0,0), pw0[1]=PKW(P0,2), pw0); \
    VRD(4); SBAR(); GAPA(C1=__builtin_amdgcn_mfma_f32_32x32x16_bf16(kf[1],qr[0],C1,0,0,0), P0[6],P0[7],P0[8],P0[9],     pw0[2]=PKW(P0,4), pw0[3]=PKW(P0,6), pw0); \
    VRD(1); SBAR(); GAPA(C0=__builtin_amdgcn_mfma_f32_32x32x16_bf16(kf[2],qr[1],C0,0,0,0),   P0[10],P0[11],P0[12],P0[13], pw1[0]=PKW(P0,8), pw1[1]=PKW(P0,10), pw1); \
    VRD(5); SBAR(); GAPA(C1=__builtin_amdgcn_mfma_f32_32x32x16_bf16(kf[3],qr[1],C1,0,0,0),   P0[14],P0[15],P1[0],P1[1],   pw1[2]=PKW(P0,12),pw1[3]=PKW(P0,14), pw1); \
    VRD(2); SBAR(); GAPA(C0=__builtin_amdgcn_mfma_f32_32x32x16_bf16(kf[4],qr[2],C0,0,0,0),   P1[2],P1[3],P1[4],P1[5],     pw2[0]=PKW(P1,0), pw2[1]=PKW(P1,2), pw2); \
    VRD(6); SBAR(); GAPA(C1=__builtin_amdgcn_mfma_f32_32x32x16_bf16(kf[5],qr[2],C1,0,0,0),   P1[6],P1[7],P1[8],P1[9],     pw2[2]=PKW(P1,4), pw2[3]=PKW(P1,6), pw2); \
    VRD(3); SBAR(); GAPA(C0=__builtin_amdgcn_mfma_f32_32x32x16_bf16(kf[6],qr[3],C0,0,0,0),   P1[10],P1[11],P1[12],P1[13], pw3[0]=PKW(P1,8), pw3[1]=PKW(P1,10), pw3); \
    VRD(7); SBAR(); GAPA(C1=__builtin_amdgcn_mfma_f32_32x32x16_bf16(kf[7],qr[3],C1,0,0,0),   P1[14],P1[15],0.f,0.f,       pw3[2]=PKW(P1,12),pw3[3]=PKW(P1,14), pw3); \
    l_reg+=sacc; \
    if(GK){DMA_K((t)+3,sl_cur);} if(GV){DMA_V((t)+1,sl_next);} \
    CMASK(C0,C1,t); \
    { float a=MX3(C0[0],C0[1],C1[0]),b=MX3(C0[2],C0[3],C1[1]); a=MX3(a,C1[2],C1[3]); \
      _Pragma("unroll") for(int r=4;r<16;r+=4){a=MX3(a,C0[r],C0[r+1]);b=MX3(b,C0[r+2],C0[r+3]);a=MX3(a,C1[r],C1[r+1]);b=MX3(b,C1[r+2],C1[r+3]);} \
      float rm=__builtin_fmaxf(a,b); { auto rr=__builtin_amdgcn_permlane32_swap(__float_as_uint(rm),__float_as_uint(rm),false,false); rm=__builtin_fmaxf(__uint_as_float(rr[0]),__uint_as_float(rr[1])); } \
      resc=false; \
      if(__builtin_expect(__any(rm>(float)THRL),0)){ const float dl=__builtin_fmaxf(rm,0.f); mhat+=dl; \
        _Pragma("unroll") for(int r=0;r<16;++r){C0[r]-=dl;C1[r]-=dl;} \
        const float f=__builtin_amdgcn_exp2f(-dl); l_reg*=f; if(hi==0)wsf[r32]=f; resc=true; } } \
    SBAR(); \
      \
    const lds_f4ptr cig_=(lds_f4ptr)(gl+64*((t)+1)+4*hi); f32x4 cia_,cib_; \
    if(GV){ cia_=cig_[0]; } \
    GAPB2(o[0]=__builtin_amdgcn_mfma_f32_32x32x16_bf16(PAF(0),VFR(0),o[0],0,0,0), C0,0,  GV, cib_=cig_[8],  P0,0, cia_); \
    GAPB2(o[1]=__builtin_amdgcn_mfma_f32_32x32x16_bf16(PAF(0),VFR(4),o[1],0,0,0), C0,4,  GV, cia_=cig_[2],  P1,0, cib_); \
    KRD(GL,0); GAPB2(o[0]=__builtin_amdgcn_mfma_f32_32x32x16_bf16(PAF(1),VFR(1),o[0],0,0,0), C0,8,  GV, cib_=cig_[10], P0,4, cia_); \
    KRD(GL,1); GAPB2(o[1]=__builtin_amdgcn_mfma_f32_32x32x16_bf16(PAF(1),VFR(5),o[1],0,0,0), C0,12, GV, cia_=cig_[4],  P1,4, cib_); \
    KRD(GL,2); GAPB2(o[0]=__builtin_amdgcn_mfma_f32_32x32x16_bf16(PAF(2),VFR(2),o[0],0,0,0), C1,0,  GV, cib_=cig_[12], P0,8, cia_); \
    KRD(GL,3); GAPB2(o[1]=__builtin_amdgcn_mfma_f32_32x32x16_bf16(PAF(2),VFR(6),o[1],0,0,0), C1,4,  GV, cia_=cig_[6],  P1,8, cib_); \
    GAPB2(o[0]=__builtin_amdgcn_mfma_f32_32x32x16_bf16(PAF(3),VFR(3),o[0],0,0,0), C1,8,  GV, cib_=cig_[14], P0,12, cia_); \
    GAPB2(o[1]=__builtin_amdgcn_mfma_f32_32x32x16_bf16(PAF(3),VFR(7),o[1],0,0,0), C1,12, GV, (void)0,         P1,12, cib_); \
    }while(0)
  int t=1;
  #undef CMASK
  #define CMASK(P0,P1,t) do{}while(0)
  for(;t+5<NT;t+=2){
    STEP(pB0,pB1,pA0,pA1,t,true,true,true);     WAIT_BAR(2); RESC(); ROT();
    STEP(pA0,pA1,pB0,pB1,t+1,true,true,true);   WAIT_BAR(2); RESC(); ROT();
  }
  #undef CMASK
  #define CMASK(P0,P1,t) do{ if(MODE==0){int jb_=(t)-(NT-4); if(jb_>=0)cmask(P0,P1,jb_,qrel,hi);} }while(0)
  #define ENDW(tt) do{ if((tt)+3<NT){WAIT_BAR(2);} else if((tt)+2<NT){WAIT_BAR(1);} else {WAIT_BAR(0);} }while(0)
  for(;t+1<NT;t+=2){
    STEP(pB0,pB1,pA0,pA1,t,(t+3<NT),(t+1<NT),(t+1<NT));       ENDW(t);   RESC(); ROT();
    STEP(pA0,pA1,pB0,pB1,t+1,(t+4<NT),(t+2<NT),(t+2<NT));     ENDW(t+1); RESC(); ROT();
  }
  STEP(pB0,pB1,pA0,pA1,NT-1,false,false,false); RESC();
  { float sacc=pB0[0]+pB0[1]; _Pragma("unroll") for(int r=2;r<16;++r)sacc+=pB0[r]; _Pragma("unroll") for(int r=0;r<16;++r)sacc+=pB1[r]; l_reg+=sacc;
    pw0=(u32x4){PKW(pB0,0),PKW(pB0,2),PKW(pB0,4),PKW(pB0,6)};pw1=(u32x4){PKW(pB0,8),PKW(pB0,10),PKW(pB0,12),PKW(pB0,14)};pw2=(u32x4){PKW(pB1,0),PKW(pB1,2),PKW(pB1,4),PKW(pB1,6)};pw3=(u32x4){PKW(pB1,8),PKW(pB1,10),PKW(pB1,12),PKW(pB1,14)};
    SBAR(); pv(o,vb0+sl_cur,PAF(0),PAF(1),PAF(2),PAF(3)); }
  #undef PKW
  #undef PAF
  #undef VFR
  #undef PIN
  #undef GAPA
  #undef GAPB
  #undef GAPB2
  #undef EX
  #undef VRD
  #undef KRD
  #undef STEP
  #undef ENDW
  {auto rr=__builtin_amdgcn_permlane32_swap(__float_as_uint(l_reg),__float_as_uint(l_reg),false,false);l_reg=__uint_as_float(rr[0])+__uint_as_float(rr[1]);}
  if(hi==0)wsf[32+r32]=l_reg;asm volatile("s_waitcnt lgkmcnt(0)":::"memory");
  float rli[16];
  #pragma unroll
  for(int r=0;r<16;++r)rli[r]=__builtin_amdgcn_rcpf(wsf[32+crow(r,hi)]);
  bf16*Ow=Ow0+(long)(wid*QBLK)*PQ;
  { bf16*stg=(bf16*)(shm+LDS_OST)+wid*2048;
    #pragma unroll
    for(int r=0;r<16;++r){const int orow=crow(r,hi);
      #pragma unroll
      for(int d0=0;d0<2;++d0)stg[orow*64+d0*32+r32]=__float2bfloat16(o[d0][r]*rli[r]);}
    asm volatile("s_waitcnt lgkmcnt(0)":::"memory");
    #pragma unroll
    for(int i=0;i<4;++i){const int row=i*8+(lane>>3),ch=lane&7; const u32x4 v=*(const u32x4*)(stg+row*64+ch*8); ATTN_STORE16(Ow+(long)row*PQ+ch*8,v);} }
  asm volatile("s_waitcnt lgkmcnt(0)\n\ts_barrier":::"memory");
  #undef DMA_K
  #undef DMA_V
  #undef CMASK
  #undef CINIT
  #undef RESC
  #undef ROT
}

constexpr int SWA_K=0, SWA_V=49152, SWA_TB=98304, SWA_LDS_BYTES=SWA_TB+4*640*4;
__device__ __forceinline__ void swa_unit(int b,int kvh,int qb,bf16*QA,const bf16*__restrict__ KA,const bf16*__restrict__ VA,const float*__restrict__ sink,const float*__restrict__ rel_bias,char*shm){
  int tid_=threadIdx.x; asm volatile("":"+v"(tid_));
  const int tid=tid_,lane=tid&63,r32=lane&31,hi=lane>>5; const int wid=__builtin_amdgcn_readfirstlane(tid>>6);
  const lds_cptr shm3=(lds_cptr)shm; const unsigned lds0=(unsigned)(uintptr_t)shm;
  const lds_fptr tb=(lds_fptr)(shm3+SWA_TB);
  const int q0=qb*QB, T0=(qb==0)?0:4*qb-2, NT=4*qb+4-T0, dq=q0-64*T0; const size_t rb=(size_t)b*SEQ;
  { const bf16*ksrc=KA+(rb+64*T0+lane)*128+kvh*64+wid*8;
    const bf16*vsrc=VA+(rb+64*T0+16*(wid&3)+(lane>>2))*128+kvh*64+(wid>>2)*32+(lane&3)*8;
    for(int t=0;t<NT;++t){ glds16(ksrc+(long)t*KVBLK*128,(unsigned)__builtin_amdgcn_readfirstlane(lds0+SWA_K+t*SLOTB+wid*1024)); glds16(vsrc+(long)t*KVBLK*128,(unsigned)__builtin_amdgcn_readfirstlane(lds0+SWA_V+t*SLOTB+wid*1024)); } }
  for(int i=tid;i<640;i+=NW*64){ const int d=i-256; const bool in=(d>=0&&d<128); int bk=d<0?0:d; if(d>=16){ bk=16+(int)(__logf((float)d*(1.0f/16.0f))*(16.0f/2.0794415416798357f)); bk=bk>31?31:bk; }
    const float*rp=rel_bias+bk*8+4*kvh;
    #pragma unroll
    for(int hh=0;hh<4;++hh) tb[hh*640+i]=in?rp[hh]*LOG2E:-1e30f; }
  asm volatile("s_waitcnt vmcnt(0) lgkmcnt(0)\n\ts_barrier":::"memory");
  const int qrel=wid*QBLK+r32, off=dq+QBLK*wid;
  const int t_lo=(off>127)?((off-127)>>6):0, t_hi=(off+31)>>6;
  const lds_cptr kp0=shm3+SWA_K+hi*1024+r32*16; const lds_cptr vp0=shm3+SWA_V+((lane>>4)&1)*32+(lane&3)*8+(4*hi+((lane&15)>>2))*64;
  bf16x8 qn[4];
  { const bf16*Q0=QA+(rb+q0+wid*QBLK)*PQ+(4*kvh)*64;
    #pragma unroll
    for(int d0=0;d0<4;++d0)qn[d0]=*reinterpret_cast<const bf16x8*>(&Q0[(long)r32*PQ+d0*16+hi*8]); }
  #pragma unroll 1
  for(int hh=0;hh<4;++hh){
    const int hq=4*kvh+hh; bf16*Qw=QA+(rb+q0+wid*QBLK)*PQ+hq*64;
    bf16x8 qr[4];
    #pragma unroll
    for(int d0=0;d0<4;++d0)qr[d0]=qn[d0];
    { const bf16*Q1=Qw+((hh<3)?64:0);
      #pragma unroll
      for(int d0=0;d0<4;++d0)qn[d0]=*reinterpret_cast<const bf16x8*>(&Q1[(long)r32*PQ+d0*16+hi*8]); }
    const lds_fptr tp=tb+hh*640+(dq+qrel-4*hi+256);
    f32x16 s[3][2];
    #pragma unroll
    for(int k=0;k<3;++k){ const int t=t_lo+k;
      if(t<=t_hi){ const lds_fptr tq=tp-64*t;
        #pragma unroll
        for(int r=0;r<16;++r){ s[k][0][r]=tq[-((r&3)+8*(r>>2))]; s[k][1][r]=tq[-32-((r&3)+8*(r>>2))]; }
        const lds_cptr kp=kp0+t*SLOTB;
        #pragma unroll
        for(int d0=0;d0<4;++d0){ const bf16x8 a0=*(const __attribute__((address_space(3))) bf16x8*)(kp+d0*2048), a1=*(const __attribute__((address_space(3))) bf16x8*)(kp+d0*2048+512);
          s[k][0]=__builtin_amdgcn_mfma_f32_32x32x16_bf16(a0,qr[d0],s[k][0],0,0,0); s[k][1]=__builtin_amdgcn_mfma_f32_32x32x16_bf16(a1,qr[d0],s[k][1],0,0,0); } }
      else{
        #pragma unroll
        for(int r=0;r<16;++r){ s[k][0][r]=-1e30f; s[k][1][r]=-1e30f; } } }
    const float sk2=sink[hq]*LOG2E;
    float m=__builtin_fmaxf(__builtin_fmaxf(rowmax(s[0][0],s[0][1]),rowmax(s[1][0],s[1][1])),__builtin_fmaxf(rowmax(s[2][0],s[2][1]),sk2));
    float l=0.f;
    #pragma unroll
    for(int k=0;k<3;++k)
      #pragma unroll
      for(int r=0;r<16;++r){ s[k][0][r]=__builtin_amdgcn_exp2f(s[k][0][r]-m); s[k][1][r]=__builtin_amdgcn_exp2f(s[k][1][r]-m); l+=s[k][0][r]+s[k][1][r]; }
    { auto rr=__builtin_amdgcn_permlane32_swap(__float_as_uint(l),__float_as_uint(l),false,false); l=__uint_as_float(rr[0])+__uint_as_float(rr[1]); }
    l+=__builtin_amdgcn_exp2f(sk2-m);
    f32x16 o[2]; o[0]=f32x16{}; o[1]=f32x16{};
    #pragma unroll
    for(int k=0;k<3;++k){ const int t=t_lo+k;
      if(t<=t_hi){ const lds_cptr vp=vp0+t*SLOTB;
        u32x4 pw[4];
        pw[0]=(u32x4){cvtpk_s(s[k][0][0],s[k][0][1]),cvtpk_s(s[k][0][2],s[k][0][3]),cvtpk_s(s[k][0][4],s[k][0][5]),cvtpk_s(s[k][0][6],s[k][0][7])};
        pw[1]=(u32x4){cvtpk_s(s[k][0][8],s[k][0][9]),cvtpk_s(s[k][0][10],s[k][0][11]),cvtpk_s(s[k][0][12],s[k][0][13]),cvtpk_s(s[k][0][14],s[k][0][15])};
        pw[2]=(u32x4){cvtpk_s(s[k][1][0],s[k][1][1]),cvtpk_s(s[k][1][2],s[k][1][3]),cvtpk_s(s[k][1][4],s[k][1][5]),cvtpk_s(s[k][1][6],s[k][1][7])};
        pw[3]=(u32x4){cvtpk_s(s[k][1][8],s[k][1][9]),cvtpk_s(s[k][1][10],s[k][1][11]),cvtpk_s(s[k][1][12],s[k][1][13]),cvtpk_s(s[k][1][14],s[k][1][15])};
        #pragma unroll
        for(int dh=0;dh<2;++dh)
          #pragma unroll
          for(int ks=0;ks<4;++ks){ const s16x4 lo=vtr(vp+dh*4096+ks*1024), hh2=vtr(vp+dh*4096+ks*1024+512);
            const bf16x8 vf=(bf16x8){lo[0],lo[1],lo[2],lo[3],hh2[0],hh2[1],hh2[2],hh2[3]};
            o[dh]=__builtin_amdgcn_mfma_f32_32x32x16_bf16(__builtin_bit_cast(bf16x8,pw[ks]),vf,o[dh],0,0,0); } } }
    const lds_fptr wsf=(lds_fptr)(shm3+SWA_LDS_BYTES)+wid*64;
    if(hi==0)wsf[r32]=l;
    float rli[16];
    #pragma unroll
    for(int r=0;r<16;++r)rli[r]=__builtin_amdgcn_rcpf(wsf[crow(r,hi)]);
    { bf16*stg=(bf16*)(shm+SWA_LDS_BYTES+2048)+wid*2048;
      #pragma unroll
      for(int r=0;r<16;++r){const int orow=crow(r,hi);
        #pragma unroll
        for(int d0=0;d0<2;++d0)stg[orow*64+d0*32+r32]=__float2bfloat16(o[d0][r]*rli[r]);}
      #pragma unroll
      for(int i=0;i<4;++i){const int row=i*8+(lane>>3),ch=lane&7; const u32x4 v=*(const u32x4*)(stg+row*64+ch*8); *(u32x4*)(Qw+(long)row*PQ+ch*8)=v;} }
  }
  asm volatile("s_waitcnt lgkmcnt(0)\n\ts_barrier":::"memory");
}

constexpr int MEM_K=0, MEM_V=65536;
__device__ __forceinline__ void mem_unit(int b,int h,int qb,const bool prep,const unsigned char*__restrict__ MIMG,const bf16*QM,bf16*OM,char*shm,char*wsbase,char*stgbase,void*tsdbg){
  int tid_=threadIdx.x; asm volatile("":"+v"(tid_));
  const int tid=tid_,lane=tid&63,r32=lane&31,hi=lane>>5; const int wid=__builtin_amdgcn_readfirstlane(tid>>6);
  const lds_cptr shm3=(lds_cptr)shm;
  const lds_fptr wsf=(lds_fptr)((lds_cptr)wsbase)+wid*64;
  constexpr float EPSM=1e-6f;
  if(prep){ const unsigned lds0=(unsigned)(uintptr_t)shm; const unsigned char*src=MIMG+(size_t)(b*4+h)*131072+wid*1024+lane*16;
    #pragma unroll 4
    for(int i=0;i<16;++i) glds16(src+i*8192,(unsigned)__builtin_amdgcn_readfirstlane(lds0+i*8192+wid*1024)); }
  const bf16*Qw=QM+(size_t)(b*SEQ+qb*QB+wid*QBLK+r32)*PQ+h*128+hi*8;
  bf16x8 qr[8]; float qs=0.f;
  #pragma unroll
  for(int d0=0;d0<8;++d0){ qr[d0]=*reinterpret_cast<const bf16x8*>(Qw+16*d0);
    #pragma unroll
    for(int e=0;e<8;++e){ const float f=__uint_as_float(((unsigned)(unsigned short)qr[d0][e])<<16); qs+=f*f; } }
  { auto rr=__builtin_amdgcn_permlane32_swap(__float_as_uint(qs),__float_as_uint(qs),false,false); qs=__uint_as_float(rr[0])+__uint_as_float(rr[1]); }
  const float sc=1.0f/sqrtf(qs*(1.0f/128.0f)+EPSM);
  asm volatile("s_waitcnt vmcnt(0) lgkmcnt(0)\n\ts_barrier":::"memory");
#if defined(TSPROBE)
  if(prep&&threadIdx.x==0) atomicMax((unsigned long long*)tsdbg+19,(unsigned long long)__builtin_amdgcn_s_memrealtime());
#endif
  float m=-1e30f,l=0.f; f32x16 o[4]; o[0]=f32x16{};o[1]=f32x16{};o[2]=f32x16{};o[3]=f32x16{};
  const lds_cptr kp0=shm3+MEM_K+hi*4096+r32*16;
  const lds_cptr vp0=shm3+MEM_V+((lane>>4)&1)*32+(lane&3)*8+(4*hi+((lane&15)>>2))*64;
  #pragma unroll 1
  for(int t=0;t<4;++t){
    f32x16 p0=f32x16{},p1=f32x16{};
    { bf16x8 kf[16];
      #pragma unroll
      for(int d0=0;d0<8;++d0){ kf[2*d0]=*(const __attribute__((address_space(3))) bf16x8*)(kp0+d0*8192+t*1024); kf[2*d0+1]=*(const __attribute__((address_space(3))) bf16x8*)(kp0+d0*8192+t*1024+512); }
      SBAR();
      #pragma unroll
      for(int d0=0;d0<8;++d0){ p0=__builtin_amdgcn_mfma_f32_32x32x16_bf16(kf[2*d0],qr[d0],p0,0,0,0); p1=__builtin_amdgcn_mfma_f32_32x32x16_bf16(kf[2*d0+1],qr[d0],p1,0,0,0); }
      SBAR(); }
    #pragma unroll
    for(int r=0;r<16;++r){p0[r]*=sc;p1[r]*=sc;}
    const float rm=rowmax(p0,p1);
    const bool mv=(t==0)||__any(rm>m+8.0f);
    float alpha=1.0f;
    if(mv){ const float mn=__builtin_fmaxf(m,rm); alpha=__builtin_amdgcn_exp2f(m-mn); m=mn; }
    float rs=0.f;
    #pragma unroll
    for(int r=0;r<16;++r){p0[r]=__builtin_amdgcn_exp2f(p0[r]-m);p1[r]=__builtin_amdgcn_exp2f(p1[r]-m);rs+=p0[r]+p1[r];}
    l=l*alpha+rs;
    if(mv&&t!=0){
      if(hi==0)wsf[r32]=alpha;
      #pragma unroll
      for(int r=0;r<16;++r){ const float a=wsf[crow(r,hi)]; o[0][r]*=a;o[1][r]*=a;o[2][r]*=a;o[3][r]*=a; } }
    u32x4 pw0,pw1,pw2,pw3;
    pw0=(u32x4){cvtpk_s(p0[0],p0[1]),cvtpk_s(p0[2],p0[3]),cvtpk_s(p0[4],p0[5]),cvtpk_s(p0[6],p0[7])};
    pw1=(u32x4){cvtpk_s(p0[8],p0[9]),cvtpk_s(p0[10],p0[11]),cvtpk_s(p0[12],p0[13]),cvtpk_s(p0[14],p0[15])};
    pw2=(u32x4){cvtpk_s(p1[0],p1[1]),cvtpk_s(p1[2],p1[3]),cvtpk_s(p1[4],p1[5]),cvtpk_s(p1[6],p1[7])};
    pw3=(u32x4){cvtpk_s(p1[8],p1[9]),cvtpk_s(p1[10],p1[11]),cvtpk_s(p1[12],p1[13]),cvtpk_s(p1[14],p1[15])};
    const lds_cptr vp=vp0+t*16384;
    s16x4 va[8],vb[8];
    #define MEM_VRD(V,db) do{ _Pragma("unroll") for(int ks=0;ks<4;++ks){ V[2*ks]=vtr(vp+(db)*4096+ks*1024); V[2*ks+1]=vtr(vp+(db)*4096+ks*1024+512); } }while(0)
    #define MEM_VF(V,ks) (bf16x8){V[2*(ks)][0],V[2*(ks)][1],V[2*(ks)][2],V[2*(ks)][3],V[2*(ks)+1][0],V[2*(ks)+1][1],V[2*(ks)+1][2],V[2*(ks)+1][3]}
    #define MEM_PV(V,db) do{ o[db]=__builtin_amdgcn_mfma_f32_32x32x16_bf16(__builtin_bit_cast(bf16x8,pw0),MEM_VF(V,0),o[db],0,0,0); o[db]=__builtin_amdgcn_mfma_f32_32x32x16_bf16(__builtin_bit_cast(bf16x8,pw1),MEM_VF(V,1),o[db],0,0,0); \
        o[db]=__builtin_amdgcn_mfma_f32_32x32x16_bf16(__builtin_bit_cast(bf16x8,pw2),MEM_VF(V,2),o[db],0,0,0); o[db]=__builtin_amdgcn_mfma_f32_32x32x16_bf16(__builtin_bit_cast(bf16x8,pw3),MEM_VF(V,3),o[db],0,0,0); }while(0)
    MEM_VRD(va,0); SBAR();
    MEM_VRD(vb,1); MEM_PV(va,0); SBAR();
    MEM_VRD(va,2); MEM_PV(vb,1); SBAR();
    MEM_VRD(vb,3); MEM_PV(va,2); SBAR();
    MEM_PV(vb,3); SBAR();
    #undef MEM_VRD
    #undef MEM_VF
    #undef MEM_PV
  }
  { auto rr=__builtin_amdgcn_permlane32_swap(__float_as_uint(l),__float_as_uint(l),false,false); l=__uint_as_float(rr[0])+__uint_as_float(rr[1]); }
  if(hi==0)wsf[32+r32]=l;
  bf16*Ow=OM+(size_t)(b*SEQ+qb*QB+wid*QBLK)*PQ+h*128;
  { bf16*stg=(bf16*)stgbase+wid*1024;
    #pragma unroll
    for(int g=0;g<4;++g){
      #pragma unroll
      for(int j=0;j<4;++j){ const int r=4*g+j; const float rl=__builtin_amdgcn_rcpf(wsf[32+crow(r,hi)]);
        #pragma unroll
        for(int db=0;db<4;++db) stg[(4*hi+j)*128+32*db+r32]=__float2bfloat16(o[db][r]*rl); }
      #pragma unroll
      for(int i=0;i<2;++i){ const int row=i*4+(lane>>4),ch=lane&15; const u32x4 v=*(const u32x4*)(stg+row*128+ch*8); *(u32x4*)(Ow+(size_t)(8*g+row)*PQ+ch*8)=v; } } }
  __syncthreads();
}
#undef SBAR
#undef WAIT_BAR
#undef MX3
}

constexpr int NWAVES = 8;
constexpr int SEQ = 4096, NBATCH = 8, MTOK = NBATCH * SEQ, MMEM = NBATCH * 256;
constexpr int NIN_ARGS = 23;
enum InIdx { I_X = 0, I_MEM, I_GMIX, I_WIN, I_BGATE, I_BFORGET, I_QNSWA, I_KNSWA, I_SINK, I_RELBIAS, I_QNFOX, I_KNFOX, I_GMEM, I_WMEMKV, I_QNMEM, I_KNMEM, I_WOSWA, I_WOFOX, I_WOMEM, I_WOUT, I_GMLP, I_WUP, I_WDN };
constexpr size_t MiB = 1u << 20;
#if defined(TSPROBE) || (defined(DETPROBE) && DETPROBE)
constexpr size_t WS_CTL = 0, CTL_ZERO_BYTES = 128 * 1024;
#else
constexpr size_t WS_CTL = 0, CTL_ZERO_BYTES = 32 * 1024;
#endif
constexpr size_t WS_WIN = 2 * MiB, WS_WKV = 14 * MiB, WS_WO = 16 * MiB, WS_WOUT = 19 * MiB, WS_WUP = 25 * MiB, WS_WD = 33 * MiB;
constexpr size_t WS_LOGF = 41 * MiB, WS_G2 = 42 * MiB, WS_SSQ = 43 * MiB, WS_MEMN = 45 * MiB, WS_MKV = 49 * MiB, WS_RINV = 57 * MiB;
constexpr size_t WS_MRG = 160 * MiB;
constexpr size_t WS_GT = 64 * MiB;
constexpr size_t WS_H = 256 * MiB;
constexpr size_t WS_U = 64 * MiB;
constexpr size_t WS_QCAT = 320 * MiB, WS_KA = 416 * MiB, WS_VA = 424 * MiB, WS_KF = 432 * MiB, WS_VF = 464 * MiB;
constexpr size_t WS_X1B = 320 * MiB;
constexpr size_t WS_END = 496 * MiB;
constexpr int CW_FOXQ = 2048;
constexpr int CW_BAR = 4096;
constexpr int RING_OFF = 0, RING_BYTES = 131072;
constexpr int ATT_EXTRA_OFF = RING_BYTES;
constexpr int LDSCTL_OFF = 159744, MISC_OFF = LDSCTL_OFF + 320, MEMWS_OFF = LDSCTL_OFF + 1024, DUMP_OFF = LDSCTL_OFF + 3072;
constexpr int LDS_BYTES = 163840;
static_assert((CW_BAR + 3456) * 4 <= (int)CTL_ZERO_BYTES && DUMP_OFF + 256 <= LDS_BYTES && pg8::STAGE_BYTES == RING_BYTES && MEMWS_OFF + 2048 <= DUMP_OFF && attn_body::LDS_BYTES <= RING_BYTES && attn_body::SWA_LDS_BYTES + 2048 + 32768 <= LDSCTL_OFF && ATT_EXTRA_OFF + 92 * 64 * 4 + 4096 <= LDSCTL_OFF, "LDS map");
#define GAS __attribute__((address_space(1)))
#define LAS __attribute__((address_space(3)))
typedef unsigned short bf16;
typedef unsigned v4u __attribute__((ext_vector_type(4)));
typedef float f32x4 __attribute__((ext_vector_type(4)));
typedef short bf16x8 __attribute__((ext_vector_type(8)));
typedef GAS unsigned gu32;
typedef GAS unsigned long long gu64;
#define RLX_AGENT __ATOMIC_RELAXED, __HIP_MEMORY_SCOPE_AGENT
#define LDS_WAIT() asm volatile("s_waitcnt lgkmcnt(0)" ::: "memory")
#define VM_WAIT() asm volatile("s_waitcnt vmcnt(0)" ::: "memory")
__device__ __forceinline__ unsigned long long rt() { return __builtin_amdgcn_s_memrealtime(); }
__device__ __forceinline__ unsigned f2bf(float f) { unsigned u = __builtin_bit_cast(unsigned, f); return (u + 0x7fffu + ((u >> 16) & 1u)) >> 16; }
__device__ __forceinline__ unsigned pk2(float lo, float hi) { return f2bf(lo) | (f2bf(hi) << 16); }

#define XB_TMO      128
#define XB_XCNT(j)  (256  + 64 * (j))
#define XB_XSUB(j)  (1280 + 64 * (j))
#define XB_XGEN(j)  (2304 + 64 * (j))
#define XB_TOP      3328
#define XB_TOPGEN   3392
#define XCD_BAR_WORDS 3456
#define XB_SPIN_CAP (1u << 18)

__device__ __forceinline__ unsigned xb_ld(unsigned* p)              { return __hip_atomic_load(p, __ATOMIC_RELAXED, __HIP_MEMORY_SCOPE_AGENT); }
__device__ __forceinline__ unsigned xb_add(unsigned* p, unsigned v) { return __hip_atomic_fetch_add(p, v, __ATOMIC_RELAXED, __HIP_MEMORY_SCOPE_AGENT); }
__device__ __forceinline__ unsigned xb_xcc_id() { return (unsigned)__builtin_amdgcn_s_getreg((3 << 11) | 20) & 0xFu; }
#define XB_SPIN(cond, bar) do { unsigned _sp = 0; while (cond) { __builtin_amdgcn_s_sleep(1); \
    if ((++_sp & 255u) == 0u) { if (xb_ld(&(bar)[XB_TMO])) break; if (_sp > XB_SPIN_CAP) { atomicAdd(&(bar)[XB_TMO], 1u); break; } } } } while (0)

struct XcdBarrier {
    unsigned* bar; unsigned x;
    volatile LAS unsigned* st;
};

__device__ __forceinline__ XcdBarrier xcd_barrier_post(unsigned* bar, volatile LAS unsigned* st) {
    XcdBarrier b; b.bar = bar; b.x = xb_xcc_id(); b.st = st;
    if (threadIdx.x == 0) (void)xb_add(&bar[XB_XCNT(b.x)], 1u);
    return b;
}
__device__ __forceinline__ void xcd_barrier_complete(unsigned* bar, unsigned x, unsigned& nloc, unsigned& nx) {
    const unsigned G = gridDim.x * gridDim.y * gridDim.z;
    unsigned sum, cnt, mine, sp = 0u;
    for (;;) {
        sum = 0u; cnt = 0u; mine = 0u;
#pragma unroll
        for (unsigned j = 0; j < 16; ++j) { const unsigned c = xb_ld(&bar[XB_XCNT(j)]); sum += c; cnt += (c > 0u) ? 1u : 0u; mine = (j == x) ? c : mine; }
        if (sum == G) break;
        __builtin_amdgcn_s_sleep(1);
        if ((++sp & 255u) == 0u) { if (xb_ld(&bar[XB_TMO])) break; if (sp > XB_SPIN_CAP) { atomicAdd(&bar[XB_TMO], 1u); break; } }
    }
    nloc = mine > 0u ? mine : 1u; nx = cnt > 0u ? cnt : 1u;
}

__device__ __forceinline__ void xcd_barrier(const XcdBarrier& b) {
    asm volatile("s_waitcnt vmcnt(0)" ::: "memory");
    __syncthreads();
    if (threadIdx.x == 0) {
        unsigned* bar = b.bar;
        __builtin_amdgcn_s_waitcnt(0);
        unsigned nloc = b.st[0], nx = b.st[1];
        if (nloc == 0u) { xcd_barrier_complete(bar, b.x, nloc, nx); b.st[0] = nloc; b.st[1] = nx; }
        const unsigned old = xb_add(&bar[XB_XSUB(b.x)], 1u);
        const unsigned gen = old / nloc;
        if (old + 1u == (gen + 1u) * nloc) {
            __builtin_amdgcn_fence(__ATOMIC_RELEASE, "agent");
            asm volatile("s_waitcnt vmcnt(0)" ::: "memory");
            const unsigned og = xb_add(&bar[XB_TOP], 1u);
            const unsigned tg = og / nx;
            if (og + 1u == (tg + 1u) * nx) xb_add(&bar[XB_TOPGEN], 1u);
            else XB_SPIN(xb_ld(&bar[XB_TOPGEN]) == tg, bar);
            __builtin_amdgcn_fence(__ATOMIC_ACQUIRE, "agent");
            xb_add(&bar[XB_XGEN(b.x)], 1u);
            asm volatile("s_waitcnt vmcnt(0)" ::: "memory");
        } else {
            XB_SPIN(xb_ld(&bar[XB_XGEN(b.x)]) == gen, bar);
            __builtin_amdgcn_fence(__ATOMIC_ACQUIRE, "agent");
            asm volatile("s_waitcnt vmcnt(0)" ::: "memory");
        }
    }
    __syncthreads();
}

#if defined(DETPROBE) && DETPROBE
constexpr size_t WS_CHK = 57 * MiB;
__global__ void chk_sum(const unsigned* p, size_t nwords, unsigned long long* dst) {
    unsigned long long s = 0; const size_t stride = (size_t)gridDim.x * blockDim.x;
    for (size_t i = (size_t)blockIdx.x * blockDim.x + threadIdx.x; i < nwords; i += stride) s += (unsigned long long)p[i] * (unsigned long long)((i & 1023) + 1);
#pragma unroll
    for (int o = 32; o > 0; o >>= 1) s += __shfl_xor(s, o);
    if ((threadIdx.x & 63) == 0) atomicAdd(dst, s);
}
__global__ void chk_report(const unsigned long long* chk, float* out, int nslots, size_t n) {
    float mk = 0.f; for (int s = 0; s < nslots; ++s) if (chk[s] != chk[64 + s]) { mk = 1000.0f * (float)(s + 1); break; }
    const size_t stride = (size_t)gridDim.x * blockDim.x;
    for (size_t i = (size_t)blockIdx.x * blockDim.x + threadIdx.x; i < n; i += stride) out[i] = (i == 0) ? mk : 0.f;
}
#endif


struct Frame {
    LAS unsigned char* lds;
    volatile LAS unsigned* MISC;
    gu32* ctl;
    int tid, lane, wave;
    int vcu, G;
    const float *x, *mem, *w_in, *w_mem_kv, *w_o_swa, *w_o_fox, *w_o_mem, *w_out, *w_up, *w_dn, *g_mix, *g_mlp, *g_mem, *b_forget;
    float* out; unsigned char* ws;
};

__device__ __forceinline__ float wave_sum(float v) {
#pragma unroll
    for (int o = 1; o < 64; o <<= 1) v += __shfl_xor(v, o);
    return v;
}
typedef float f32x2_t __attribute__((ext_vector_type(2))); typedef __bf16 bf16x2_t __attribute__((ext_vector_type(2)));
__device__ __forceinline__ unsigned pkc(float lo, float hi) { f32x2_t v = {lo, hi}; bf16x2_t b = __builtin_convertvector(v, bf16x2_t); return __builtin_bit_cast(unsigned, b); }
__device__ __forceinline__ void p0_tr_item(const float* __restrict__ W, int ldw, int k0, int n0, bf16* WT, int ldt, int drow_lane, int dk0, const float* __restrict__ kscale, int lane) {
    const int c4 = lane & 7, kg = lane >> 3;
    const float* src = W + (size_t)(k0 + 8 * kg) * ldw + n0 + 4 * c4;
    f32x4 r[8];
#pragma unroll
    for (int i = 0; i < 8; ++i) r[i] = *(const GAS f32x4*)(src + (size_t)i * ldw);
    if (kscale) { const f32x4 s0 = *(const GAS f32x4*)(kscale + k0 + 8 * kg), s1 = *(const GAS f32x4*)(kscale + k0 + 8 * kg + 4);
#pragma unroll
        for (int i = 0; i < 4; ++i) { r[i] = r[i] * s0[i]; r[4 + i] = r[4 + i] * s1[i]; } }
    bf16* dst = WT + (size_t)drow_lane * ldt + dk0 + k0 + 8 * kg;
#pragma unroll
    for (int e = 0; e < 4; ++e) { v4u o; o.x = pkc(r[0][e], r[1][e]); o.y = pkc(r[2][e], r[3][e]); o.z = pkc(r[4][e], r[5][e]); o.w = pkc(r[6][e], r[7][e]); *(GAS v4u*)(dst + (size_t)e * ldt) = o; }
}
__device__ __forceinline__ int in_srcbase(int g) {
    return g < 8 ? 64 * g : g < 10 ? 512 + 64 * (g - 8) : g < 12 ? 640 + 64 * (g - 10) : g < 20 ? 768 + 64 * (g - 12) : g < 28 ? 1280 + 64 * (g - 20) : g < 36 ? 1792 + 64 * (g - 28) : g < 44 ? 2312 + 64 * (g - 36) : 2824 + 64 * (g - 44);
}
__device__ __forceinline__ float rms_row_to_bf16(const f32x4 (&v)[4], const f32x4 (&gn)[4], bf16* orow, int lane, f32x4 (&vg)[4], float* rinv) {
    float s = 0.f;
#pragma unroll
    for (int j = 0; j < 4; ++j) s += (v[j].x * v[j].x + v[j].y * v[j].y) + (v[j].z * v[j].z + v[j].w * v[j].w);
    const float rt2 = sqrtf(wave_sum(s) * (1.f / 1024.f) + 1e-6f); const float r = 1.f / rt2;
    if (rinv && lane == 0) *rinv = rt2;
    GAS unsigned long long* o8 = (GAS unsigned long long*)orow + lane;
#pragma unroll
    for (int j = 0; j < 4; ++j) { vg[j] = v[j] * gn[j]; const f32x4 y = vg[j] * r; o8[64 * j] = (unsigned long long)pkc(y.x, y.y) | ((unsigned long long)pkc(y.z, y.w) << 32); }
    return r;
}
__device__ __forceinline__ int adj_row(int n) { return 128 * ((n >> 3) & 1) + 32 * (n >> 6) + 8 * ((n & 63) >> 4) + (n & 7); }
constexpr int I_IN = 16 * 184, I_KV = 16 * 32, I_O1 = 8 * 32, I_OUT = 16 * 32, I_UP = 16 * 128, I_DN = 64 * 32;
constexpr int I_EARLY = I_IN + I_KV, NITEMS = I_IN + I_KV + 3 * I_O1 + I_OUT + I_UP + I_DN;
struct WItem { size_t dst; int ldt, ksc; };
__device__ __forceinline__ WItem witem_fetch(const Frame& F, int it, f32x4 (&rr)[8]) {
    const int c4 = F.lane & 7, kg = F.lane >> 3;
    WItem w; w.ksc = -1;
#define WI_LOAD(Wp_, ldw_, k0_, n0_) do { const float* sp_ = (Wp_) + (size_t)((k0_) + 8 * kg) * (ldw_) + (n0_) + 4 * c4; _Pragma("unroll") for (int i = 0; i < 8; ++i) rr[i] = *(const GAS f32x4*)(sp_ + (size_t)i * (ldw_)); } while (0)
#define WI_DST(ws_off_, ldt_, drow_, dk_) do { w.ldt = (ldt_); w.dst = (size_t)(ws_off_) / 2 + (size_t)(drow_) * (ldt_) + (dk_) + 8 * kg; } while (0)
    int r = it;
    if (r < I_IN) { const int kb = r / 184, gg = r % 184, g = gg >> 1, bj = gg & 1;
        const int drow = 256 * (g >> 2) + ((g >= 44) ? adj_row(64 * (g & 3) + 32 * bj + 4 * c4) : 128 * bj + 32 * (g & 3) + 4 * c4);
        WI_LOAD(F.w_in, 5896, 64 * kb, in_srcbase(g) + 32 * bj); WI_DST(WS_WIN, 1024, drow, 64 * kb); return w; } r -= I_IN;
    if (r < I_KV) { WI_LOAD(F.w_mem_kv, 1024, 64 * (r / 32), 32 * (r % 32)); WI_DST(WS_WKV, 1024, 32 * (r % 32) + 4 * c4, 64 * (r / 32)); return w; } r -= I_KV;
    if (r < I_O1) { WI_LOAD(F.w_o_swa, 1024, 64 * (r / 32), 32 * (r % 32)); WI_DST(WS_WO, 1536, 256 * ((r % 32) >> 3) + adj_row(32 * ((r % 32) & 7) + 4 * c4), 64 * (r / 32)); return w; } r -= I_O1;
    if (r < I_O1) { WI_LOAD(F.w_o_fox, 1024, 64 * (r / 32), 32 * (r % 32)); WI_DST(WS_WO, 1536, 256 * ((r % 32) >> 3) + adj_row(32 * ((r % 32) & 7) + 4 * c4), 512 + 64 * (r / 32)); return w; } r -= I_O1;
    if (r < I_O1) { WI_LOAD(F.w_o_mem, 1024, 64 * (r / 32), 32 * (r % 32)); WI_DST(WS_WO, 1536, 256 * ((r % 32) >> 3) + adj_row(32 * ((r % 32) & 7) + 4 * c4), 1024 + 64 * (r / 32)); return w; } r -= I_O1;
    if (r < I_OUT) { WI_LOAD(F.w_out, 1024, 64 * (r / 32), 32 * (r % 32)); WI_DST(WS_WOUT, 1024, 32 * (r % 32) + 4 * c4, 64 * (r / 32)); return w; } r -= I_OUT;
    if (r < I_UP) { WI_LOAD(F.w_up, 4096, 64 * (r / 128), 32 * (r % 128)); WI_DST(WS_WUP, 1024, 32 * (r % 128) + 4 * c4, 64 * (r / 128)); w.ksc = 64 * (r / 128) + 8 * kg; return w; } r -= I_UP;
    WI_LOAD(F.w_dn, 1024, 64 * (r / 32), 32 * (r % 32)); WI_DST(WS_WD, 4096, 32 * (r % 32) + 4 * c4, 64 * (r / 32));
#undef WI_LOAD
#undef WI_DST
    return w;
}
__device__ __forceinline__ void witem_store(const Frame& F, const WItem& w, f32x4 (&r)[8]) {
    if (w.ksc >= 0) { const f32x4 s0 = *(const GAS f32x4*)(F.g_mlp + w.ksc), s1 = *(const GAS f32x4*)(F.g_mlp + w.ksc + 4);
#pragma unroll
        for (int i = 0; i < 4; ++i) { r[i] = r[i] * s0[i]; r[4 + i] = r[4 + i] * s1[i]; } }
    bf16* dst = (bf16*)F.ws + w.dst;
#pragma unroll
    for (int e = 0; e < 4; ++e) { v4u o; o.x = pkc(r[0][e], r[1][e]); o.y = pkc(r[2][e], r[3][e]); o.z = pkc(r[4][e], r[5][e]); o.w = pkc(r[6][e], r[7][e]); *(GAS v4u*)(dst + (size_t)e * w.ldt) = o; }
}
__device__ __forceinline__ void weight_items(Frame& F, int lo, int hi, int widx, int nw) {
    for (int it = lo + widx; it < hi; it += 2 * nw) {
        const int it2 = it + nw; const bool two = it2 < hi;
        f32x4 ra[8], rb[8];
        const WItem a = witem_fetch(F, it, ra), b = witem_fetch(F, two ? it2 : it, rb);
        witem_store(F, a, ra);
        if (two) witem_store(F, b, rb);
    }
}
__device__ __forceinline__ float lane_xor(float v, int d) { return __shfl_xor(v, d); }
template <int MODE = 0> __device__ __forceinline__ void p0_trip(const Frame& F, f32x4 (&v)[4][4], const f32x4 (&gn)[4], int m0, int mstep, int msafe, LAS const f32x4* wl, float bsel, bf16* H, float* LOGF, float* RINV) {
    if (MODE == 2) { f32x4 a_ = v[0][0];
#pragma unroll
        for (int q = 0; q < 4; ++q)
#pragma unroll
            for (int j = 0; j < 4; ++j) a_ += v[q][j];
        asm volatile("" :: "v"(a_)); return; }
    const int lane = F.lane; const bool h5 = (lane & 32) != 0, h4 = (lane & 16) != 0, h3 = (lane & 8) != 0, h2 = (lane & 4) != 0, h1 = (lane & 2) != 0;
    float r[4];
    {   float s[4];
#pragma unroll
        for (int q = 0; q < 4; ++q) { s[q] = 0.f;
#pragma unroll
            for (int j = 0; j < 4; ++j) s[q] += (v[q][j].x * v[q][j].x + v[q][j].y * v[q][j].y) + (v[q][j].z * v[q][j].z + v[q][j].w * v[q][j].w); }
        float k0 = (h5 ? s[2] : s[0]) + lane_xor(h5 ? s[0] : s[2], 32), k1 = (h5 ? s[3] : s[1]) + lane_xor(h5 ? s[1] : s[3], 32);
        float k = (h4 ? k1 : k0) + lane_xor(h4 ? k0 : k1, 16);
        k += lane_xor(k, 8); k += lane_xor(k, 4); k += lane_xor(k, 2); k += lane_xor(k, 1);
#pragma unroll
        for (int q = 0; q < 4; ++q) { const float tot = __int_as_float(__builtin_amdgcn_readlane(__float_as_int(k), 16 * q)); const float rt2 = sqrtf(tot * (1.f / 1024.f) + 1e-6f); r[q] = 1.f / rt2;
            const int mq = m0 + q * mstep; const bool ok = mq < MTOK;
            if (MODE == 0 && ok && lane == 0) RINV[mq] = rt2;
            GAS unsigned long long* o8 = (GAS unsigned long long*)(H + (size_t)(ok ? mq : msafe) * 1024) + lane;
#pragma unroll
            for (int j = 0; j < 4; ++j) { v[q][j] = v[q][j] * gn[j]; const f32x4 y = v[q][j] * r[q]; const unsigned long long pk_ = (unsigned long long)pkc(y.x, y.y) | ((unsigned long long)pkc(y.z, y.w) << 32); if (MODE == 0) { if (ok) o8[64 * j] = pk_; } else asm volatile("" :: "v"(pk_)); } }
    }
    float val[32];
#pragma unroll
    for (int i = 0; i < 32; ++i) val[i] = 0.f;
    LAS const f32x4* wl_ = wl + lane; asm volatile("" : "+v"(wl_));
#pragma unroll
    for (int j = 0; j < 4; ++j) {
#pragma unroll
        for (int e = 0; e < 4; ++e) { const f32x4 wa = wl_[(j * 4 + e) * 64], wb = wl_[1024 + (j * 4 + e) * 64];
#pragma unroll
            for (int q = 0; q < 4; ++q) { const float xv = v[q][j][e];
#pragma unroll
                for (int c = 0; c < 4; ++c) { val[8 * q + c] += wa[c] * xv; val[8 * q + 4 + c] += wb[c] * xv; } } }
        asm volatile("" ::: "memory");
    }
#define P0_RS(n_, h_, d_) do { _Pragma("unroll") for (int i = 0; i < (n_); ++i) val[i] = ((h_) ? val[i + (n_)] : val[i]) + lane_xor((h_) ? val[i] : val[i + (n_)], (d_)); } while (0)
    P0_RS(16, h5, 32); P0_RS(8, h4, 16); P0_RS(4, h3, 8); P0_RS(2, h2, 4); P0_RS(1, h1, 2);
#undef P0_RS
    float z = val[0] + lane_xor(val[0], 1);
    const float rsel = h5 ? (h4 ? r[3] : r[2]) : (h4 ? r[1] : r[0]);
    z = z * rsel + bsel;
    z = fminf(z, 0.f) - log1pf(expf(-fabsf(z)));
    const int mq = m0 + (lane >> 4) * mstep;
    if (MODE == 0) { if (mq < MTOK && (lane & 1) == 0) LOGF[(size_t)mq * 8 + ((lane >> 1) & 7)] = z; } else asm volatile("" :: "v"(z));
}
__device__ __forceinline__ void p0_prologue(Frame& F) {
    const float* x = F.x; const float* mem = F.mem; const float* w_in = F.w_in;
    const int gw = F.vcu * NWAVES + F.wave, NGW = F.G * NWAVES;
    bf16* H = (bf16*)(F.ws + WS_H); float* LOGF = (float*)(F.ws + WS_LOGF); float* RINV = (float*)(F.ws + WS_RINV); bf16* MEMN = (bf16*)(F.ws + WS_MEMN);
    LAS f32x4* wl = (LAS f32x4*)(F.lds + RING_OFF);
    f32x4 wreg[4];
#pragma unroll
    for (int q = 0; q < 4; ++q) { const int i = F.tid + NWAVES * 64 * q, h = i >> 10, je = (i >> 6) & 15, l = i & 63, k = 4 * l + 256 * (je >> 2) + (je & 3); wreg[q] = *(const GAS f32x4*)(w_in + (size_t)k * 5896 + 2304 + 4 * h); }
    f32x4 va[4][4], vb[4][4];
#if !defined(EXPER_NO_NTLOAD)
#define P0_XLOAD(p_) __builtin_nontemporal_load(p_)
#else
#define P0_XLOAD(p_) (*(p_))
#endif
#define P0_LOAD(v_, m0_) do { _Pragma("unroll") for (int q = 0; q < 4; ++q) { const int mq_ = (m0_) + q * NGW; const GAS f32x4* xp_ = (const GAS f32x4*)(x + (size_t)(mq_ < MTOK ? mq_ : gw) * 1024) + F.lane; \
        _Pragma("unroll") for (int j = 0; j < 4; ++j) v_[q][j] = P0_XLOAD(xp_ + 64 * j); } } while (0)
    f32x4 gn[4];
#pragma unroll
    for (int j = 0; j < 4; ++j) gn[j] = ((const GAS f32x4*)F.g_mix)[F.lane + 64 * j];
#pragma unroll
    for (int q = 0; q < 4; ++q) wl[F.tid + NWAVES * 64 * q] = wreg[q];
    {
        f32x4 gm[4];
#pragma unroll
        for (int j = 0; j < 4; ++j) gm[j] = ((const GAS f32x4*)F.g_mem)[F.lane + 64 * j];
        for (int m = gw; m < MMEM; m += NGW) { f32x4 v[4], vg[4];
#pragma unroll
            for (int j = 0; j < 4; ++j) v[j] = ((const GAS f32x4*)(mem + (size_t)m * 1024))[F.lane + 64 * j];
            (void)rms_row_to_bf16(v, gm, MEMN + (size_t)m * 1024, F.lane, vg, nullptr); }
    }
    weight_items(F, 0, (F.G == 256) ? I_EARLY : NITEMS, gw, NGW);
#if defined(TSPROBE)
    if (threadIdx.x == 0) atomicMax((unsigned long long*)(F.ws + 65536) + 8, rt());
#endif
    P0_LOAD(va, gw);
    __syncthreads();
    const float bsel = F.b_forget[(F.lane >> 1) & 7];
#if defined(EXPER_P0MODE)
    for (int m = gw; m < MTOK; m += 8 * NGW) {
        const int m2 = m + 4 * NGW;
        if (m2 < MTOK) P0_LOAD(vb, m2);
        p0_trip<EXPER_P0MODE>(F, va, gn, m, NGW, gw, wl, bsel, H, LOGF, RINV);
        if (m2 >= MTOK) break;
        const int m3 = m2 + 4 * NGW;
        if (m3 < MTOK) P0_LOAD(va, m3);
        p0_trip<EXPER_P0MODE>(F, vb, gn, m2, NGW, gw, wl, bsel, H, LOGF, RINV);
    }
    if (threadIdx.x == 0) atomicMax((unsigned long long*)(F.ws + 65536) + 9, rt());
    P0_LOAD(va, gw);
#endif
    for (int m = gw; m < MTOK; m += 8 * NGW) {
        const int m2 = m + 4 * NGW;
        if (m2 < MTOK) P0_LOAD(vb, m2);
        p0_trip(F, va, gn, m, NGW, gw, wl, bsel, H, LOGF, RINV);
        if (m2 >= MTOK) break;
        const int m3 = m2 + 4 * NGW;
        if (m3 < MTOK) P0_LOAD(va, m3);
        p0_trip(F, vb, gn, m2, NGW, gw, wl, bsel, H, LOGF, RINV);
    }
#undef P0_LOAD
#if defined(TSPROBE) && !defined(EXPER_P0MODE)
    if (threadIdx.x == 0) atomicMax((unsigned long long*)(F.ws + 65536) + 9, rt());
#endif
    __syncthreads();
}
__device__ __forceinline__ void p1_scan(Frame& F) {
    if (F.vcu >= 64) return;
    const int seq = F.vcu;
    const float* LOGF = (const float*)(F.ws + WS_LOGF); float* G2 = (float*)(F.ws + WS_G2);
    const int b = seq >> 3, h = seq & 7, s0 = 8 * F.tid;
    float a[8]; float run = 0.f;
#pragma unroll
    for (int i = 0; i < 8; ++i) { run += LOGF[((size_t)(b * SEQ + s0 + i)) * 8 + h]; a[i] = run; }
    float sc = run;
#pragma unroll
    for (int o = 1; o < 64; o <<= 1) { const float y = __shfl_up(sc, o); if (F.lane >= o) sc += y; }
    volatile LAS float* wt = (volatile LAS float*)(F.MISC + 16);
    if (F.lane == 63) wt[F.wave] = sc;
    __syncthreads();
    float woff = 0.f;
#pragma unroll
    for (int w = 0; w < NWAVES; ++w) woff += (w < F.wave) ? wt[w] : 0.f;
    const float off = woff + (sc - run);
    f32x4 o0, o1;
#pragma unroll
    for (int i = 0; i < 4; ++i) { o0[i] = -(a[i] + off) * 1.4426950408889634f; o1[i] = -(a[4 + i] + off) * 1.4426950408889634f; }
    GAS f32x4* gp = (GAS f32x4*)(G2 + (size_t)seq * SEQ + s0); gp[0] = o0; gp[1] = o1;
    __syncthreads();
}

struct Args { const float* in[NIN_ARGS]; float* out; unsigned char* ws; int ph_lo, ph_hi; };
__global__ void __launch_bounds__(NWAVES * 64, 2) mega_fwd(Args args) {
    extern __shared__ __attribute__((aligned(16))) unsigned char lds[];
    Frame F;
    F.lds = (LAS unsigned char*)lds;
    F.MISC = (volatile LAS unsigned*)(F.lds + MISC_OFF);
    F.tid = threadIdx.x; F.lane = F.tid & 63; F.wave = __builtin_amdgcn_readfirstlane(F.tid >> 6);
    F.G = gridDim.x; { const int bx = blockIdx.x; F.vcu = (F.G % 8 == 0) ? (bx % 8) * (F.G / 8) + bx / 8 : bx; }
    unsigned char* ws = args.ws; F.ws = ws; F.out = args.out;
    F.x = args.in[I_X]; F.mem = args.in[I_MEM]; F.w_in = args.in[I_WIN]; F.w_mem_kv = args.in[I_WMEMKV]; F.w_o_swa = args.in[I_WOSWA]; F.w_o_fox = args.in[I_WOFOX]; F.w_o_mem = args.in[I_WOMEM];
    F.w_out = args.in[I_WOUT]; F.w_up = args.in[I_WUP]; F.w_dn = args.in[I_WDN]; F.g_mix = args.in[I_GMIX]; F.g_mlp = args.in[I_GMLP]; F.g_mem = args.in[I_GMEM]; F.b_forget = args.in[I_BFORGET];
    F.ctl = (gu32*)(ws + WS_CTL);
    for (int u = F.tid; u < (LDS_BYTES - LDSCTL_OFF) / 4; u += NWAVES * 64) ((LAS unsigned*)(F.lds + LDSCTL_OFF))[u] = 0u;
    __syncthreads();
    const int lo = args.ph_lo, hi = args.ph_hi;
    const bool use_bar = (hi - lo) > 1;
    XcdBarrier bar; bar.bar = (unsigned*)(F.ctl + CW_BAR); bar.x = 0; bar.st = nullptr;
    if (use_bar) bar = xcd_barrier_post((unsigned*)(F.ctl + CW_BAR), F.MISC + 8);
#if defined(TSPROBE)
#define STAMP(k) do { if (blockIdx.x == 0 && threadIdx.x == 0) { ((unsigned long long*)(args.ws + 65536))[k] = rt(); ((unsigned long long*)(args.ws + 65536))[32 + (k)] = __builtin_amdgcn_s_memtime(); } } while (0)
#else
#define STAMP(k) do {} while (0)
#endif
    STAMP(0);
#define IN(k) (lo <= (k) && (k) < hi)
#define BOTH(k) (IN(k) && IN((k) + 1))
#define GRID_BAR() xcd_barrier(bar)

    bf16* Win_t = (bf16*)(ws + WS_WIN); bf16* Wkv_t = (bf16*)(ws + WS_WKV); bf16* Wo_t = (bf16*)(ws + WS_WO); bf16* Wout_t = (bf16*)(ws + WS_WOUT); bf16* Wup_t = (bf16*)(ws + WS_WUP); bf16* Wd_t = (bf16*)(ws + WS_WD);
    bf16* H = (bf16*)(ws + WS_H); bf16* GT = (bf16*)(ws + WS_GT); bf16* U = (bf16*)(ws + WS_U); bf16* X1B = (bf16*)(ws + WS_X1B); bf16* MEMN = (bf16*)(ws + WS_MEMN);
    bf16* QCAT = (bf16*)(ws + WS_QCAT); bf16* QA = QCAT; bf16* QF = QCAT + 512; bf16* QM = QCAT + 1024; bf16* MRG = (bf16*)(ws + WS_MRG);
    bf16* KA = (bf16*)(ws + WS_KA); bf16* VA = (bf16*)(ws + WS_VA); bf16* KF = (bf16*)(ws + WS_KF); bf16* VF = (bf16*)(ws + WS_VF);
    unsigned char* MIMG = ws + WS_MKV; float* SSQ = (float*)(ws + WS_SSQ); float* G2 = (float*)(ws + WS_G2);

    if (IN(0)) { p0_prologue(F); if (BOTH(0)) GRID_BAR(); STAMP(1); }

    if (IN(1)) {
        p1_scan(F);
        pg8::Sched S; S.init(MTOK, 5888, 1024, F.G, (int)blockIdx.x, H, Win_t); S.tsbase = (void*)(ws + 65536);
        { LAS float* tab = (LAS float*)(F.lds + ATT_EXTRA_OFF);
          for (int i = F.tid; i < 92 * 64; i += NWAVES * 64) { const int g = i >> 6, c = i & 63; float v = 0.f;
              if (g < 8) v = args.in[I_QNSWA][c] * pg8::kC2_64; else if (g < 10) v = args.in[I_KNSWA][c]; else if (g >= 12 && g < 20) v = args.in[I_QNFOX][c] * pg8::kC2_64; else if (g >= 20 && g < 28) v = args.in[I_KNFOX][c];
              else if (g == 28 || g == 29) v = args.in[I_KNMEM][i - 28 * 64] * args.in[I_QNMEM][i - 28 * 64] * (0.08838834764831845f * 1.4426950408889634f);
              else if (g >= 44) v = args.in[I_BGATE][i - 44 * 64];
              tab[i] = v; }
          __syncthreads(); }
        pg8::EpiInProj E{QA, KA, VA, QF, KF, VF, QM, (unsigned char*)GT, (LAS const float*)(F.lds + ATT_EXTRA_OFF)};
        pg8::gemm_phase<pg8::EpiInProj, pg8::Sched, true, true>(F.lds + RING_OFF, 1024, S, E);
        { pg8::Sched S2; S2.init(MMEM, 1024, 1024, F.G, (blockIdx.x >= 128) ? (int)blockIdx.x - 128 : (1 << 20), MEMN, Wkv_t); S2.tsbase = (void*)(ws + 65536);
          if (F.G <= 128) S2.c = (int)blockIdx.x;
          pg8::EpiMemKV E2{MIMG, (LAS const float*)(F.lds + ATT_EXTRA_OFF), (LAS float*)(F.lds + ATT_EXTRA_OFF + 92 * 64 * 4)};
          pg8::gemm_phase<pg8::EpiMemKV, pg8::Sched, true, true>(F.lds + RING_OFF, 1024, S2, E2); }
        if (F.G == 256 && blockIdx.x >= 160) weight_items(F, I_EARLY, NITEMS, ((int)blockIdx.x - 160) * NWAVES + F.wave, 96 * NWAVES);
        if (BOTH(1)) GRID_BAR();
        STAMP(2);
    }

    if (IN(2)) {
        using ab = attn_body::bf16;
        char* shm = (char*)lds + RING_OFF;
        float fox_margin;
        { const float gq = fabsf(args.in[I_QNFOX][F.lane]), gk = fabsf(args.in[I_KNFOX][F.lane]); float mq = gq, mk = gk;
#pragma unroll
          for (int o = 1; o < 64; o <<= 1) { mq = fmaxf(mq, __shfl_xor(mq, o)); mk = fmaxf(mk, __shfl_xor(mk, o)); }
          fox_margin = 2.0f * (8.0f * mq * mk * 1.4426950408889634f * 1.02f) + 40.0f; }
        for (;;) {
            if (F.tid == 0) F.MISC[24] = atomicAdd((unsigned*)(F.ctl + CW_FOXQ), 1u);
            __syncthreads();
            const int id = (int)F.MISC[24];
            __syncthreads();
            if (id >= 1024) break;
            const int bh = id & 63, qb = 15 - (id >> 6);
            const int b = bh >> 3, h = bh & 7; const size_t rb = (size_t)b * SEQ; const float* g2 = G2 + (size_t)bh * SEQ; const int NT = 4 * qb + 4;
            const float thr = g2[qb * 256] - fox_margin;
            const bool far = (F.lane < NT - 4) && (g2[64 * F.lane + 63] <= thr);
            const int t0 = __builtin_amdgcn_readfirstlane(__popcll(__ballot(far))) & ~1;
            attn_body::attn_unit<0, 512, 8>((const ab*)QF + (rb + qb * 256) * 1536 + h * 64, (const ab*)KF + (rb + 64 * t0) * 512 + h * 64, (const ab*)VF + (rb + 64 * t0) * 512 + h * 64, (ab*)QF + (rb + qb * 256) * 1536 + h * 64,
                                              NT - t0, qb * 256 - 64 * t0, 0, 0.f, g2 + 64 * t0, nullptr, shm); }
#if defined(TSPROBE)
        if (threadIdx.x == 0) { atomicMax((unsigned long long*)(ws + 65536) + 10, rt()); atomicMin((unsigned long long*)(ws + 65536) + 13, rt() ^ 0xffffffffffffffffull); }
#endif
        for (int id = F.vcu; id < 256; id += F.G)
            attn_body::swa_unit(id >> 5, (id >> 4) & 1, id & 15, (ab*)QA, (const ab*)KA, (const ab*)VA, args.in[I_SINK], args.in[I_RELBIAS], shm);
#if defined(TSPROBE)
        if (threadIdx.x == 0) atomicMax((unsigned long long*)(ws + 65536) + 11, rt());
#endif
        for (int i = 0, prev_bh = -1;; ++i) { const int id = (F.G == 256) ? F.vcu * 2 + i : i * F.G + F.vcu; if (id >= 512 || (F.G == 256 && i >= 2)) break;
            const bool prep = (id >> 4) != prev_bh; prev_bh = id >> 4;
            attn_body::mem_unit(id >> 6, (id >> 4) & 3, id & 15, prep, MIMG, (const ab*)QM, (ab*)QM, shm, (char*)lds + MEMWS_OFF, (char*)lds + ATT_EXTRA_OFF, (void*)(ws + 65536)); }
#if defined(TSPROBE)
        if (threadIdx.x == 0) atomicMax((unsigned long long*)(ws + 65536) + 12, rt());
#endif
        if (BOTH(2)) GRID_BAR();
        STAMP(3);
    }

    if (IN(3)) {
        pg8::Sched S; S.init(MTOK, 1024, 1536, F.G, (int)blockIdx.x, QCAT, Wo_t); S.tsbase = (void*)(ws + 65536);
        pg8::EpiMerge E{(const unsigned char*)GT, MRG, (void*)(ws + 65536)};
        pg8::gemm_phase<pg8::EpiMerge, pg8::Sched, true, true>(F.lds + RING_OFF, 1536, S, E);
        if (BOTH(3)) GRID_BAR();
        STAMP(4);
    }

    if (IN(4)) {
        pg8::Sched S; S.init(MTOK, 1024, 1024, F.G, (int)blockIdx.x, MRG, Wout_t); S.tsbase = (void*)(ws + 65536);
        { LAS float* tab = (LAS float*)(F.lds + ATT_EXTRA_OFF); for (int i = F.tid; i < 1024; i += NWAVES * 64) tab[i] = 1.0f / F.g_mix[i]; __syncthreads(); }
        pg8::EpiOutProj E{H, (const float*)(ws + WS_RINV), (LAS const float*)(F.lds + ATT_EXTRA_OFF), X1B, SSQ};
        pg8::gemm_phase<pg8::EpiOutProj, pg8::Sched, true, true>(F.lds + RING_OFF, 1024, S, E);
        if (BOTH(4)) GRID_BAR();
        STAMP(5);
    }

    if (IN(5)) {
        pg8::Sched S; S.init(MTOK, 4096, 1024, F.G, (int)blockIdx.x, X1B, Wup_t); S.tsbase = (void*)(ws + 65536);
#if defined(EXPER_NOSTORE)
        { pg8::EpiUpT<true> E0{SSQ, U, (PG8_LAS float*)(F.lds + ATT_EXTRA_OFF)}; pg8::gemm_phase<pg8::EpiUpT<true>, pg8::Sched, true, true>(F.lds + RING_OFF, 1024, S, E0); GRID_BAR(); STAMP(18); }
#endif
#if defined(EXPER_VARIANT)
        { pg8::EpiUp E0{SSQ, U, (PG8_LAS float*)(F.lds + ATT_EXTRA_OFF)}; pg8::gemm_phase<pg8::EpiUp, pg8::Sched, EXPER_ALIGN, EXPER_SP2>(F.lds + RING_OFF, 1024, S, E0); GRID_BAR(); STAMP(18); }
#endif
        pg8::EpiUp E{SSQ, U, (PG8_LAS float*)(F.lds + ATT_EXTRA_OFF)};
        pg8::gemm_phase<pg8::EpiUp, pg8::Sched, true, true>(F.lds + RING_OFF, 1024, S, E);
        if (BOTH(5)) GRID_BAR();
        STAMP(6);
    }

    if (IN(6)) {
        pg8::Sched S; S.init(MTOK, 1024, 4096, F.G, (int)blockIdx.x, U, Wd_t); S.tsbase = (void*)(ws + 65536);
        pg8::EpiDown E{X1B, F.out};
        pg8::gemm_phase<pg8::EpiDown, pg8::Sched, true, true>(F.lds + RING_OFF, 4096, S, E);
        STAMP(7);
    }
#if defined(TSPROBE)
    if (blockIdx.x == 0 && threadIdx.x == 0) { const unsigned long long* tsb = (const unsigned long long*)(args.ws + 65536);
#if defined(TS_CYCLES)
        const unsigned long long span = (tsb[32 + TS_B] - tsb[32 + TS_A]) / 25ull, t0 = rt();
#else
        const unsigned long long span = (tsb[TS_B] - tsb[TS_A]) * 8ull, t0 = rt();
#endif
        while (rt() - t0 < span) __builtin_amdgcn_s_sleep(32); }
#endif
#undef IN
#undef BOTH
#undef GRID_BAR
}

extern "C" void kernel_launch(void* const* d_in, const int* in_sizes, int n_in, void* d_out, int out_size, void* d_ws, size_t ws_size, hipStream_t stream) {
    static int grid = 0;
    if (grid == 0) {
        if (n_in != NIN_ARGS || in_sizes[0] != MTOK * 1024 || out_size != MTOK * 1024 || ws_size < WS_END) { fprintf(stderr, "kernel_launch: unexpected shapes (n_in %d, in0 %d, out %d, ws %zu < %zu); nothing launched\n", n_in, n_in > 0 ? in_sizes[0] : -1, out_size, ws_size, (size_t)WS_END); grid = -1; return; }
        int dev = 0, cus = 0, per_cu = 0;
        if (hipGetDevice(&dev) != hipSuccess || hipDeviceGetAttribute(&cus, hipDeviceAttributeMultiprocessorCount, dev) != hipSuccess) { fprintf(stderr, "kernel_launch: hipGetDevice / hipDeviceGetAttribute failed\n"); grid = -1; return; }
        if (hipFuncSetAttribute((const void*)mega_fwd, hipFuncAttributeMaxDynamicSharedMemorySize, LDS_BYTES) != hipSuccess) { fprintf(stderr, "kernel_launch: hipFuncSetAttribute failed\n"); grid = -1; return; }
        if (hipOccupancyMaxActiveBlocksPerMultiprocessor(&per_cu, (const void*)mega_fwd, NWAVES * 64, LDS_BYTES) != hipSuccess || per_cu < 1) { fprintf(stderr, "kernel_launch: occupancy query says %d workgroups per CU\n", per_cu); per_cu = 1; }
        (void)hipGetLastError();
        if (per_cu > 1) per_cu = 1;
        grid = cus * per_cu;
    }
    if (grid < 0) return;
    if (hipMemsetAsync((char*)d_ws + WS_CTL, 0, CTL_ZERO_BYTES, stream) != hipSuccess) { fprintf(stderr, "kernel_launch: hipMemsetAsync failed\n"); return; }
    Args a{};
    for (int i = 0; i < NIN_ARGS; ++i) a.in[i] = (const float*)d_in[i];
    a.out = (float*)d_out; a.ws = (unsigned char*)d_ws;
#if defined(DETPROBE) && DETPROBE
    {   unsigned char* w = (unsigned char*)d_ws; unsigned long long* chk = (unsigned long long*)(w + WS_CHK);
        (void)hipMemsetAsync(chk, 0, 2 * 64 * 8, stream);
        struct Slot { int phase; size_t off; size_t bytes; bool in_out; };
        const Slot slots[] = { {0, WS_WIN, 39 * MiB, false}, {0, WS_LOGF, 1 * MiB, false}, {0, WS_MEMN, 4 * MiB, false}, {0, WS_H, 64 * MiB, false},
            {1, WS_G2, 1 * MiB, false}, {1, WS_MKV, 4 * MiB, false}, {1, WS_GT, 192 * MiB, false}, {1, WS_QCAT, 96 * MiB, false}, {1, WS_KA, 8 * MiB, false}, {1, WS_VA, 8 * MiB, false}, {1, WS_KF, 32 * MiB, false}, {1, WS_VF, 32 * MiB, false},
            {2, WS_QCAT, 96 * MiB, false},
            {3, WS_MRG, 64 * MiB, false}, {4, WS_X1B, 64 * MiB, false}, {4, WS_SSQ, 2 * MiB, false}, {5, WS_U, 256 * MiB, false}, {6, 0, 128 * MiB, true} };
        const int nslots = (int)(sizeof(slots) / sizeof(slots[0]));
        for (int run = 0; run < 2; ++run)
            for (int p = 0; p < 7; ++p) { a.ph_lo = p; a.ph_hi = p + 1; if (p == 1) (void)hipMemsetAsync(w + WS_GT, 0, 192 * MiB, stream); if (p == 1) (void)hipMemsetAsync(w + WS_QCAT, 0, 176 * MiB, stream);
                hipLaunchKernelGGL(mega_fwd, dim3(grid), dim3(NWAVES * 64), LDS_BYTES, stream, a);
                for (int s = 0; s < nslots; ++s) if (slots[s].phase == p) { const unsigned* src = slots[s].in_out ? (const unsigned*)d_out : (const unsigned*)(w + slots[s].off);
                    hipLaunchKernelGGL(chk_sum, dim3(2048), dim3(256), 0, stream, src, slots[s].bytes / 4, chk + run * 64 + s); } }
        hipLaunchKernelGGL(chk_report, dim3(2048), dim3(256), 0, stream, (const unsigned long long*)chk, (float*)d_out, nslots, (size_t)out_size);
    }
#elif N_LAUNCHES == 1
#if defined(EXPER_P0TWICE)
    a.ph_lo = 0; a.ph_hi = 1; hipLaunchKernelGGL(mega_fwd, dim3(grid), dim3(NWAVES * 64), LDS_BYTES, stream, a);
    (void)hipMemsetAsync((char*)d_ws + WS_CTL, 0, CTL_ZERO_BYTES, stream);
#endif
    a.ph_lo = 0; a.ph_hi = 7;
    hipLaunchKernelGGL(mega_fwd, dim3(grid), dim3(NWAVES * 64), LDS_BYTES, stream, a);
#else
    for (int p = 0; p < 7; ++p) { a.ph_lo = p; a.ph_hi = p + 1; hipLaunchKernelGGL(mega_fwd, dim3(grid), dim3(NWAVES * 64), LDS_BYTES, stream, a); }
#endif
    const hipError_t le = hipPeekAtLastError();
    if (le != hipSuccess) fprintf(stderr, "kernel_launch: launch failed: %s\n", hipGetErrorName(le));
}
```

```cpp
#include <hip/hip_runtime.h>
#include <hip/hip_bf16.h>
#include <cstdio>
#include <cstdint>
#include <cmath>
#ifndef N_LAUNCHES
#define N_LAUNCHES 1
#endif
#if defined(TSPROBE) && !defined(TS_A)
#define TS_A TSPROBE
#define TS_B (TSPROBE + 1)
#endif
namespace pg8 {
#define PG8_LAS __attribute__((address_space(3)))
typedef unsigned short bf16_t;
typedef short bf16x8 __attribute__((ext_vector_type(8)));
typedef float f32x4 __attribute__((ext_vector_type(4)));
typedef int v4i_t __attribute__((ext_vector_type(4))); typedef int v8i_t __attribute__((ext_vector_type(8)));
typedef unsigned u32x4 __attribute__((ext_vector_type(4)));
constexpr int BM = 256, BK = 64, HALF = 128, HTB = HALF * BK * 2  , STAGE_BYTES = 8 * HTB, NXCD = 8, WGM = 8;

__host__ __device__ __forceinline__ int lds_byte(int r, int c) { const int st = (r >> 4) * 2 + (c >> 5), rr = r & 15, cc = c & 31, ob = rr * 64 + cc * 2; return st * 1024 + (ob ^ (((ob >> 9) & 1) << 5)); }
__host__ __device__ __forceinline__ void stage_rc(int b, int& R, int& C) { const int st = b / 1024, sb = b % 1024, swz = sb ^ (((sb >> 9) & 1) << 5); R = (st >> 1) * 16 + swz / 64; C = (st & 1) * 32 + (swz % 64) / 2; }
__host__ __device__ __forceinline__ int perm32(int rho) { const int n = rho >> 4, i = rho & 15; return 8 * (i >> 2) + 4 * n + (i & 3); }

#if defined(NO_EPI_RETIRE)
#define EPI_RETIRE do {} while (0)
#else
#define EPI_RETIRE asm volatile("s_waitcnt vmcnt(0)" ::: "memory")
#endif
#ifndef NT_GATES
#define NT_GATES 0
#endif
#ifndef NT_RESID
#define NT_RESID 0
#endif
#ifndef NT_OUT
#define NT_OUT 0
#endif
#define NTLD_IF(c_, p_) ((c_) ? __builtin_nontemporal_load(p_) : *(p_))
#define NTST_IF(c_, p_, v_) do { if (c_) __builtin_nontemporal_store((v_), (p_)); else *(p_) = (v_); } while (0)
#ifndef MRG_BLOCKED
#define MRG_BLOCKED 1
#endif
struct Unit { int pm, pn; };
typedef float f32x2_t __attribute__((ext_vector_type(2))); typedef __bf16 bf16x2_t __attribute__((ext_vector_type(2)));
__device__ __forceinline__ unsigned cvt_pk_bf16(float lo, float hi) { f32x2_t v = {lo, hi}; bf16x2_t b = __builtin_convertvector(v, bf16x2_t); return __builtin_bit_cast(unsigned, b); }
typedef unsigned u32x2 __attribute__((ext_vector_type(2)));

struct Sched {
    int nM, nN, nwg, G, c, nx, asel, a_pitch, xrounds, p1bal; size_t a_kstep;
    const char *A0, *Bt, *Ax, *Bx; size_t tstep, astride; void* tsbase;
    __device__ __forceinline__ void init(int M, int N, int K, int G_, int c_, const void* a0, const void* bt) {
        nM = M / BM; nN = N / BM; nwg = nM * nN; G = G_; c = c_; nx = 0; asel = 0; astride = 0; tsbase = nullptr; a_pitch = 0; a_kstep = 0; xrounds = 0; p1bal = 0; A0 = (const char*)a0; Bt = (const char*)bt; Ax = Bx = (const char*)a0; tstep = (size_t)BM * K * 2; }
    __device__ __forceinline__ bool next(int i, Unit& u) const {
        long L = (long)i * G + c;
        if (p1bal && i >= 10) {
            if (c >= 128 || i > 12) return false;
            L = (long)10 * G + (long)(i - 10) * 128 + c; }
        if (xrounds > 0 && i >= xrounds) {
            const int k = i - xrounds;
            if (c >= 160 && k < 2) L = (long)xrounds * G + (c - 160) * 2 + k; else if (c >= 96 && c < 160 && k == 0) L = (long)xrounds * G + 192 + (c - 96); else return false; }
        if (L >= nwg) { const long e = L - nwg; if (e >= nx) return false; u.pm = nM + (int)(e >> 2); u.pn = (int)(e & 3); return true; }
        int wgid = (int)L; { const int q = nwg / NXCD, r = nwg % NXCD, xcd = wgid % NXCD, off = wgid / NXCD; wgid = (xcd < r ? xcd * (q + 1) : r * (q + 1) + (xcd - r) * q) + off; }
        const int nig = WGM * nN, gid = wgid / nig, fm = gid * WGM, gsz = (nM - fm) < WGM ? (nM - fm) : WGM;
        u.pm = fm + ((wgid % nig) % gsz); u.pn = (wgid % nig) / gsz; return true;
    }
    __device__ __forceinline__ const char* a_ptr(const Unit& u) const {
        if (u.pm >= nM) return Ax + (size_t)(u.pm - nM) * tstep;
        return A0 + (size_t)(asel ? (u.pn >> 2) : 0) * astride + (size_t)u.pm * tstep; }
    __device__ __forceinline__ const char* b_ptr(const Unit& u) const { return ((u.pm >= nM) ? Bx : Bt) + (size_t)u.pn * tstep; }
    __device__ __forceinline__ void a_ready(const Unit&) const {}
    __device__ __forceinline__ void done(const Unit&) const {}
};

__device__ __forceinline__ float dot4(const f32x4 a) { return (a[0] * a[0] + a[1] * a[1]) + (a[2] * a[2] + a[3] * a[3]); }
__device__ __forceinline__ u32x4 pack8(const f32x4 a, const f32x4 b) { u32x4 w; w.x = cvt_pk_bf16(a[0], a[1]); w.y = cvt_pk_bf16(a[2], a[3]); w.z = cvt_pk_bf16(b[0], b[1]); w.w = cvt_pk_bf16(b[2], b[3]); return w; }

__device__ __forceinline__ int quad_src_idx(int lane) { return ((((lane & 3) << 4) | (lane >> 2)) << 2); }
__device__ __forceinline__ u32x4 quad_gather(const u32x4 w, int pidx) { u32x4 o; o.x = (unsigned)__builtin_amdgcn_ds_bpermute(pidx, (int)w.x); o.y = (unsigned)__builtin_amdgcn_ds_bpermute(pidx, (int)w.y);
    o.z = (unsigned)__builtin_amdgcn_ds_bpermute(pidx, (int)w.z); o.w = (unsigned)__builtin_amdgcn_ds_bpermute(pidx, (int)w.w); return o; }
struct LineGather {
    int rl, c, ia, ib; bool hi, odd;
    __device__ __forceinline__ LineGather(int lane) { rl = lane >> 3; c = lane & 7; odd = (c & 1) != 0; hi = (lane & 8) != 0; ia = (16 * (c >> 1) + (odd ? 8 : 0) + rl) << 2; ib = (16 * (c >> 1) + (odd ? 0 : 8) + rl) << 2; }
    __device__ __forceinline__ void gather(const u32x4 p0, const u32x4 p1, u32x4& r0, u32x4& r1) const {
#pragma unroll
        for (int d = 0; d < 4; ++d) { const unsigned xa = hi ? p1[d] : p0[d], xb = hi ? p0[d] : p1[d];
            const unsigned ta = (unsigned)__builtin_amdgcn_ds_bpermute(ia, (int)xa), tb = (unsigned)__builtin_amdgcn_ds_bpermute(ib, (int)xb);
            r0[d] = odd ? tb : ta; r1[d] = odd ? ta : tb; }
    }
};
constexpr float kLog2e = 1.4426950408889634f;
constexpr float kEps = 1e-6f;
constexpr float kC2_64 = 0.125f * 1.4426950408889634f;

__device__ __forceinline__ constexpr int p1_ltile(int p) { return p == 0 ? 2 : p <= 2 ? p + 6 : p <= 4 ? p - 3 : p <= 8 ? p - 2 : p; }
__device__ __forceinline__ constexpr int p1_ptile(int l) { return l <= 1 ? l + 3 : l == 2 ? 0 : l <= 6 ? l + 2 : l <= 8 ? l - 6 : l; }
#ifndef P1_QUAD
#define P1_QUAD 1
#endif
#define P1_QG(x_, i_) (P1_QUAD ? quad_gather((x_), (i_)) : (x_))
template <int pn0, int QMODE> struct EpiInProjT {
    static constexpr bool PERM = true, AFTER_DRAIN = false, HAS_MID = false, HAS_PRE = (QMODE == 2);
    __device__ __forceinline__ void pre(const Unit& u, int wr, int fr, float (&e)[4]) const {
#pragma unroll
        for (int i = 0; i < 4; ++i) e[i] = HS[u.pm * BM + wr * 64 + fr + i * 16]; }
    __device__ __forceinline__ void operator()(const f32x4 (&acc)[2][2][4][2], const Unit& u, int wr, int wc, int fr, int fq, const float (&epre)[4]) const { run(acc, u, wr, wc, fr, fq, epre); }
    __device__ __forceinline__ void operator()(const f32x4 (&acc)[2][2][4][2], const Unit& u, int wr, int wc, int fr, int fq) const { const float z[4] = {0.f, 0.f, 0.f, 0.f}; run(acc, u, wr, wc, fr, fq, z); }
    bf16_t *QA, *KA, *VA, *QF, *KF, *VF, *QM; unsigned char* GT8;
    const float* HS; const float* SWG;
    static __device__ __forceinline__ f32x4 av(const f32x4 a) { if constexpr (QMODE == 2) return __builtin_convertvector(__builtin_bit_cast(v4i_t, a), f32x4); else return a; }
    PG8_LAS const float* tab;
    __device__ __forceinline__ void run(const f32x4 (&acc)[2][2][4][2], const Unit& u, int wr, int wc, int fr, int fq, const float (&epre)[4]) const {
        const int g = p1_ltile(u.pn + pn0) * 4 + wc;
        bf16_t* dst; int pitch, dcol, mode;
        constexpr bool LOW = true;
        if (LOW && g < 8)       { dst = QA; pitch = 1536; dcol = 64 * g;        mode = 1; }
        else if (LOW && g < 10) { dst = KA; pitch = 128;  dcol = 64 * (g - 8);  mode = 1; }
        else if (LOW && g < 12) { dst = VA; pitch = 128;  dcol = 64 * (g - 10); mode = 0; }
        else if (LOW && g < 20) { dst = QF; pitch = 1536; dcol = 64 * (g - 12); mode = 1; }
        else if (LOW && g < 28) { dst = KF; pitch = 512;  dcol = 64 * (g - 20); mode = 1; }
        else if (g < 36) { dst = VF; pitch = 512;  dcol = 64 * (g - 28); mode = 0; }
        else if (g < 44) { dst = QM; pitch = 1536; dcol = 64 * (g - 36); mode = 0; }
        else             { dst = nullptr; pitch = 0; dcol = 64 * (g - 44); mode = 2; }
        const int lane_ = P1_QUAD ? fq * 16 + fr : 0, pidx = P1_QUAD ? quad_src_idx(lane_) : 0;
        const int row0 = u.pm * BM + wr * 64 + fr, rowS = P1_QUAD ? u.pm * BM + wr * 64 + (lane_ >> 2) : u.pm * BM + wr * 64 + fr;
        bf16_t* base = dst + dcol + 8 * (P1_QUAD ? (lane_ & 3) : fq);
        const float swb0 = (QMODE == 2) ? SWG[2 * g] : 1.0f, swb1 = (QMODE == 2) ? SWG[2 * g + 1] : 1.0f, swl = (fq >= 2) ? swb1 : swb0;
        float kr[2][4];
#pragma unroll
        for (int ai = 0; ai < 2; ++ai)
#pragma unroll
            for (int m = 0; m < 4; ++m) kr[ai][m] = (QMODE == 2) ? (ai == 0 ? epre[m] : HS[row0 + HALF + m * 16]) : (QMODE == 1) ? 1.0f / 64.0f : 1.0f;
        f32x4 cv[2][2];
#pragma unroll
        for (int bj = 0; bj < 2; ++bj)
#pragma unroll
            for (int n = 0; n < 2; ++n) cv[bj][n] = *(PG8_LAS const f32x4*)(tab + g * 64 + ((g >= 44) ? 16 * fq + 8 * bj : 32 * bj + 8 * fq) + 4 * n);
        if (mode == 1) {
#pragma unroll
            for (int ai = 0; ai < 2; ++ai)
#pragma unroll
                for (int m = 0; m < 4; ++m) { bf16_t* rowp = base + (size_t)(rowS + ai * HALF + m * 16) * pitch;
                    const f32x4 a00 = av(acc[ai][0][m][0]) * swb0, a01 = av(acc[ai][0][m][1]) * swb0, a10 = av(acc[ai][1][m][0]) * swb1, a11 = av(acc[ai][1][m][1]) * swb1; const float kIn = kr[ai][m];
                    float ss = (dot4(a00) + dot4(a01)) + (dot4(a10) + dot4(a11));
                    ss += __shfl_xor(ss, 16); ss += __shfl_xor(ss, 32);
                    const float r = kIn / sqrtf(ss * (kIn * kIn / 64.0f) + kEps);
                    if (ai == 0 && m == 0) EPI_RETIRE;
                    *(u32x4*)(rowp) = P1_QG(pack8(a00 * r * cv[0][0], a01 * r * cv[0][1]), pidx); *(u32x4*)(rowp + 32) = P1_QG(pack8(a10 * r * cv[1][0], a11 * r * cv[1][1]), pidx); }
        } else if (mode == 2) {
            unsigned char* gbase = (unsigned char*)GT8 + dcol + 16 * (P1_QUAD ? (lane_ & 3) : fq);
#pragma unroll
            for (int ai = 0; ai < 2; ++ai)
#pragma unroll
                for (int m = 0; m < 4; ++m) { u32x4 w;
#pragma unroll
                    for (int bj = 0; bj < 2; ++bj)
#pragma unroll
                        for (int n = 0; n < 2; ++n) { const f32x4 z = av(acc[ai][bj][m][n]) * (-kLog2e * kr[ai][m] * swl) + cv[bj][n]; unsigned q = 0;
#pragma unroll
                            for (int j = 0; j < 4; ++j) { const float g255 = __builtin_amdgcn_rcpf(__builtin_amdgcn_exp2f(z[j]) * (1.0f / 255.0f) + (1.0f / 255.0f));
                                q = __builtin_amdgcn_cvt_pk_u8_f32(fmaxf(g255, 1.0f), j, q); }
                            w[2 * bj + n] = q; }
                    if (ai == 0 && m == 0) EPI_RETIRE;
                    *(u32x4*)(gbase + (size_t)(rowS + ai * HALF + m * 16) * 3072) = P1_QG(w, pidx); asm volatile("" ::: "memory"); }
        } else {
            EPI_RETIRE;
#pragma unroll
            for (int ai = 0; ai < 2; ++ai)
#pragma unroll
                for (int m = 0; m < 4; ++m) { bf16_t* rowp = base + (size_t)(rowS + ai * HALF + m * 16) * pitch;
#pragma unroll
                    for (int bj = 0; bj < 2; ++bj) *(u32x4*)(rowp + 32 * bj) = P1_QG(pack8(av(acc[ai][bj][m][0]) * (kr[ai][m] * (bj ? swb1 : swb0)), av(acc[ai][bj][m][1]) * (kr[ai][m] * (bj ? swb1 : swb0))), pidx); }
        }
    }
};

struct EpiGate8 {
    static constexpr bool PERM = true, AFTER_DRAIN = false, HAS_MID = false, HAS_PRE = false;
    unsigned char* GT8; PG8_LAS const float* tab;
    __device__ __forceinline__ void operator()(const f32x4 (&acc)[2][2][4][2], const Unit& u, int wr, int wc, int fr_, int fq_) const {
        int fr = fr_, fq = fq_; asm volatile("" : "+v"(fr), "+v"(fq));
        const int g = 44 + u.pn * 4 + wc, dcol = 64 * (g - 44);
        const int lane_ = fq * 16 + fr, pidx = quad_src_idx(lane_), rowS = u.pm * BM + wr * 64 + (lane_ >> 2);
        f32x4 cv[2][2];
#pragma unroll
        for (int bj = 0; bj < 2; ++bj)
#pragma unroll
            for (int n = 0; n < 2; ++n) cv[bj][n] = *(PG8_LAS const f32x4*)(tab + g * 64 + 16 * fq + 8 * bj + 4 * n);
        unsigned char* gbase = (unsigned char*)GT8 + dcol + 16 * (lane_ & 3);
        constexpr float kS = -kLog2e * (1.0f / 64.0f);
#pragma unroll
        for (int ai = 0; ai < 2; ++ai)
#pragma unroll
            for (int m = 0; m < 4; ++m) { u32x4 w;
#pragma unroll
                for (int bj = 0; bj < 2; ++bj)
#pragma unroll
                    for (int n = 0; n < 2; ++n) { const f32x4 z = acc[ai][bj][m][n] * kS + cv[bj][n]; unsigned q = 0;
#pragma unroll
                        for (int j = 0; j < 4; ++j) { const float g255 = __builtin_amdgcn_rcpf(__builtin_amdgcn_exp2f(z[j]) * (1.0f / 255.0f) + (1.0f / 255.0f));
                            q = __builtin_amdgcn_cvt_pk_u8_f32(fmaxf(g255, 1.0f), j, q); }
                        w[2 * bj + n] = q; }
                if (ai == 0 && m == 0) EPI_RETIRE;
                *(u32x4*)(gbase + (size_t)(rowS + ai * HALF + m * 16) * 3072) = quad_gather(w, pidx); asm volatile("" ::: "memory"); }
    }
};

struct EpiMemKV {
    static constexpr bool PERM = true, AFTER_DRAIN = false, HAS_MID = false, HAS_PRE = false;
    unsigned char* MIMG; PG8_LAS const float* tab; PG8_LAS float* ex;
    __device__ __forceinline__ void operator()(const f32x4 (&acc)[2][2][4][2], const Unit& u, int wr, int wc, int fr, int fq) const {
            const int b = u.pm, hp = (u.pn & 1) * 2, key0 = wr * 64 + fr;
            unsigned char* im0 = MIMG + (size_t)(b * 4 + hp) * 131072;
            if (u.pn < 2) {
                PG8_LAS const f32x4* gp = (PG8_LAS const f32x4*)(tab + 28 * 64 + 32 * wc + 8 * fq);
#pragma unroll
                for (int bj = 0; bj < 2; ++bj) {
#pragma unroll
                    for (int ai = 0; ai < 2; ++ai)
#pragma unroll
                        for (int m = 0; m < 4; ++m) { float ss = dot4(acc[ai][bj][m][0]) + dot4(acc[ai][bj][m][1]); ss += __shfl_xor(ss, 16); ss += __shfl_xor(ss, 32);
                            if (fq == 0) ex[(ai * HALF + key0 + m * 16) * 4 + wc] = ss; }
                    asm volatile("s_waitcnt lgkmcnt(0)" ::: "memory"); __builtin_amdgcn_s_barrier(); asm volatile("" ::: "memory");
                    if (bj == 0) EPI_RETIRE;
                    unsigned char* im = im0 + (size_t)bj * 131072 + (4 * wc + fq) * 4096;
#pragma unroll
                    for (int ai = 0; ai < 2; ++ai)
#pragma unroll
                        for (int m = 0; m < 4; ++m) { const int key = ai * HALF + key0 + m * 16; const f32x4 e4 = *(PG8_LAS const f32x4*)(ex + key * 4);
                            const float r = 1.0f / sqrtf(((e4[0] + e4[1]) + (e4[2] + e4[3])) * (1.0f / 128.0f) + kEps);
                            *(u32x4*)(im + key * 16) = pack8(acc[ai][bj][m][0] * r * gp[0], acc[ai][bj][m][1] * r * gp[1]); }
                    asm volatile("s_waitcnt lgkmcnt(0)" ::: "memory"); __builtin_amdgcn_s_barrier(); asm volatile("" ::: "memory");
                }
            } else {
                EPI_RETIRE;
#pragma unroll
                for (int bj = 0; bj < 2; ++bj) { unsigned char* im = im0 + (size_t)bj * 131072 + 65536 + wc * 4096 + fq * 16;
#pragma unroll
                    for (int ai = 0; ai < 2; ++ai)
#pragma unroll
                        for (int m = 0; m < 4; ++m) { const int key = ai * HALF + key0 + m * 16; *(u32x4*)(im + (key >> 6) * 16384 + (key & 63) * 64) = pack8(acc[ai][bj][m][0], acc[ai][bj][m][1]); } }
            }
    }
};

__device__ __forceinline__ void unpack8(const u32x4 w, f32x4& a, f32x4& b) {
    a[0] = __uint_as_float(w.x << 16); a[1] = __uint_as_float(w.x & 0xffff0000u); a[2] = __uint_as_float(w.y << 16); a[3] = __uint_as_float(w.y & 0xffff0000u);
    b[0] = __uint_as_float(w.z << 16); b[1] = __uint_as_float(w.z & 0xffff0000u); b[2] = __uint_as_float(w.w << 16); b[3] = __uint_as_float(w.w & 0xffff0000u); }
__device__ __forceinline__ f32x4 ub4(unsigned w) { return (f32x4){(float)(w & 0xffu), (float)((w >> 8) & 0xffu), (float)((w >> 16) & 0xffu), (float)(w >> 24)}; }
template <bool MID = true> struct EpiMergeT {
    static constexpr bool PERM = true, AFTER_DRAIN = false, HAS_MID = MID, HAS_PRE = false;
    const unsigned char* GT8; bf16_t* MRG; void* tsbase;
    static __device__ __forceinline__ void scale16(f32x4& a00, f32x4& a01, f32x4& a10, f32x4& a11, const u32x4 nw, const u32x4 dw) {
        const f32x4 n0 = ub4(nw.x), n1 = ub4(nw.y), n2 = ub4(nw.z), n3 = ub4(nw.w), d0 = ub4(dw.x), d1 = ub4(dw.y), d2 = ub4(dw.z), d3 = ub4(dw.w);
#pragma unroll
        for (int j = 0; j < 4; ++j) { a00[j] *= n0[j] * __builtin_amdgcn_rcpf(d0[j]); a01[j] *= n1[j] * __builtin_amdgcn_rcpf(d1[j]); a10[j] *= n2[j] * __builtin_amdgcn_rcpf(d2[j]); a11[j] *= n3[j] * __builtin_amdgcn_rcpf(d3[j]); } }
    __device__ __forceinline__ void mid(f32x4 (&acc)[2][2][4][2], const Unit& u, int t, int wr, int wc, int fr, int fq) const {
        const unsigned char* base = GT8 + (size_t)(u.pm * BM + wr * 64 + fr) * 3072 + u.pn * BM + wc * 64 + 16 * fq + ((t == 8) ? 0 : 1024);
        u32x4 nA, dA, nB, dB, nC, dC;
#define MID_LOAD(N, D, g) do { const unsigned char* rp_ = base + (size_t)(((g) >> 2) * HALF + ((g) & 3) * 16) * 3072; N = NTLD_IF(NT_GATES, (const u32x4*)(rp_)); D = NTLD_IF(NT_GATES, (const u32x4*)(rp_ + 1024)); } while (0)
#define MID_APPLY(N, D, g) do { scale16(acc[(g) >> 2][0][(g) & 3][0], acc[(g) >> 2][0][(g) & 3][1], acc[(g) >> 2][1][(g) & 3][0], acc[(g) >> 2][1][(g) & 3][1], N, D); \
        asm volatile("" : "+v"(acc[(g) >> 2][0][(g) & 3][0]), "+v"(acc[(g) >> 2][0][(g) & 3][1]), "+v"(acc[(g) >> 2][1][(g) & 3][0]), "+v"(acc[(g) >> 2][1][(g) & 3][1]) :: "memory"); } while (0)
        MID_LOAD(nA, dA, 0); MID_LOAD(nB, dB, 1);
        MID_LOAD(nC, dC, 2); MID_APPLY(nA, dA, 0);
        MID_LOAD(nA, dA, 3); MID_APPLY(nB, dB, 1);
        MID_LOAD(nB, dB, 4); MID_APPLY(nC, dC, 2);
        MID_LOAD(nC, dC, 5); MID_APPLY(nA, dA, 3);
        MID_LOAD(nA, dA, 6); MID_APPLY(nB, dB, 4);
        MID_LOAD(nB, dB, 7); MID_APPLY(nC, dC, 5);
        MID_APPLY(nA, dA, 6);
        MID_APPLY(nB, dB, 7);
#undef MID_LOAD
#undef MID_APPLY
    }
    __device__ __forceinline__ void operator()(const f32x4 (&acc)[2][2][4][2], const Unit& u, int wr, int wc, int fr, int fq) const {
        const int row0 = u.pm * BM + wr * 64 + fr, col0 = u.pn * BM + wc * 64 + 16 * fq;
        const LineGather lg(fq * 16 + fr); const int rowS = u.pm * BM + wr * 64 + lg.rl, colS = u.pn * BM + wc * 64 + 8 * lg.c;
        u32x4 gw[2][4];
#pragma unroll
        for (int ai = 0; ai < 2; ++ai)
#pragma unroll
            for (int m = 0; m < 4; ++m) gw[ai][m] = NTLD_IF(NT_GATES, (const u32x4*)(GT8 + (size_t)(row0 + ai * HALF + m * 16) * 3072 + 2048 + col0));
        EPI_RETIRE;
#pragma unroll
        for (int ai = 0; ai < 2; ++ai)
#pragma unroll
            for (int m = 0; m < 4; ++m) { const float k = 1.0f / 255.0f;
#if MRG_BLOCKED
                bf16_t* op = MRG + (size_t)u.pm * (BM * 1024) + (size_t)(u.pn * 4 + wc) * (BM * 64) + (size_t)(wr * 64 + lg.rl + ai * HALF + m * 16) * 64 + 8 * lg.c; constexpr size_t kRow8 = 8 * 64;
#else
                bf16_t* op = MRG + (size_t)(rowS + ai * HALF + m * 16) * 1024 + colS; constexpr size_t kRow8 = (size_t)8 * 1024;
#endif
                u32x4 s0, s1; lg.gather(pack8(acc[ai][0][m][0] * (ub4(gw[ai][m].x) * k), acc[ai][0][m][1] * (ub4(gw[ai][m].y) * k)), pack8(acc[ai][1][m][0] * (ub4(gw[ai][m].z) * k), acc[ai][1][m][1] * (ub4(gw[ai][m].w) * k)), s0, s1);
                *(u32x4*)(op) = s0; *(u32x4*)(op + kRow8) = s1; }
    }
};
typedef EpiMergeT<true> EpiMerge;


struct EpiOutProj {
    static constexpr bool PERM = true, AFTER_DRAIN = false, HAS_MID = false, HAS_PRE = false;
    const bf16_t* Hn; const float* RINV; PG8_LAS const float* ginv; bf16_t* X1B; float* SSQ;
    __device__ __forceinline__ void operator()(const f32x4 (&acc)[2][2][4][2], const Unit& u, int wr, int wc, int fr, int fq) const {
        const int row0 = u.pm * BM + wr * 64 + fr, col0 = u.pn * BM + wc * 32 + 8 * fq;
        const int lane_ = fq * 16 + fr, pidx = quad_src_idx(lane_), rowS = u.pm * BM + wr * 64 + (lane_ >> 2), colS = u.pn * BM + wc * 32 + 8 * (lane_ & 3);
        f32x4 gi[2][2];
#pragma unroll
        for (int bj = 0; bj < 2; ++bj)
#pragma unroll
            for (int n = 0; n < 2; ++n) gi[bj][n] = *(PG8_LAS const f32x4*)(ginv + col0 + bj * HALF + 4 * n);
#pragma unroll
        for (int ai = 0; ai < 2; ++ai) {
            u32x4 hw[4][2]; float ri[4];
#pragma unroll
            for (int m = 0; m < 4; ++m) { const int row = row0 + ai * HALF + m * 16; ri[m] = RINV[row]; hw[m][0] = NTLD_IF(NT_RESID, (const u32x4*)(Hn + (size_t)row * 1024 + col0)); hw[m][1] = NTLD_IF(NT_RESID, (const u32x4*)(Hn + (size_t)row * 1024 + col0 + HALF)); }
            if (ai == 0) EPI_RETIRE;
#pragma unroll
            for (int m = 0; m < 4; ++m) { const int row = row0 + ai * HALF + m * 16; const size_t offS = (size_t)(rowS + ai * HALF + m * 16) * 1024 + colS; float ss = 0.f;
#pragma unroll
                for (int bj = 0; bj < 2; ++bj) { f32x4 h0, h1; unpack8(hw[m][bj], h0, h1);
                    const f32x4 v0 = h0 * ri[m] * gi[bj][0] + acc[ai][bj][m][0], v1 = h1 * ri[m] * gi[bj][1] + acc[ai][bj][m][1];
                    ss += dot4(v0) + dot4(v1); *(u32x4*)(X1B + offS + bj * HALF) = quad_gather(pack8(v0, v1), pidx); }
                ss += __shfl_xor(ss, 16); ss += __shfl_xor(ss, 32);
                if (fq == 0) SSQ[(size_t)row * 16 + u.pn * 4 + wc] = ss; }
            asm volatile("" ::: "memory"); }
    }
};

template <bool NOSTORE = false> struct EpiUpT {
    static constexpr bool PERM = true, AFTER_DRAIN = false, HAS_MID = false, HAS_PRE = false;
    const float* SSQ; bf16_t* U; PG8_LAS float* rl;
    __device__ __forceinline__ void operator()(const f32x4 (&acc)[2][2][4][2], const Unit& u, int wr, int wc, int fr, int fq) const {
        const LineGather lg(fq * 16 + fr);
        bf16_t* tbase = U + (size_t)u.pm * (BM * 4096) + (size_t)(u.pn * 4 + wc) * (BM * 64) + (size_t)(wr * 64 + lg.rl) * 64 + 8 * lg.c;
        { const int t = (wr * 4 + wc) * 64 + fq * 16 + fr;
          if (t < BM) { const f32x4* sp = (const f32x4*)(SSQ + (size_t)(u.pm * BM + t) * 16); const f32x4 s4 = (sp[0] + sp[1]) + (sp[2] + sp[3]);
              rl[t] = 1.0f / sqrtf(((s4[0] + s4[1]) + (s4[2] + s4[3])) * (1.0f / 1024.0f) + kEps); }
          asm volatile("s_waitcnt lgkmcnt(0)" ::: "memory"); __builtin_amdgcn_s_barrier(); asm volatile("" ::: "memory"); }
        EPI_RETIRE;
#pragma unroll
        for (int ai = 0; ai < 2; ++ai) {
#pragma unroll
            for (int m = 0; m < 4; ++m) { const float r = rl[ai * HALF + wr * 64 + m * 16 + fr];
                bf16_t* rowp = tbase + (size_t)(ai * HALF + m * 16) * 64;
                u32x4 pk[2];
#pragma unroll
                for (int bj = 0; bj < 2; ++bj) { f32x4 a = acc[ai][bj][m][0] * r, b = acc[ai][bj][m][1] * r;
#pragma unroll
                    for (int j = 0; j < 4; ++j) { a[j] = fmaxf(a[j], 0.f); a[j] *= a[j]; b[j] = fmaxf(b[j], 0.f); b[j] *= b[j]; }
                    pk[bj] = pack8(a, b); }
                u32x4 r0, r1; lg.gather(pk[0], pk[1], r0, r1);
                if (NOSTORE) { asm volatile("" :: "v"(r0)); asm volatile("" :: "v"(r1)); } else { *(u32x4*)(rowp) = r0; *(u32x4*)(rowp + 8 * 64) = r1; } } }
        asm volatile("s_waitcnt lgkmcnt(0)" ::: "memory"); __builtin_amdgcn_s_barrier(); asm volatile("" ::: "memory");
    }
};
typedef EpiUpT<false> EpiUp;

struct EpiDown {
    static constexpr bool PERM = true, AFTER_DRAIN = false, HAS_MID = false, HAS_PRE = false;
    const bf16_t* X1B; float* OUT;
    __device__ __forceinline__ void operator()(const f32x4 (&acc)[2][2][4][2], const Unit& u, int wr, int wc, int fr, int fq) const {
        const int row0 = u.pm * BM + wr * 64 + fr, col0 = u.pn * BM + wc * 32 + 8 * fq;
        const LineGather lg(fq * 16 + fr); const int rowS = u.pm * BM + wr * 64 + lg.rl, colS = u.pn * BM + wc * 32 + 4 * lg.c;
        u32x4 xw[2][4][2];
#pragma unroll
        for (int ai = 0; ai < 2; ++ai)
#pragma unroll
            for (int m = 0; m < 4; ++m) { const size_t off = (size_t)(row0 + ai * HALF + m * 16) * 1024 + col0; xw[ai][m][0] = NTLD_IF(NT_RESID, (const u32x4*)(X1B + off)); xw[ai][m][1] = NTLD_IF(NT_RESID, (const u32x4*)(X1B + off + HALF)); }
        EPI_RETIRE;
#pragma unroll
        for (int ai = 0; ai < 2; ++ai)
#pragma unroll
            for (int m = 0; m < 4; ++m) { const size_t off = (size_t)(row0 + ai * HALF + m * 16) * 1024 + col0;
#pragma unroll
                for (int bj = 0; bj < 2; ++bj) { f32x4 r0, r1; unpack8(xw[ai][m][bj], r0, r1);
                    const f32x4 y0 = r0 + acc[ai][bj][m][0], y1 = r1 + acc[ai][bj][m][1]; u32x4 s0, s1;
                    lg.gather(__builtin_bit_cast(u32x4, y0), __builtin_bit_cast(u32x4, y1), s0, s1);
                    float* op = OUT + (size_t)(rowS + ai * HALF + m * 16) * 1024 + colS + bj * HALF;
                    *(u32x4*)(op) = s0; *(u32x4*)(op + (size_t)8 * 1024) = s1; } }
    }
};

template <class Epi, class Sched, bool ALIGN_EPI = false, bool SP2 = false, int A_AUX = 0, int OPM = 0>
__device__ __forceinline__ void gemm_phase(PG8_LAS unsigned char* lds, const int K_, const Sched& S, const Epi& E) {
    constexpr bool FP8 = (OPM == 1);
    int tid_ = threadIdx.x; asm volatile("" : "+v"(tid_));
    const int tid = tid_, wid = __builtin_amdgcn_readfirstlane(tid >> 6), lane = tid & 63, wr = wid >> 2, wc = wid & 3, fr = lane & 15, fq = lane >> 4;
    const int K = K_, nt = K / BK;
    unsigned voffA[2], voffB[2];
#pragma unroll
    for (int i = 0; i < 2; ++i) { int R, C; stage_rc(tid * 16 + i * 8192, R, C); const int Rb = Epi::PERM ? ((R & ~31) + perm32(R & 31)) : R;
        voffA[i] = (unsigned)(R * (S.a_pitch ? S.a_pitch : K) + C) * 2u; voffB[i] = (unsigned)(Rb * K + C) * 2u; }
    const size_t kstep = (size_t)(BK * 2);
    const size_t hstep = (size_t)HALF * K * 2;
    const size_t kstepA = S.a_pitch ? S.a_kstep : kstep, hstepA = S.a_pitch ? (size_t)HALF * S.a_pitch * 2 : hstep;
    const size_t tstep = 2 * hstep;
    const unsigned ldsw = (unsigned)wid * 1024u;
    const int aoff = lds_byte(wr * 64 + fr, fq * 8), boff = lds_byte(wc * 32 + fr, fq * 8);
#define PG8_SA(b, h) (((b) * 2 + (h)) * HTB)
#define PG8_SB(b, h) ((4 + (b) * 2 + (h)) * HTB)
#define PG8_STAGE(bufoff, gbase, voff) do { _Pragma("unroll") for (int _i = 0; _i < 2; ++_i) \
        __builtin_amdgcn_global_load_lds((const unsigned*)((const char*)(gbase) + (voff)[_i]), (PG8_LAS unsigned*)(lds + (bufoff) + ldsw + _i * 8192), 16, 0, 0); } while (0)
#define PG8_STAGE_A(bufoff, gbase, voff) do { _Pragma("unroll") for (int _i = 0; _i < 2; ++_i) \
        __builtin_amdgcn_global_load_lds((const unsigned*)((const char*)(gbase) + (voff)[_i]), (PG8_LAS unsigned*)(lds + (bufoff) + ldsw + _i * 8192), 16, 0, A_AUX); } while (0)
#define PG8_CAT(x0, x1) __builtin_shufflevector((x0), (x1), 0, 1, 2, 3, 4, 5, 6, 7)
#define PG8_LDA(dst, b, h) do { if constexpr (FP8) { _Pragma("unroll") for (int m = 0; m < 4; ++m) dst##8[m] = PG8_CAT(*(const PG8_LAS v4i_t*)(lds + PG8_SA(b, h) + aoff + m * 2048), *(const PG8_LAS v4i_t*)(lds + PG8_SA(b, h) + aoff + m * 2048 + 1024)); } \
        else { _Pragma("unroll") for (int m = 0; m < 4; ++m) _Pragma("unroll") for (int k = 0; k < 2; ++k) dst[m][k] = *(const PG8_LAS bf16x8*)(lds + PG8_SA(b, h) + aoff + m * 2048 + k * 1024); } } while (0)
#define PG8_LDB(dst, b, h) do { if constexpr (FP8) { _Pragma("unroll") for (int n = 0; n < 2; ++n) dst##8[n] = PG8_CAT(*(const PG8_LAS v4i_t*)(lds + PG8_SB(b, h) + boff + n * 2048), *(const PG8_LAS v4i_t*)(lds + PG8_SB(b, h) + boff + n * 2048 + 1024)); } \
        else { _Pragma("unroll") for (int n = 0; n < 2; ++n) _Pragma("unroll") for (int k = 0; k < 2; ++k) dst[n][k] = *(const PG8_LAS bf16x8*)(lds + PG8_SB(b, h) + boff + n * 2048 + k * 1024); } } while (0)
#define PG8_MMA(ai, bj, At, Bt) do { __builtin_amdgcn_s_setprio(1); _Pragma("unroll") for (int m = 0; m < 4; ++m) _Pragma("unroll") for (int n = 0; n < 2; ++n) _Pragma("unroll") for (int k = 0; k < 2; ++k) \
        acc[ai][bj][m][n] = __builtin_amdgcn_mfma_f32_16x16x32_bf16(Bt[n][k], At[m][k], acc[ai][bj][m][n], 0, 0, 0); __builtin_amdgcn_s_setprio(0); } while (0)
#define PG8_MMA8(ai, bj, At, Bt) do { __builtin_amdgcn_s_setprio(1); _Pragma("unroll") for (int m = 0; m < 4; ++m) _Pragma("unroll") for (int n = 0; n < 2; ++n) \
        asm volatile("v_mfma_f32_16x16x128_f8f6f4 %0, %1, %2, %0" : "+v"(acc[ai][bj][m][n]) : "v"(Bt[n]), "v"(At[m])); __builtin_amdgcn_s_setprio(0); } while (0)
#define PG8_MMAI(ai, bj, At, Bt) do { __builtin_amdgcn_s_setprio(1); _Pragma("unroll") for (int m = 0; m < 4; ++m) _Pragma("unroll") for (int n = 0; n < 2; ++n) _Pragma("unroll") for (int k = 0; k < 2; ++k) \
        acc[ai][bj][m][n] = __builtin_bit_cast(f32x4, __builtin_amdgcn_mfma_i32_16x16x64_i8(__builtin_bit_cast(v4i_t, Bt[n][k]), __builtin_bit_cast(v4i_t, At[m][k]), __builtin_bit_cast(v4i_t, acc[ai][bj][m][n]), 0, 0, 0)); __builtin_amdgcn_s_setprio(0); } while (0)
#define PG8_MMAX(ai, bj, At, Bt) do { if constexpr (FP8) PG8_MMA8(ai, bj, At##8, Bt##8); else if constexpr (OPM == 2) PG8_MMAI(ai, bj, At, Bt); else PG8_MMA(ai, bj, At, Bt); } while (0)
#define PG8_WAIT_V(n) asm volatile("s_waitcnt vmcnt(" #n ")" ::: "memory")
#define PG8_WAIT_L(n) asm volatile("s_waitcnt lgkmcnt(" #n ")" ::: "memory")
#if defined(NO_TZ)
#define PG8_WAIT_V8_T(tz) PG8_WAIT_V(8)
#else
#define PG8_WAIT_V8_T(tz) asm volatile("s_cmp_eq_u32 %0, 0\n\ts_cbranch_scc1 .Lpg8w_%=\n\ts_waitcnt vmcnt(8)\n.Lpg8w_%=:" :: "s"(tz) : "memory", "scc")
#endif
#define PG8_BAR __builtin_amdgcn_s_barrier()
#define PG8_SCHED __builtin_amdgcn_sched_barrier(0)
    Unit cur, nxt; int ui = 0;
    if (!S.next(0, cur)) return;
    f32x4 acc[2][2][4][2];
#pragma unroll
    for (int a = 0; a < 2; ++a)
#pragma unroll
        for (int b = 0; b < 2; ++b)
#pragma unroll
            for (int m = 0; m < 4; ++m)
#pragma unroll
                for (int n = 0; n < 2; ++n) acc[a][b][m][n] = (f32x4){0.f, 0.f, 0.f, 0.f};
    bf16x8 At[4][2], B0[2][2], B1[2][2]; v8i_t At8[4], B08[2], B18[2];
    const char* cA = S.a_ptr(cur); const char* cB = S.b_ptr(cur);
    S.a_ready(cur);
    if constexpr (SP2) {
        PG8_STAGE(PG8_SB(0, 0), cB, voffB); PG8_STAGE(PG8_SB(0, 1), cB + hstep, voffB); PG8_STAGE_A(PG8_SA(0, 0), cA, voffA); PG8_STAGE_A(PG8_SA(0, 1), cA + hstepA, voffA);
        if (wr == 1) PG8_BAR;
        PG8_WAIT_V(2); PG8_BAR;
        PG8_STAGE(PG8_SB(1, 0), cB + kstep, voffB); PG8_STAGE_A(PG8_SA(1, 0), cA + kstepA, voffA); PG8_STAGE(PG8_SB(1, 1), cB + hstep + kstep, voffB); PG8_STAGE_A(PG8_SA(1, 1), cA + hstepA + kstepA, voffA);
        PG8_WAIT_V(0); PG8_BAR;
    } else {
        PG8_STAGE(PG8_SB(0, 0), cB, voffB); PG8_STAGE_A(PG8_SA(0, 0), cA, voffA); PG8_STAGE(PG8_SB(0, 1), cB + hstep, voffB); PG8_STAGE_A(PG8_SA(0, 1), cA + hstepA, voffA);
        if (wr == 1) PG8_BAR;
        PG8_WAIT_V(4); PG8_BAR;
        PG8_STAGE(PG8_SB(1, 0), cB + kstep, voffB); PG8_STAGE_A(PG8_SA(1, 0), cA + kstepA, voffA); PG8_STAGE(PG8_SB(1, 1), cB + hstep + kstep, voffB);
        PG8_WAIT_V(6); PG8_BAR;
    }
    for (;;) {
        float epre[4];
        if constexpr (Epi::HAS_PRE) E.pre(cur, wr, fr, epre);
        const bool has_next = S.next(ui + 1, nxt);
        const char* nA = has_next ? S.a_ptr(nxt) : cA; const char* nB = has_next ? S.b_ptr(nxt) : cB;
#if defined(TSPROBE)
        const unsigned long long kc0_ = __builtin_amdgcn_s_memtime();
#endif
#pragma unroll 1
        for (int t = 0; t < nt; t += 2) {
            if constexpr (Epi::HAS_MID) { if (t == 8 || t == 16) {
                if (wr == 0) PG8_BAR;
#if defined(TSPROBE)
                const unsigned long long h0_ = __builtin_amdgcn_s_memrealtime();
#endif
                E.mid(acc, cur, t, wr, wc, fr, fq);
#if defined(TSPROBE)
                if (blockIdx.x == 0 && threadIdx.x == 0) { unsigned long long* tsp_ = (unsigned long long*)E.tsbase; tsp_[15] = tsp_[15] + (__builtin_amdgcn_s_memrealtime() - h0_); }
#endif
                if (wr == 1) PG8_BAR;
            } }
            const bool last = (t == nt - 2);
            const char* a1 = cA + (size_t)(t + 1) * kstepA;
            const char* a2 = last ? nA : cA + (size_t)(t + 2) * kstepA; const char* b2 = last ? nB : cB + (size_t)(t + 2) * kstep;
            const char* a3 = a2 + kstepA; const char* b3 = b2 + kstep;
            if (last && has_next) S.a_ready(nxt);
            const int tz = __builtin_amdgcn_readfirstlane(t);
            if constexpr (SP2) {
            PG8_LDB(B0, 0, 0); PG8_LDB(B1, 0, 1); PG8_SCHED; PG8_LDA(At, 0, 0); PG8_STAGE_A(PG8_SA(1, 1), a1 + hstepA, voffA);
            PG8_WAIT_V8_T(tz); PG8_WAIT_L(0); PG8_BAR; PG8_MMAX(0, 0, At, B0); PG8_MMAX(0, 1, At, B1); PG8_BAR; PG8_SCHED;
            PG8_LDA(At, 0, 1); PG8_STAGE(PG8_SB(0, 0), b2, voffB); PG8_STAGE(PG8_SB(0, 1), b2 + hstep, voffB); PG8_STAGE_A(PG8_SA(0, 0), a2, voffA);
            PG8_WAIT_V8_T(tz); PG8_WAIT_L(0); PG8_BAR; PG8_MMAX(1, 0, At, B0); PG8_MMAX(1, 1, At, B1); PG8_BAR; PG8_SCHED;
            PG8_LDB(B0, 1, 0); PG8_LDB(B1, 1, 1); PG8_SCHED; PG8_LDA(At, 1, 0); PG8_STAGE_A(PG8_SA(0, 1), a2 + hstepA, voffA);
            PG8_WAIT_V8_T(tz); PG8_WAIT_L(0); PG8_BAR; PG8_MMAX(0, 0, At, B0); PG8_MMAX(0, 1, At, B1); PG8_BAR; PG8_SCHED;
            PG8_LDA(At, 1, 1); PG8_STAGE(PG8_SB(1, 0), b3, voffB); PG8_STAGE(PG8_SB(1, 1), b3 + hstep, voffB); PG8_STAGE_A(PG8_SA(1, 0), a3, voffA);
            PG8_WAIT_V(8); PG8_WAIT_L(0); PG8_BAR; PG8_MMAX(1, 0, At, B0); PG8_MMAX(1, 1, At, B1); PG8_BAR; PG8_SCHED;
            } else {
            PG8_LDB(B0, 0, 0); PG8_SCHED; PG8_LDA(At, 0, 0); PG8_STAGE_A(PG8_SA(1, 1), a1 + hstepA, voffA);
            PG8_WAIT_L(8); PG8_BAR; PG8_WAIT_L(0); PG8_MMAX(0, 0, At, B0); PG8_BAR; PG8_SCHED;
            PG8_LDB(B1, 0, 1); PG8_STAGE(PG8_SB(0, 0), b2, voffB);
            PG8_BAR; PG8_WAIT_L(0); PG8_MMAX(0, 1, At, B1); PG8_BAR;
            PG8_LDA(At, 0, 1); PG8_STAGE_A(PG8_SA(0, 0), a2, voffA);
            PG8_BAR; PG8_WAIT_L(0); PG8_MMAX(1, 0, At, B0); PG8_BAR; PG8_SCHED;
            PG8_STAGE(PG8_SB(0, 1), b2 + hstep, voffB);
            PG8_WAIT_V(6); PG8_BAR; PG8_MMAX(1, 1, At, B1); PG8_BAR;
            PG8_LDB(B0, 1, 0); PG8_SCHED; PG8_LDA(At, 1, 0); PG8_STAGE_A(PG8_SA(0, 1), a2 + hstepA, voffA);
            PG8_WAIT_L(8); PG8_BAR; PG8_WAIT_L(0); PG8_MMAX(0, 0, At, B0); PG8_BAR; PG8_SCHED;
            PG8_LDB(B1, 1, 1); PG8_STAGE(PG8_SB(1, 0), b3, voffB);
            PG8_BAR; PG8_WAIT_L(0); PG8_MMAX(0, 1, At, B1); PG8_BAR;
            PG8_LDA(At, 1, 1); PG8_STAGE_A(PG8_SA(1, 0), a3, voffA);
            PG8_BAR; PG8_WAIT_L(0); PG8_MMAX(1, 0, At, B0); PG8_BAR; PG8_SCHED;
            PG8_STAGE(PG8_SB(1, 1), b3 + hstep, voffB);
            PG8_WAIT_V(6); PG8_BAR; PG8_MMAX(1, 1, At, B1); PG8_BAR;
            }
        }
#if defined(TSPROBE)
        if (blockIdx.x == 0 && threadIdx.x == 0) { unsigned long long* tsp_ = (unsigned long long*)S.tsbase; tsp_[42] = tsp_[42] + (__builtin_amdgcn_s_memtime() - kc0_); tsp_[44] = tsp_[44] + (unsigned long long)nt; }
#endif
        if constexpr (FP8) { asm volatile("s_nop 15\n\ts_nop 15" ::: "memory"); }
#if !defined(NO_PRESTAGE)
        if constexpr (SP2) PG8_STAGE_A(PG8_SA(1, 1), nA + kstepA + hstepA, voffA);
#endif
        if constexpr (ALIGN_EPI) { if (wr == 0) PG8_BAR; }
#if defined(TSPROBE)
        const unsigned long long e0_ = __builtin_amdgcn_s_memrealtime();
#endif
        if constexpr (!Epi::AFTER_DRAIN) { if constexpr (Epi::HAS_PRE) E(acc, cur, wr, wc, fr, fq, epre); else E(acc, cur, wr, wc, fr, fq); S.done(cur); }
#if defined(TSPROBE)
        if (blockIdx.x == 0 && threadIdx.x == 0) { unsigned long long* tsp_ = (unsigned long long*)S.tsbase; tsp_[17] = tsp_[17] + (__builtin_amdgcn_s_memrealtime() - e0_); }
#endif
        if (!has_next) break;
#pragma unroll
        for (int a = 0; a < 2; ++a)
#pragma unroll
            for (int b = 0; b < 2; ++b)
#pragma unroll
                for (int m = 0; m < 4; ++m)
#pragma unroll
                    for (int n = 0; n < 2; ++n) acc[a][b][m][n] = (f32x4){0.f, 0.f, 0.f, 0.f};
        cur = nxt; cA = nA; cB = nB; ++ui;
        if constexpr (ALIGN_EPI) { if (wr == 1) PG8_BAR; }
    }
    PG8_WAIT_V(0);
    if constexpr (!ALIGN_EPI) { if (wr == 0) PG8_BAR; }
    PG8_BAR;
    if constexpr (Epi::AFTER_DRAIN) { E.fused(acc, cur, wr, wc, fr, fq, lds, wid, lane); S.done(cur); }
#undef PG8_SA
#undef PG8_SB
#undef PG8_STAGE
#undef PG8_STAGE_A
#undef PG8_LDA
#undef PG8_LDB
#undef PG8_MMA
#undef PG8_MMA8
#undef PG8_MMAI
#undef PG8_MMAX
#undef PG8_CAT
#undef PG8_WAIT_V
#undef PG8_WAIT_L
#undef PG8_BAR
#undef PG8_SCHED
}
}
namespace attn_body {
using bf16=__hip_bfloat16;
using bf16x8=__attribute__((ext_vector_type(8)))short;
using s16x4=__attribute__((ext_vector_type(4)))short;
using f32x16=__attribute__((ext_vector_type(16)))float;
using f32x4=__attribute__((ext_vector_type(4)))float;
using u32x4=__attribute__((ext_vector_type(4)))unsigned;
constexpr int SEQ=4096,D=64,PQ=1536;
constexpr int NW=8,QBLK=32,QB=QBLK*NW,KVBLK=64;
__device__ __forceinline__ int crow(int r,int hi){return (r&3)+8*(r>>2)+4*hi;}
#define SBAR() __builtin_amdgcn_sched_barrier(0)
__device__ __forceinline__ void cmask(f32x16&p0,f32x16&p1,int jb,int qrel,int hi){
  const float NEG=-INFINITY; int kb=64*jb+4*hi;
  #pragma unroll
  for(int r=0;r<16;++r){int kv=kb+(r&3)+8*(r>>2); if(kv>qrel)p0[r]=NEG; if(kv+32>qrel)p1[r]=NEG;}
}
constexpr int NSLOT=3, SLOTB=8192;
constexpr int LDS_K=0, LDS_V=NSLOT*SLOTB, LDS_WS=2*NSLOT*SLOTB, LDS_OST=LDS_WS+NW*64*4, LDS_GL=LDS_OST+NW*4096+2048  , LDS_TB=LDS_GL+16384  , LDS_BYTES=LDS_TB+2560;
constexpr float LOG2E=1.4426950408889634f;
__device__ __forceinline__ void glds16(const void*gsrc,unsigned lds_dst){unsigned keep;
  asm volatile("s_mov_b32 %0, m0\n\ts_mov_b32 m0, %2\n\ts_nop 0\n\tglobal_load_lds_dwordx4 %1, off\n\ts_mov_b32 m0, %0":"=&s"(keep):"v"(gsrc),"s"(lds_dst):"memory");}
typedef float f32x2_t __attribute__((ext_vector_type(2))); typedef __bf16 bf16x2_t __attribute__((ext_vector_type(2)));
__device__ __forceinline__ unsigned cvtpk_s(float lo,float hi){f32x2_t v={lo,hi};bf16x2_t b=__builtin_convertvector(v,bf16x2_t);return __builtin_bit_cast(unsigned,b);}
#define WAIT_BAR(N) asm volatile("s_waitcnt vmcnt(" #N ") lgkmcnt(0)\n\ts_barrier":::"memory")
typedef __attribute__((address_space(3))) const char* lds_cptr;
typedef __attribute__((address_space(3))) float* lds_fptr;
typedef __attribute__((address_space(3))) f32x4* lds_f4ptr;
typedef short v4i16_t __attribute__((ext_vector_type(4)));
#define MX3(a,b,c) __builtin_fmaxf(__builtin_fmaxf((a),(b)),(c))
__device__ __forceinline__ void qkt(f32x16&p0,f32x16&p1,const char*Kslot,const bf16x8*qr,int r32,int hi){
  const char*kb=Kslot+hi*1024+r32*16;
  #pragma unroll
  for(int d0=0;d0<4;++d0){
    const bf16x8 b0=*reinterpret_cast<const bf16x8*>(kb+d0*2048);
    const bf16x8 b1=*reinterpret_cast<const bf16x8*>(kb+d0*2048+512);
    p0=__builtin_amdgcn_mfma_f32_32x32x16_bf16(b0,qr[d0],p0,0,0,0);p1=__builtin_amdgcn_mfma_f32_32x32x16_bf16(b1,qr[d0],p1,0,0,0);}
}
__device__ __forceinline__ void kload8(bf16x8*kf,lds_cptr kp){
  kf[0]=*(const __attribute__((address_space(3))) bf16x8*)(kp);      kf[1]=*(const __attribute__((address_space(3))) bf16x8*)(kp+512);
  kf[2]=*(const __attribute__((address_space(3))) bf16x8*)(kp+2048); kf[3]=*(const __attribute__((address_space(3))) bf16x8*)(kp+2560);
  kf[4]=*(const __attribute__((address_space(3))) bf16x8*)(kp+4096); kf[5]=*(const __attribute__((address_space(3))) bf16x8*)(kp+4608);
  kf[6]=*(const __attribute__((address_space(3))) bf16x8*)(kp+6144); kf[7]=*(const __attribute__((address_space(3))) bf16x8*)(kp+6656);
}
__device__ __forceinline__ void kload2(bf16x8*kf,lds_cptr kp,int j){ kf[2*j]=*(const __attribute__((address_space(3))) bf16x8*)(kp+j*2048); kf[2*j+1]=*(const __attribute__((address_space(3))) bf16x8*)(kp+j*2048+512); }
__device__ __forceinline__ s16x4 vtr(lds_cptr p){ return __builtin_bit_cast(s16x4,__builtin_amdgcn_ds_read_tr16_b64_v4i16((__attribute__((address_space(3))) v4i16_t*)p)); }
__device__ __forceinline__ float rowmax(const f32x16&p0,const f32x16&p1){
  float a=MX3(p0[0],p0[1],p1[0]),b=MX3(p0[2],p0[3],p1[1]);a=MX3(a,p1[2],p1[3]);
  #pragma unroll
  for(int r=4;r<16;r+=4){a=MX3(a,p0[r],p0[r+1]);b=MX3(b,p0[r+2],p0[r+3]);a=MX3(a,p1[r],p1[r+1]);b=MX3(b,p1[r+2],p1[r+3]);}
  float m=__builtin_fmaxf(a,b);
  auto rr=__builtin_amdgcn_permlane32_swap(__float_as_uint(m),__float_as_uint(m),false,false);
  return __builtin_fmaxf(__uint_as_float(rr[0]),__uint_as_float(rr[1]));
}
__device__ __forceinline__ void pv(f32x16*o,int vb,bf16x8 pa0,bf16x8 pa1,bf16x8 pa2,bf16x8 pa3){
  #pragma unroll
  for(int d0=0;d0<2;++d0){s16x4 lo[4],hi[4];
    #pragma unroll
    for(int ks=0;ks<4;++ks){
      asm volatile("ds_read_b64_tr_b16 %0,%1 offset:%c2":"=&v"(lo[ks]):"v"(vb),"i"(d0*4096+ks*1024):"memory");
      asm volatile("ds_read_b64_tr_b16 %0,%1 offset:%c2":"=&v"(hi[ks]):"v"(vb),"i"(d0*4096+ks*1024+512):"memory");}
    asm volatile("s_waitcnt lgkmcnt(0)":::"memory");SBAR();
    #define PK(k) (bf16x8){lo[k][0],lo[k][1],lo[k][2],lo[k][3],hi[k][0],hi[k][1],hi[k][2],hi[k][3]}
    o[d0]=__builtin_amdgcn_mfma_f32_32x32x16_bf16(pa0,PK(0),o[d0],0,0,0);
    o[d0]=__builtin_amdgcn_mfma_f32_32x32x16_bf16(pa1,PK(1),o[d0],0,0,0);
    o[d0]=__builtin_amdgcn_mfma_f32_32x32x16_bf16(pa2,PK(2),o[d0],0,0,0);
    o[d0]=__builtin_amdgcn_mfma_f32_32x32x16_bf16(pa3,PK(3),o[d0],0,0,0);
    #undef PK
  }
}

#define ATTN_STORE16(p,v) (*(u32x4*)(p)=(v))
template<int MODE,int PKV,int THRL> __device__ __forceinline__ void attn_unit(const bf16*Qw0,const bf16*__restrict__ Kh,const bf16*__restrict__ Vh,bf16*Ow0,const int NT,const int q0,const int dq,const float l0,const float*__restrict__ gsrc,const float*__restrict__ rb,char*shm){
  int tid_=threadIdx.x; asm volatile("":"+v"(tid_));
  static_assert(MODE==0,"only the FoX form is instantiated: the phase-B C-init interleave reads the g copy (the window-table form is swa_unit)");
  const int tid=tid_,lane=tid&63,r32=lane&31,hi=lane>>5; const int wid=__builtin_amdgcn_readfirstlane(tid>>6);
  const bf16*Qw=Qw0+(long)(wid*QBLK)*PQ;
  const unsigned lds0=(unsigned)(uintptr_t)shm;
  float*wsf=(float*)(shm+LDS_WS)+wid*64;
  const lds_cptr shm3=(lds_cptr)shm;
  const lds_fptr gl=(lds_fptr)(shm3+LDS_GL); const lds_fptr tb=(lds_fptr)(shm3+LDS_TB);
  const bf16*ksrc=Kh+(long)lane*PKV+wid*8;
  const bf16*vsrc=Vh+(long)(16*(wid&3)+(lane>>2))*PKV+(wid>>2)*32+(lane&3)*8;
  const unsigned kdst=lds0+LDS_K+wid*1024, vdst=lds0+LDS_V+wid*1024;
  #define DMA_K(t,slot) glds16(ksrc+(long)(t)*KVBLK*PKV,(unsigned)__builtin_amdgcn_readfirstlane(kdst+(slot)))
  #define DMA_V(t,slot) glds16(vsrc+(long)(t)*KVBLK*PKV,(unsigned)__builtin_amdgcn_readfirstlane(vdst+(slot)))
  const int vb0=(int)(lds0+LDS_V)+((lane>>4)&1)*32+(lane&3)*8+(4*hi+((lane&15)>>2))*64;
  const char*Kbase=shm+LDS_K; bf16x8 kf[8];
  const lds_cptr kp0=shm3+LDS_K+hi*1024+r32*16; const lds_cptr vp0=shm3+LDS_V+((lane>>4)&1)*32+(lane&3)*8+(4*hi+((lane&15)>>2))*64;
  DMA_K(0,0);DMA_V(0,0);DMA_K(1,SLOTB);
  if(MODE==0){ const int n4=(q0+QB)>>2; for(int i=tid;i<n4;i+=NW*64) ((lds_f4ptr)gl)[i]=((const f32x4*)gsrc)[i]; }
  else{ for(int i=tid;i<640;i+=NW*64){ const int d=i-256; float v=-1e30f;
      if(d>=0&&d<128){ int bk=d; if(d>=16){ bk=16+(int)(__logf((float)d*(1.0f/16.0f))*(16.0f/2.0794415416798357f)); bk=bk>31?31:bk; } v=rb[bk*8]*LOG2E; }
      tb[i]=v; } }
  bf16x8 qr[4];
  #pragma unroll
  for(int d0=0;d0<4;++d0)qr[d0]=*reinterpret_cast<const bf16x8*>(&Qw[(long)r32*PQ+d0*16+hi*8]);
  const int qrel=wid*QBLK+r32;
  float mhat=(MODE==0)?gsrc[q0+qrel]:0.f; float l_reg=(MODE==0)?0.f:((hi==0)?l0:0.f);
  f32x16 o[2];o[0]=f32x16{};o[1]=f32x16{};
  #define CMASK(P0,P1,t) do{ if(MODE==0){int jb_=(t)-(NT-4); if(jb_>=0)cmask(P0,P1,jb_,qrel,hi);} }while(0)
  #define CINIT(X0,X1,tt) do{ if(MODE==0){ const lds_f4ptr gp_=(lds_f4ptr)(gl+64*(tt)+4*hi); \
        _Pragma("unroll") for(int g4=0;g4<4;++g4){ const f32x4 a_=gp_[2*g4], b_=gp_[8+2*g4]; \
          X0[4*g4]=a_[0]-mhat;X0[4*g4+1]=a_[1]-mhat;X0[4*g4+2]=a_[2]-mhat;X0[4*g4+3]=a_[3]-mhat; X1[4*g4]=b_[0]-mhat;X1[4*g4+1]=b_[1]-mhat;X1[4*g4+2]=b_[2]-mhat;X1[4*g4+3]=b_[3]-mhat; } } \
      else{ const lds_fptr tp_=tb+(dq+qrel-4*hi+256-64*(tt)); \
        _Pragma("unroll") for(int r=0;r<16;++r){ X0[r]=tp_[-((r&3)+8*(r>>2))]-mhat; X1[r]=tp_[-32-((r&3)+8*(r>>2))]-mhat; } } }while(0)
  bool resc=false;
  #define RESC() do{ if(resc){ asm volatile("s_waitcnt lgkmcnt(0)":::"memory"); \
      _Pragma("unroll") for(int d_=0;d_<2;++d_) _Pragma("unroll") for(int r=0;r<16;++r)o[d_][r]*=wsf[crow(r,hi)]; } }while(0)
  f32x16 pA0,pA1,pB0,pB1;
  int sl_prev=0,sl_cur=0,sl_next=SLOTB;
  #define ROT() do{sl_prev=sl_cur;sl_cur=sl_next;sl_next=(sl_next==(NSLOT-1)*SLOTB)?0:sl_next+SLOTB;}while(0)
  DMA_K(2,2*SLOTB);
  WAIT_BAR(3);
  CINIT(pA0,pA1,0);
  qkt(pA0,pA1,Kbase,qr,r32,hi);CMASK(pA0,pA1,0);
  { const float rm=rowmax(pA0,pA1);
    if(__any(rm>(float)THRL)){ const float dl=__builtin_fmaxf(rm,0.f); mhat+=dl;
      _Pragma("unroll") for(int r=0;r<16;++r){pA0[r]-=dl;pA1[r]-=dl;}
      l_reg*=__builtin_amdgcn_exp2f(-dl); }
    _Pragma("unroll") for(int r=0;r<16;++r){pA0[r]=__builtin_amdgcn_exp2f(pA0[r]);pA1[r]=__builtin_amdgcn_exp2f(pA1[r]);} }
  WAIT_BAR(0);
  DMA_K(3,0);DMA_V(1,SLOTB);
  ROT();
  kload8(kf,kp0+sl_cur);
  CINIT(pB0,pB1,1);
  WAIT_BAR(2);
  s16x4 vlo[8],vhi[8]; u32x4 pw0,pw1,pw2,pw3;
  #define PKW(P,B) cvtpk_s(P[B],P[B+1])
  #define PAF(k) __builtin_bit_cast(bf16x8,pw##k)
  #define VFR(i) (bf16x8){vlo[i][0],vlo[i][1],vlo[i][2],vlo[i][3],vhi[i][0],vhi[i][1],vhi[i][2],vhi[i][3]}
  #define PIN(x) asm volatile("":"+v"(x))
  #define GAPA(MF,A0,A1,A2,A3,W0,W1,PW) do{ MF; sacc+=A0; sacc+=A1; sacc+=A2; sacc+=A3; PIN(sacc); W0; W1; PIN(PW); SBAR(); }while(0)
  #define EX(v) __builtin_amdgcn_exp2f(v)
  #define GAPB(MF,X,B) do{ MF; X[B]=EX(X[B]); X[B+1]=EX(X[B+1]); X[B+2]=EX(X[B+2]); X[B+3]=EX(X[B+3]); PIN(X); SBAR(); }while(0)
  #define GAPB2(MF,X,B,G,LD,Y,YB,CI) do{ if(G){ LD; } MF; X[B]=EX(X[B]); X[B+1]=EX(X[B+1]); X[B+2]=EX(X[B+2]); X[B+3]=EX(X[B+3]); PIN(X); if(G){ Y[YB]=CI[0]-mhat; Y[YB+1]=CI[1]-mhat; Y[YB+2]=CI[2]-mhat; Y[YB+3]=CI[3]-mhat; PIN(Y); } SBAR(); }while(0)
  #define VRD(i) do{ vlo[i]=vtr(vp_+(((i)>>2)*4096+((i)&3)*1024)); vhi[i]=vtr(vp_+(((i)>>2)*4096+((i)&3)*1024+512)); }while(0)
  #define KRD(G,j) do{ if(G){ kload2(kf,kp0+sl_next,j); SBAR(); } }while(0)
  #define STEP(C0,C1,P0,P1,t,GK,GV,GL) do{ SBAR(); \
    const lds_cptr vp_=vp0+sl_prev; \
    VRD(0); SBAR(); float sacc=(P0[0]+P0[1]); \
    GAPA(C0=__builtin_amdgcn_mfma_f32_32x32x16_bf16(kf[0],qr[0],C0,0,0,0), P0[2],P0[3],P0[4],P0[5],     pw0[0]=PKW(P0,0), pw0[1]=PKW(P0,2), pw0); \
    VRD(4); SBAR(); GAPA(C1=__builtin_amdgcn_mfma_f32_32x32x16_bf16(kf[1],qr[0],C1,0,0,0), P0[6],P0[7],P0[8],P0[9],     pw0[2]=PKW(P0,4), pw0[3]=PKW(P0,6), pw0); \
    VRD(1); SBAR(); GAPA(C0=__builtin_amdgcn_mfma_f32_32x32x16_bf16(kf[2],qr[1],C0,0,0,0),   P0[10],P0[11],P0[12],P0[13], pw1[0]=PKW(P0,8), pw1[1]=PKW(P0,10), pw1); \
    VRD(5); SBAR(); GAPA(C1=__builtin_amdgcn_mfma_f32_32x32x16_bf16(kf[3],qr[1],C1,0,0,0),   P0[14],P0[15],P1[0],P1[1],   pw1[2]=PKW(P0,12),pw1[3]=PKW(P0,14), pw1); \
    VRD(2); SBAR(); GAPA(C0=__builtin_amdgcn_mfma_f32_32x32x16_bf16(kf[4],qr[2],C0,0,0,0),   P1[2],P1[3],P1[4],P1[5],     pw2[0]=PKW(P1,0), pw2[1]=PKW(P1,2), pw2); \
    VRD(6); SBAR(); GAPA(C1=__builtin_amdgcn_mfma_f32_32x32x16_bf16(kf[5],qr[2],C1,0,0,0),   P1[6],P1[7],P1[8],P1[9],     pw2[2]=PKW(P1,4), pw2[3]=PKW(P1,6), pw2); \
    VRD(3); SBAR(); GAPA(C0=__builtin_amdgcn_mfma_f32_32x32x16_bf16(kf[6],qr[3],C0,0,0,0),   P1[10],P1[11],P1[12],P1[13], pw3[0]=PKW(P1,8), pw3[1]=PKW(P1,10), pw3); \
    VRD(7); SBAR(); GAPA(C1=__builtin_amdgcn_mfma_f32_32x32x16_bf16(kf[7],qr[3],C1,0,0,0),   P1[14],P1[15],0.f,0.f,       pw3[2]=PKW(P1,12),pw3[3]=PKW(P1,14), pw3); \
    l_reg+=sacc; \
    if(GK){DMA_K((t)+3,sl_cur);} if(GV){DMA_V((t)+1,sl_next);} \
    CMASK(C0,C1,t); \
    { float a=MX3(C0[0],C0[1],C1[0]),b=MX3(C0[2],C0[3],C1[1]); a=MX3(a,C1[2],C1[3]); \
      _Pragma("unroll") for(int r=4;r<16;r+=4){a=MX3(a,C0[r],C0[r+1]);b=MX3(b,C0[r+2],C0[r+3]);a=MX3(a,C1[r],C1[r+1]);b=MX3(b,C1[r+2],C1[r+3]);} \
      float rm=__builtin_fmaxf(a,b); { auto rr=__builtin_amdgcn_permlane32_swap(__float_as_uint(rm),__float_as_uint(rm),false,false); rm=__builtin_fmaxf(__uint_as_float(rr[0]),__uint_as_float(rr[1])); } \
      resc=false; \
      if(__builtin_expect(__any(rm>(float)THRL),0)){ const float dl=__builtin_fmaxf(rm,0.f); mhat+=dl; \
        _Pragma("unroll") for(int r=0;r<16;++r){C0[r]-=dl;C1[r]-=dl;} \
        const float f=__builtin_amdgcn_exp2f(-dl); l_reg*=f; if(hi==0)wsf[r32]=f; resc=true; } } \
    SBAR(); \
      \
    const lds_f4ptr cig_=(lds_f4ptr)(gl+64*((t)+1)+4*hi); f32x4 cia_,cib_; \
    if(GV){ cia_=cig_[0]; } \
    GAPB2(o[0]=__builtin_amdgcn_mfma_f32_32x32x16_bf16(PAF(0),VFR(0),o[0],0,0,0), C0,0,  GV, cib_=cig_[8],  P0,0, cia_); \
    GAPB2(o[1]=__builtin_amdgcn_mfma_f32_32x32x16_bf16(PAF(0),VFR(4),o[1],0,0,0), C0,4,  GV, cia_=cig_[2],  P1,0, cib_); \
    KRD(GL,0); GAPB2(o[0]=__builtin_amdgcn_mfma_f32_32x32x16_bf16(PAF(1),VFR(1),o[0],0,0,0), C0,8,  GV, cib_=cig_[10], P0,4, cia_); \
    KRD(GL,1); GAPB2(o[1]=__builtin_amdgcn_mfma_f32_32x32x16_bf16(PAF(1),VFR(5),o[1],0,0,0), C0,12, GV, cia_=cig_[4],  P1,4, cib_); \
    KRD(GL,2); GAPB2(o[0]=__builtin_amdgcn_mfma_f32_32x32x16_bf16(PAF(2),VFR(2),o[0],0,0,0), C1,0,  GV, cib_=cig_[12], P0,8, cia_); \
    KRD(GL,3); GAPB2(o[1]=__builtin_amdgcn_mfma_f32_32x32x16_bf16(PAF(2),VFR(6),o[1],0,0,0), C1,4,  GV, cia_=cig_[6],  P1,8, cib_); \
    GAPB2(o[0]=__builtin_amdgcn_mfma_f32_32x32x16_bf16(PAF(3),VFR(3),o[0],0,0,0), C1,8,  GV, cib_=cig_[14], P0,12, cia_); \
    GAPB2(o[1]=__builtin_amdgcn_mfma_f32_32x32x16_bf16(PAF(3),VFR(7),o[1],0,0,0), C1,12, GV, (void)0,         P1,12, cib_); \
    }while(0)
  int t=1;
  #undef CMASK
  #define CMASK(P0,P1,t) do{}while(0)
  for(;t+5<NT;t+=2){
    STEP(pB0,pB1,pA0,pA1,t,true,true,true);     WAIT_BAR(2); RESC(); ROT();
    STEP(pA0,pA1,pB0,pB1,t+1,true,true,true);   WAIT_BAR(2); RESC(); ROT();
  }
  #undef CMASK
  #define CMASK(P0,P1,t) do{ if(MODE==0){int jb_=(t)-(NT-4); if(jb_>=0)cmask(P0,P1,jb_,qrel,hi);} }while(0)
  #define ENDW(tt) do{ if((tt)+3<NT){WAIT_BAR(2);} else if((tt)+2<NT){WAIT_BAR(1);} else {WAIT_BAR(0);} }while(0)
  for(;t+1<NT;t+=2){
    STEP(pB0,pB1,pA0,pA1,t,(t+3<NT),(t+1<NT),(t+1<NT));       ENDW(t);   RESC(); ROT();
    STEP(pA0,pA1,pB0,pB1,t+1,(t+4<NT),(t+2<NT),(t+2<NT));     ENDW(t+1); RESC(); ROT();
  }
  STEP(pB0,pB1,pA0,pA1,NT-1,false,false,false); RESC();
  { float sacc=pB0[0]+pB0[1]; _Pragma("unroll") for(int r=2;r<16;++r)sacc+=pB0[r]; _Pragma("unroll") for(int r=0;r<16;++r)sacc+=pB1[r]; l_reg+=sacc;
    pw0=(u32x4){PKW(pB0,0),PKW(pB0,2),PKW(pB0,4),PKW(pB0,6)};pw1=(u32x4){PKW(pB0,8),PKW(pB0,10),PKW(pB0,12),PKW(pB0,14)};pw2=(u32x4){PKW(pB1,0),PKW(pB1,2),PKW(pB1,4),PKW(pB1,6)};pw3=(u32x4){PKW(pB1,8),PKW(pB1,10),PKW(pB1,12),PKW(pB1,14)};
    SBAR(); pv(o,vb0+sl_cur,PAF(0),PAF(1),PAF(2),PAF(3)); }
  #undef PKW
  #undef PAF
  #undef VFR
  #undef PIN
  #undef GAPA
  #undef GAPB
  #undef GAPB2
  #undef EX
  #undef VRD
  #undef KRD
  #undef STEP
  #undef ENDW
  {auto rr=__builtin_amdgcn_permlane32_swap(__float_as_uint(l_reg),__float_as_uint(l_reg),false,false);l_reg=__uint_as_float(rr[0])+__uint_as_float(rr[1]);}
  if(hi==0)wsf[32+r32]=l_reg;asm volatile("s_waitcnt lgkmcnt(0)":::"memory");
  float rli[16];
  #pragma unroll
  for(int r=0;r<16;++r)rli[r]=__builtin_amdgcn_rcpf(wsf[32+crow(r,hi)]);
  bf16*Ow=Ow0+(long)(wid*QBLK)*PQ;
  { bf16*stg=(bf16*)(shm+LDS_OST)+wid*2048;
    #pragma unroll
    for(int r=0;r<16;++r){const int orow=crow(r,hi);
      #pragma unroll
      for(int d0=0;d0<2;++d0)stg[orow*64+d0*32+r32]=__float2bfloat16(o[d0][r]*rli[r]);}
    asm volatile("s_waitcnt lgkmcnt(0)":::"memory");
    #pragma unroll
    for(int i=0;i<4;++i){const int row=i*8+(lane>>3),ch=lane&7; const u32x4 v=*(const u32x4*)(stg+row*64+ch*8); ATTN_STORE16(Ow+(long)row*PQ+ch*8,v);} }
  asm volatile("s_waitcnt lgkmcnt(0)\n\ts_barrier":::"memory");
  #undef DMA_K
  #undef DMA_V
  #undef CMASK
  #undef CINIT
  #undef RESC
  #undef ROT
}

constexpr int SWA_K=0, SWA_V=49152, SWA_TB=98304, SWA_LDS_BYTES=SWA_TB+4*640*4;
__device__ __forceinline__ void swa_unit(int b,int kvh,int qb,bf16*QA,const bf16*__restrict__ KA,const bf16*__restrict__ VA,const float*__restrict__ sink,const float*__restrict__ rel_bias,char*shm){
  int tid_=threadIdx.x; asm volatile("":"+v"(tid_));
  const int tid=tid_,lane=tid&63,r32=lane&31,hi=lane>>5; const int wid=__builtin_amdgcn_readfirstlane(tid>>6);
  const lds_cptr shm3=(lds_cptr)shm; const unsigned lds0=(unsigned)(uintptr_t)shm;
  const lds_fptr tb=(lds_fptr)(shm3+SWA_TB);
  const int q0=qb*QB, T0=(qb==0)?0:4*qb-2, NT=4*qb+4-T0, dq=q0-64*T0; const size_t rb=(size_t)b*SEQ;
  { const bf16*ksrc=KA+(rb+64*T0+lane)*128+kvh*64+wid*8;
    const bf16*vsrc=VA+(rb+64*T0+16*(wid&3)+(lane>>2))*128+kvh*64+(wid>>2)*32+(lane&3)*8;
    for(int t=0;t<NT;++t){ glds16(ksrc+(long)t*KVBLK*128,(unsigned)__builtin_amdgcn_readfirstlane(lds0+SWA_K+t*SLOTB+wid*1024)); glds16(vsrc+(long)t*KVBLK*128,(unsigned)__builtin_amdgcn_readfirstlane(lds0+SWA_V+t*SLOTB+wid*1024)); } }
  for(int i=tid;i<640;i+=NW*64){ const int d=i-256; const bool in=(d>=0&&d<128); int bk=d<0?0:d; if(d>=16){ bk=16+(int)(__logf((float)d*(1.0f/16.0f))*(16.0f/2.0794415416798357f)); bk=bk>31?31:bk; }
    const float*rp=rel_bias+bk*8+4*kvh;
    #pragma unroll
    for(int hh=0;hh<4;++hh) tb[hh*640+i]=in?rp[hh]*LOG2E:-1e30f; }
  asm volatile("s_waitcnt vmcnt(0) lgkmcnt(0)\n\ts_barrier":::"memory");
  const int qrel=wid*QBLK+r32, off=dq+QBLK*wid;
  const int t_lo=(off>127)?((off-127)>>6):0, t_hi=(off+31)>>6;
  const lds_cptr kp0=shm3+SWA_K+hi*1024+r32*16; const lds_cptr vp0=shm3+SWA_V+((lane>>4)&1)*32+(lane&3)*8+(4*hi+((lane&15)>>2))*64;
  bf16x8 qn[4];
  { const bf16*Q0=QA+(rb+q0+wid*QBLK)*PQ+(4*kvh)*64;
    #pragma unroll
    for(int d0=0;d0<4;++d0)qn[d0]=*reinterpret_cast<const bf16x8*>(&Q0[(long)r32*PQ+d0*16+hi*8]); }
  #pragma unroll 1
  for(int hh=0;hh<4;++hh){
    const int hq=4*kvh+hh; bf16*Qw=QA+(rb+q0+wid*QBLK)*PQ+hq*64;
    bf16x8 qr[4];
    #pragma unroll
    for(int d0=0;d0<4;++d0)qr[d0]=qn[d0];
    { const bf16*Q1=Qw+((hh<3)?64:0);
      #pragma unroll
      for(int d0=0;d0<4;++d0)qn[d0]=*reinterpret_cast<const bf16x8*>(&Q1[(long)r32*PQ+d0*16+hi*8]); }
    const lds_fptr tp=tb+hh*640+(dq+qrel-4*hi+256);
    f32x16 s[3][2];
    #pragma unroll
    for(int k=0;k<3;++k){ const int t=t_lo+k;
      if(t<=t_hi){ const lds_fptr tq=tp-64*t;
        #pragma unroll
        for(int r=0;r<16;++r){ s[k][0][r]=tq[-((r&3)+8*(r>>2))]; s[k][1][r]=tq[-32-((r&3)+8*(r>>2))]; }
        const lds_cptr kp=kp0+t*SLOTB;
        #pragma unroll
        for(int d0=0;d0<4;++d0){ const bf16x8 a0=*(const __attribute__((address_space(3))) bf16x8*)(kp+d0*2048), a1=*(const __attribute__((address_space(3))) bf16x8*)(kp+d0*2048+512);
          s[k][0]=__builtin_amdgcn_mfma_f32_32x32x16_bf16(a0,qr[d0],s[k][0],0,0,0); s[k][1]=__builtin_amdgcn_mfma_f32_32x32x16_bf16(a1,qr[d0],s[k][1],0,0,0); } }
      else{
        #pragma unroll
        for(int r=0;r<16;++r){ s[k][0][r]=-1e30f; s[k][1][r]=-1e30f; } } }
    const float sk2=sink[hq]*LOG2E;
    float m=__builtin_fmaxf(__builtin_fmaxf(rowmax(s[0][0],s[0][1]),rowmax(s[1][0],s[1][1])),__builtin_fmaxf(rowmax(s[2][0],s[2][1]),sk2));
    float l=0.f;
    #pragma unroll
    for(int k=0;k<3;++k)
      #pragma unroll
      for(int r=0;r<16;++r){ s[k][0][r]=__builtin_amdgcn_exp2f(s[k][0][r]-m); s[k][1][r]=__builtin_amdgcn_exp2f(s[k][1][r]-m); l+=s[k][0][r]+s[k][1][r]; }
    { auto rr=__builtin_amdgcn_permlane32_swap(__float_as_uint(l),__float_as_uint(l),false,false); l=__uint_as_float(rr[0])+__uint_as_float(rr[1]); }
    l+=__builtin_amdgcn_exp2f(sk2-m);
    f32x16 o[2]; o[0]=f32x16{}; o[1]=f32x16{};
    #pragma unroll
    for(int k=0;k<3;++k){ const int t=t_lo+k;
      if(t<=t_hi){ const lds_cptr vp=vp0+t*SLOTB;
        u32x4 pw[4];
        pw[0]=(u32x4){cvtpk_s(s[k][0][0],s[k][0][1]),cvtpk_s(s[k][0][2],s[k][0][3]),cvtpk_s(s[k][0][4],s[k][0][5]),cvtpk_s(s[k][0][6],s[k][0][7])};
        pw[1]=(u32x4){cvtpk_s(s[k][0][8],s[k][0][9]),cvtpk_s(s[k][0][10],s[k][0][11]),cvtpk_s(s[k][0][12],s[k][0][13]),cvtpk_s(s[k][0][14],s[k][0][15])};
        pw[2]=(u32x4){cvtpk_s(s[k][1][0],s[k][1][1]),cvtpk_s(s[k][1][2],s[k][1][3]),cvtpk_s(s[k][1][4],s[k][1][5]),cvtpk_s(s[k][1][6],s[k][1][7])};
        pw[3]=(u32x4){cvtpk_s(s[k][1][8],s[k][1][9]),cvtpk_s(s[k][1][10],s[k][1][11]),cvtpk_s(s[k][1][12],s[k][1][13]),cvtpk_s(s[k][1][14],s[k][1][15])};
        #pragma unroll
        for(int dh=0;dh<2;++dh)
          #pragma unroll
          for(int ks=0;ks<4;++ks){ const s16x4 lo=vtr(vp+dh*4096+ks*1024), hh2=vtr(vp+dh*4096+ks*1024+512);
            const bf16x8 vf=(bf16x8){lo[0],lo[1],lo[2],lo[3],hh2[0],hh2[1],hh2[2],hh2[3]};
            o[dh]=__builtin_amdgcn_mfma_f32_32x32x16_bf16(__builtin_bit_cast(bf16x8,pw[ks]),vf,o[dh],0,0,0); } } }
    const lds_fptr wsf=(lds_fptr)(shm3+SWA_LDS_BYTES)+wid*64;
    if(hi==0)wsf[r32]=l;
    float rli[16];
    #pragma unroll
    for(int r=0;r<16;++r)rli[r]=__builtin_amdgcn_rcpf(wsf[crow(r,hi)]);
    { bf16*stg=(bf16*)(shm+SWA_LDS_BYTES+2048)+wid*2048;
      #pragma unroll
      for(int r=0;r<16;++r){const int orow=crow(r,hi);
        #pragma unroll
        for(int d0=0;d0<2;++d0)stg[orow*64+d0*32+r32]=__float2bfloat16(o[d0][r]*rli[r]);}
      #pragma unroll
      for(int i=0;i<4;++i){const int row=i*8+(lane>>3),ch=lane&7; const u32x4 v=*(const u32x4*)(stg+row*64+ch*8); *(u32x4*)(Qw+(long)row*PQ+ch*8)=v;} }
  }
  asm volatile("s_waitcnt lgkmcnt(0)\n\ts_barrier":::"memory");
}

constexpr int MEM_K=0, MEM_V=65536;
__device__ __forceinline__ void mem_unit(int b,int h,int qb,const bool prep,const unsigned char*__restrict__ MIMG,const bf16*QM,bf16*OM,char*shm,char*wsbase,char*stgbase,void*tsdbg){
  int tid_=threadIdx.x; asm volatile("":"+v"(tid_));
  const int tid=tid_,lane=tid&63,r32=lane&31,hi=lane>>5; const int wid=__builtin_amdgcn_readfirstlane(tid>>6);
  const lds_cptr shm3=(lds_cptr)shm;
  const lds_fptr wsf=(lds_fptr)((lds_cptr)wsbase)+wid*64;
  constexpr float EPSM=1e-6f;
  if(prep){ const unsigned lds0=(unsigned)(uintptr_t)shm; const unsigned char*src=MIMG+(size_t)(b*4+h)*131072+wid*1024+lane*16;
    #pragma unroll 4
    for(int i=0;i<16;++i) glds16(src+i*8192,(unsigned)__builtin_amdgcn_readfirstlane(lds0+i*8192+wid*1024)); }
  const bf16*Qw=QM+(size_t)(b*SEQ+qb*QB+wid*QBLK+r32)*PQ+h*128+hi*8;
  bf16x8 qr[8]; float qs=0.f;
  #pragma unroll
  for(int d0=0;d0<8;++d0){ qr[d0]=*reinterpret_cast<const bf16x8*>(Qw+16*d0);
    #pragma unroll
    for(int e=0;e<8;++e){ const float f=__uint_as_float(((unsigned)(unsigned short)qr[d0][e])<<16); qs+=f*f; } }
  { auto rr=__builtin_amdgcn_permlane32_swap(__float_as_uint(qs),__float_as_uint(qs),false,false); qs=__uint_as_float(rr[0])+__uint_as_float(rr[1]); }
  const float sc=1.0f/sqrtf(qs*(1.0f/128.0f)+EPSM);
  asm volatile("s_waitcnt vmcnt(0) lgkmcnt(0)\n\ts_barrier":::"memory");
#if defined(TSPROBE)
  if(prep&&threadIdx.x==0) atomicMax((unsigned long long*)tsdbg+19,(unsigned long long)__builtin_amdgcn_s_memrealtime());
#endif
  float m=-1e30f,l=0.f; f32x16 o[4]; o[0]=f32x16{};o[1]=f32x16{};o[2]=f32x16{};o[3]=f32x16{};
  const lds_cptr kp0=shm3+MEM_K+hi*4096+r32*16;
  const lds_cptr vp0=shm3+MEM_V+((lane>>4)&1)*32+(lane&3)*8+(4*hi+((lane&15)>>2))*64;
  #pragma unroll 1
  for(int t=0;t<4;++t){
    f32x16 p0=f32x16{},p1=f32x16{};
    { bf16x8 kf[16];
      #pragma unroll
      for(int d0=0;d0<8;++d0){ kf[2*d0]=*(const __attribute__((address_space(3))) bf16x8*)(kp0+d0*8192+t*1024); kf[2*d0+1]=*(const __attribute__((address_space(3))) bf16x8*)(kp0+d0*8192+t*1024+512); }
      SBAR();
      #pragma unroll
      for(int d0=0;d0<8;++d0){ p0=__builtin_amdgcn_mfma_f32_32x32x16_bf16(kf[2*d0],qr[d0],p0,0,0,0); p1=__builtin_amdgcn_mfma_f32_32x32x16_bf16(kf[2*d0+1],qr[d0],p1,0,0,0); }
      SBAR(); }
    #pragma unroll
    for(int r=0;r<16;++r){p0[r]*=sc;p1[r]*=sc;}
    const float rm=rowmax(p0,p1);
    const bool mv=(t==0)||__any(rm>m+8.0f);
    float alpha=1.0f;
    if(mv){ const float mn=__builtin_fmaxf(m,rm); alpha=__builtin_amdgcn_exp2f(m-mn); m=mn; }
    float rs=0.f;
    #pragma unroll
    for(int r=0;r<16;++r){p0[r]=__builtin_amdgcn_exp2f(p0[r]-m);p1[r]=__builtin_amdgcn_exp2f(p1[r]-m);rs+=p0[r]+p1[r];}
    l=l*alpha+rs;
    if(mv&&t!=0){
      if(hi==0)wsf[r32]=alpha;
      #pragma unroll
      for(int r=0;r<16;++r){ const float a=wsf[crow(r,hi)]; o[0][r]*=a;o[1][r]*=a;o[2][r]*=a;o[3][r]*=a; } }
    u32x4 pw0,pw1,pw2,pw3;
    pw0=(u32x4){cvtpk_s(p0[0],p0[1]),cvtpk_s(p0[2],p0[3]),cvtpk_s(p0[4],p0[5]),cvtpk_s(p0[6],p0[7])};
    pw1=(u32x4){cvtpk_s(p0[8],p0[9]),cvtpk_s(p0[10],p0[11]),cvtpk_s(p0[12],p0[13]),cvtpk_s(p0[14],p0[15])};
    pw2=(u32x4){cvtpk_s(p1[0],p1[1]),cvtpk_s(p1[2],p1[3]),cvtpk_s(p1[4],p1[5]),cvtpk_s(p1[6],p1[7])};
    pw3=(u32x4){cvtpk_s(p1[8],p1[9]),cvtpk_s(p1[10],p1[11]),cvtpk_s(p1[12],p1[13]),cvtpk_s(p1[14],p1[15])};
    const lds_cptr vp=vp0+t*16384;
    s16x4 va[8],vb[8];
    #define MEM_VRD(V,db) do{ _Pragma("unroll") for(int ks=0;ks<4;++ks){ V[2*ks]=vtr(vp+(db)*4096+ks*1024); V[2*ks+1]=vtr(vp+(db)*4096+ks*1024+512); } }while(0)
    #define MEM_VF(V,ks) (bf16x8){V[2*(ks)][0],V[2*(ks)][1],V[2*(ks)][2],V[2*(ks)][3],V[2*(ks)+1][0],V[2*(ks)+1][1],V[2*(ks)+1][2],V[2*(ks)+1][3]}
    #define MEM_PV(V,db) do{ o[db]=__builtin_amdgcn_mfma_f32_32x32x16_bf16(__builtin_bit_cast(bf16x8,pw0),MEM_VF(V,0),o[db],0,0,0); o[db]=__builtin_amdgcn_mfma_f32_32x32x16_bf16(__builtin_bit_cast(bf16x8,pw1),MEM_VF(V,1),o[db],0,0,0); \
        o[db]=__builtin_amdgcn_mfma_f32_32x32x16_bf16(__builtin_bit_cast(bf16x8,pw2),MEM_VF(V,2),o[db],0,0,0); o[db]=__builtin_amdgcn_mfma_f32_32x32x16_bf16(__builtin_bit_cast(bf16x8,pw3),MEM_VF(V,3),o[db],0,0,0); }while(0)
    MEM_VRD(va,0); SBAR();
    MEM_VRD(vb,1); MEM_PV(va,0); SBAR();
    MEM_VRD(va,2); MEM_PV(vb,1); SBAR();
    MEM_VRD(vb,3); MEM_PV(va,2); SBAR();
    MEM_PV(vb,3); SBAR();
    #undef MEM_VRD
    #undef MEM_VF
    #undef MEM_PV
  }
  { auto rr=__builtin_amdgcn_permlane32_swap(__float_as_uint(l),__float_as_uint(l),false,false); l=__uint_as_float(rr[0])+__uint_as_float(rr[1]); }
  if(hi==0)wsf[32+r32]=l;
  bf16*Ow=OM+(size_t)(b*SEQ+qb*QB+wid*QBLK)*PQ+h*128;
  { bf16*stg=(bf16*)stgbase+wid*1024;
    #pragma unroll
    for(int g=0;g<4;++g){
      #pragma unroll
      for(int j=0;j<4;++j){ const int r=4*g+j; const float rl=__builtin_amdgcn_rcpf(wsf[32+crow(r,hi)]);
        #pragma unroll
        for(int db=0;db<4;++db) stg[(4*hi+j)*128+32*db+r32]=__float2bfloat16(o[db][r]*rl); }
      #pragma unroll
      for(int i=0;i<2;++i){ const int row=i*4+(lane>>4),ch=lane&15; const u32x4 v=*(const u32x4*)(stg+row*128+ch*8); *(u32x4*)(Ow+(size_t)(8*g+row)*PQ+ch*8)=v; } } }
  __syncthreads();
}
#undef SBAR
#undef WAIT_BAR
#undef MX3
}

constexpr int NWAVES = 8;
constexpr int SEQ = 4096, NBATCH = 8, MTOK = NBATCH * SEQ, MMEM = NBATCH * 256;
constexpr int NIN_ARGS = 23;
enum InIdx { I_X = 0, I_MEM, I_GMIX, I_WIN, I_BGATE, I_BFORGET, I_QNSWA, I_KNSWA, I_SINK, I_RELBIAS, I_QNFOX, I_KNFOX, I_GMEM, I_WMEMKV, I_QNMEM, I_KNMEM, I_WOSWA, I_WOFOX, I_WOMEM, I_WOUT, I_GMLP, I_WUP, I_WDN };
constexpr size_t MiB = 1u << 20;
#if defined(TSPROBE) || (defined(DETPROBE) && DETPROBE)
constexpr size_t WS_CTL = 0, CTL_ZERO_BYTES = 128 * 1024;
#else
constexpr size_t WS_CTL = 0, CTL_ZERO_BYTES = 32 * 1024;
#endif
constexpr size_t WS_WIN = 2 * MiB, WS_WKV = 14 * MiB, WS_WO = 16 * MiB, WS_WOUT = 19 * MiB, WS_WUP = 25 * MiB, WS_WD = 33 * MiB;
constexpr size_t WS_LOGF = 41 * MiB, WS_G2 = 42 * MiB, WS_SSQ = 43 * MiB, WS_MEMN = 45 * MiB, WS_MKV = 49 * MiB, WS_RINV = 57 * MiB;
constexpr size_t WS_WIN8 = 58 * MiB, WS_H8 = 224 * MiB;
constexpr size_t WS_MRG = 160 * MiB;
constexpr size_t WS_GT = 64 * MiB;
constexpr size_t WS_H = 256 * MiB;
constexpr size_t WS_U = 64 * MiB;
constexpr size_t WS_QCAT = 320 * MiB, WS_KA = 416 * MiB, WS_VA = 424 * MiB, WS_KF = 432 * MiB, WS_VF = 464 * MiB;
constexpr size_t WS_X1B = 320 * MiB;
constexpr size_t WS_END = 496 * MiB;
constexpr int CW_FOXQ = 2048;
constexpr size_t WS_SWG = 57 * MiB + 512 * 1024;
constexpr size_t WS_HS = 57 * MiB + 256 * 1024;
constexpr int CW_BAR = 4096;
constexpr int RING_OFF = 0, RING_BYTES = 131072;
constexpr int ATT_EXTRA_OFF = RING_BYTES;
constexpr int LDSCTL_OFF = 159744, MISC_OFF = LDSCTL_OFF + 320, MEMWS_OFF = LDSCTL_OFF + 1024, DUMP_OFF = LDSCTL_OFF + 3072;
constexpr int LDS_BYTES = 163840;
static_assert((CW_BAR + 3456) * 4 <= (int)CTL_ZERO_BYTES && DUMP_OFF + 256 <= LDS_BYTES && pg8::STAGE_BYTES == RING_BYTES && MEMWS_OFF + 2048 <= DUMP_OFF && attn_body::LDS_BYTES <= RING_BYTES && attn_body::SWA_LDS_BYTES + 2048 + 32768 <= LDSCTL_OFF && ATT_EXTRA_OFF + 92 * 64 * 4 + 4096 <= LDSCTL_OFF, "LDS map");
#define GAS __attribute__((address_space(1)))
#define LAS __attribute__((address_space(3)))
typedef unsigned short bf16;
typedef unsigned v4u __attribute__((ext_vector_type(4)));
typedef float f32x4 __attribute__((ext_vector_type(4)));
typedef short bf16x8 __attribute__((ext_vector_type(8)));
typedef GAS unsigned gu32;
typedef GAS unsigned long long gu64;
#define RLX_AGENT __ATOMIC_RELAXED, __HIP_MEMORY_SCOPE_AGENT
#define LDS_WAIT() asm volatile("s_waitcnt lgkmcnt(0)" ::: "memory")
#define VM_WAIT() asm volatile("s_waitcnt vmcnt(0)" ::: "memory")
__device__ __forceinline__ unsigned long long rt() { return __builtin_amdgcn_s_memrealtime(); }
__device__ __forceinline__ unsigned f2bf(float f) { unsigned u = __builtin_bit_cast(unsigned, f); return (u + 0x7fffu + ((u >> 16) & 1u)) >> 16; }
__device__ __forceinline__ unsigned pk2(float lo, float hi) { return f2bf(lo) | (f2bf(hi) << 16); }

#define XB_TMO      128
#define XB_XCNT(j)  (256  + 64 * (j))
#define XB_XSUB(j)  (1280 + 64 * (j))
#define XB_XGEN(j)  (2304 + 64 * (j))
#define XB_TOP      3328
#define XB_TOPGEN   3392
#define XCD_BAR_WORDS 3456
#define XB_SPIN_CAP (1u << 18)

__device__ __forceinline__ unsigned xb_ld(unsigned* p)              { return __hip_atomic_load(p, __ATOMIC_RELAXED, __HIP_MEMORY_SCOPE_AGENT); }
__device__ __forceinline__ unsigned xb_add(unsigned* p, unsigned v) { return __hip_atomic_fetch_add(p, v, __ATOMIC_RELAXED, __HIP_MEMORY_SCOPE_AGENT); }
__device__ __forceinline__ unsigned xb_xcc_id() { return (unsigned)__builtin_amdgcn_s_getreg((3 << 11) | 20) & 0xFu; }
#define XB_SPIN(cond, bar) do { unsigned _sp = 0; while (cond) { __builtin_amdgcn_s_sleep(1); \
    if ((++_sp & 255u) == 0u) { if (xb_ld(&(bar)[XB_TMO])) break; if (_sp > XB_SPIN_CAP) { atomicAdd(&(bar)[XB_TMO], 1u); break; } } } } while (0)

struct XcdBarrier {
    unsigned* bar; unsigned x;
    volatile LAS unsigned* st;
};

__device__ __forceinline__ XcdBarrier xcd_barrier_post(unsigned* bar, volatile LAS unsigned* st) {
    XcdBarrier b; b.bar = bar; b.x = xb_xcc_id(); b.st = st;
    if (threadIdx.x == 0) (void)xb_add(&bar[XB_XCNT(b.x)], 1u);
    return b;
}
__device__ __forceinline__ void xcd_barrier_complete(unsigned* bar, unsigned x, unsigned& nloc, unsigned& nx) {
    const unsigned G = gridDim.x * gridDim.y * gridDim.z;
    unsigned sum, cnt, mine, sp = 0u;
    for (;;) {
        sum = 0u; cnt = 0u; mine = 0u;
#pragma unroll
        for (unsigned j = 0; j < 16; ++j) { const unsigned c = xb_ld(&bar[XB_XCNT(j)]); sum += c; cnt += (c > 0u) ? 1u : 0u; mine = (j == x) ? c : mine; }
        if (sum == G) break;
        __builtin_amdgcn_s_sleep(1);
        if ((++sp & 255u) == 0u) { if (xb_ld(&bar[XB_TMO])) break; if (sp > XB_SPIN_CAP) { atomicAdd(&bar[XB_TMO], 1u); break; } }
    }
    nloc = mine > 0u ? mine : 1u; nx = cnt > 0u ? cnt : 1u;
}

__device__ __forceinline__ void xcd_barrier(const XcdBarrier& b) {
    asm volatile("s_waitcnt vmcnt(0)" ::: "memory");
    __syncthreads();
    if (threadIdx.x == 0) {
        unsigned* bar = b.bar;
        __builtin_amdgcn_s_waitcnt(0);
        unsigned nloc = b.st[0], nx = b.st[1];
        if (nloc == 0u) { xcd_barrier_complete(bar, b.x, nloc, nx); b.st[0] = nloc; b.st[1] = nx; }
        const unsigned old = xb_add(&bar[XB_XSUB(b.x)], 1u);
        const unsigned gen = old / nloc;
        if (old + 1u == (gen + 1u) * nloc) {
            __builtin_amdgcn_fence(__ATOMIC_RELEASE, "agent");
            asm volatile("s_waitcnt vmcnt(0)" ::: "memory");
            const unsigned og = xb_add(&bar[XB_TOP], 1u);
            const unsigned tg = og / nx;
            if (og + 1u == (tg + 1u) * nx) xb_add(&bar[XB_TOPGEN], 1u);
            else XB_SPIN(xb_ld(&bar[XB_TOPGEN]) == tg, bar);
            __builtin_amdgcn_fence(__ATOMIC_ACQUIRE, "agent");
            xb_add(&bar[XB_XGEN(b.x)], 1u);
            asm volatile("s_waitcnt vmcnt(0)" ::: "memory");
        } else {
            XB_SPIN(xb_ld(&bar[XB_XGEN(b.x)]) == gen, bar);
            __builtin_amdgcn_fence(__ATOMIC_ACQUIRE, "agent");
            asm volatile("s_waitcnt vmcnt(0)" ::: "memory");
        }
    }
    __syncthreads();
}

#if defined(DETPROBE) && DETPROBE
constexpr size_t WS_CHK = 57 * MiB;
__global__ void chk_sum(const unsigned* p, size_t nwords, unsigned long long* dst) {
    unsigned long long s = 0; const size_t stride = (size_t)gridDim.x * blockDim.x;
    for (size_t i = (size_t)blockIdx.x * blockDim.x + threadIdx.x; i < nwords; i += stride) s += (unsigned long long)p[i] * (unsigned long long)((i & 1023) + 1);
#pragma unroll
    for (int o = 32; o > 0; o >>= 1) s += __shfl_xor(s, o);
    if ((threadIdx.x & 63) == 0) atomicAdd(dst, s);
}
__global__ void chk_report(const unsigned long long* chk, float* out, int nslots, size_t n) {
    float mk = 0.f; for (int s = 0; s < nslots; ++s) if (chk[s] != chk[64 + s]) { mk = 1000.0f * (float)(s + 1); break; }
    const size_t stride = (size_t)gridDim.x * blockDim.x;
    for (size_t i = (size_t)blockIdx.x * blockDim.x + threadIdx.x; i < n; i += stride) out[i] = (i == 0) ? mk : 0.f;
}
#endif


struct Frame {
    LAS unsigned char* lds;
    volatile LAS unsigned* MISC;
    gu32* ctl;
    int tid, lane, wave;
    int vcu, G;
    const float *x, *mem, *w_in, *w_mem_kv, *w_o_swa, *w_o_fox, *w_o_mem, *w_out, *w_up, *w_dn, *g_mix, *g_mlp, *g_mem, *b_forget;
    float* out; unsigned char* ws;
};

__device__ __forceinline__ float wave_sum(float v) {
#pragma unroll
    for (int o = 1; o < 64; o <<= 1) v += __shfl_xor(v, o);
    return v;
}
typedef float f32x2_t __attribute__((ext_vector_type(2))); typedef __bf16 bf16x2_t __attribute__((ext_vector_type(2))); typedef unsigned u32x4_t __attribute__((ext_vector_type(4)));
__device__ __forceinline__ unsigned pkc(float lo, float hi) { f32x2_t v = {lo, hi}; bf16x2_t b = __builtin_convertvector(v, bf16x2_t); return __builtin_bit_cast(unsigned, b); }
__device__ __forceinline__ unsigned pk8(float a, float b, float c, float d) { unsigned w = 0; w = __builtin_amdgcn_cvt_pk_fp8_f32(a, b, w, false); w = __builtin_amdgcn_cvt_pk_fp8_f32(c, d, w, true); return w; }
__device__ __forceinline__ unsigned pki8(float a, float b, float c, float d) {
    const unsigned ua = __float_as_uint(a + 12582912.0f), ub = __float_as_uint(b + 12582912.0f), uc = __float_as_uint(c + 12582912.0f), ud = __float_as_uint(d + 12582912.0f);
    return __builtin_amdgcn_perm(ub, ua, 0x0c0c0400u) | __builtin_amdgcn_perm(ud, uc, 0x04000c0cu); }
__device__ __forceinline__ float wave_max(float v) {
#pragma unroll
    for (int o = 1; o < 64; o <<= 1) v = fmaxf(v, __shfl_xor(v, o));
    return v; }
__device__ __forceinline__ void p0_tr_item(const float* __restrict__ W, int ldw, int k0, int n0, bf16* WT, int ldt, int drow_lane, int dk0, const float* __restrict__ kscale, int lane) {
    const int c4 = lane & 7, kg = lane >> 3;
    const float* src = W + (size_t)(k0 + 8 * kg) * ldw + n0 + 4 * c4;
    f32x4 r[8];
#pragma unroll
    for (int i = 0; i < 8; ++i) r[i] = *(const GAS f32x4*)(src + (size_t)i * ldw);
    if (kscale) { const f32x4 s0 = *(const GAS f32x4*)(kscale + k0 + 8 * kg), s1 = *(const GAS f32x4*)(kscale + k0 + 8 * kg + 4);
#pragma unroll
        for (int i = 0; i < 4; ++i) { r[i] = r[i] * s0[i]; r[4 + i] = r[4 + i] * s1[i]; } }
    bf16* dst = WT + (size_t)drow_lane * ldt + dk0 + k0 + 8 * kg;
#pragma unroll
    for (int e = 0; e < 4; ++e) { v4u o; o.x = pkc(r[0][e], r[1][e]); o.y = pkc(r[2][e], r[3][e]); o.z = pkc(r[4][e], r[5][e]); o.w = pkc(r[6][e], r[7][e]); *(GAS v4u*)(dst + (size_t)e * ldt) = o; }
}
__device__ __forceinline__ int in_srcbase(int g) {
    return g < 8 ? 64 * g : g < 10 ? 512 + 64 * (g - 8) : g < 12 ? 640 + 64 * (g - 10) : g < 20 ? 768 + 64 * (g - 12) : g < 28 ? 1280 + 64 * (g - 20) : g < 36 ? 1792 + 64 * (g - 28) : g < 44 ? 2312 + 64 * (g - 36) : 2824 + 64 * (g - 44);
}
__device__ __forceinline__ float rms_row_to_bf16(const f32x4 (&v)[4], const f32x4 (&gn)[4], bf16* orow, int lane, f32x4 (&vg)[4], float* rinv) {
    float s = 0.f;
#pragma unroll
    for (int j = 0; j < 4; ++j) s += (v[j].x * v[j].x + v[j].y * v[j].y) + (v[j].z * v[j].z + v[j].w * v[j].w);
    const float rt2 = sqrtf(wave_sum(s) * (1.f / 1024.f) + 1e-6f); const float r = 1.f / rt2;
    if (rinv && lane == 0) *rinv = rt2;
    GAS unsigned long long* o8 = (GAS unsigned long long*)orow + lane;
#pragma unroll
    for (int j = 0; j < 4; ++j) { vg[j] = v[j] * gn[j]; const f32x4 y = vg[j] * r; o8[64 * j] = (unsigned long long)pkc(y.x, y.y) | ((unsigned long long)pkc(y.z, y.w) << 32); }
    return r;
}
__device__ __forceinline__ int adj_row(int n) { return 128 * ((n >> 3) & 1) + 32 * (n >> 6) + 8 * ((n & 63) >> 4) + (n & 7); }
#ifndef P1_T8
#define P1_T8 3
#endif
constexpr int I_IN = 16 * 184, I_KV = 16 * 32, I_O1 = 8 * 32, I_OUT = 16 * 32, I_UP = 16 * 128, I_DN = 64 * 32;
constexpr int I_EARLY = I_IN + I_KV, NITEMS = I_IN + I_KV + 3 * I_O1 + I_OUT + I_UP + I_DN;
struct WItem { size_t dst; int ldt, ksc, f8; float qs; };
__device__ __forceinline__ WItem witem_fetch(const Frame& F, int it, f32x4 (&rr)[8]) {
    const int c4 = F.lane & 7, kg = F.lane >> 3;
    WItem w; w.ksc = -1; w.f8 = 0; w.qs = 0.f;
#define WI_LOAD(Wp_, ldw_, k0_, n0_) do { const float* sp_ = (Wp_) + (size_t)((k0_) + 8 * kg) * (ldw_) + (n0_) + 4 * c4; _Pragma("unroll") for (int i = 0; i < 8; ++i) rr[i] = __builtin_nontemporal_load((const GAS f32x4*)(sp_ + (size_t)i * (ldw_))); } while (0)
#define WI_DST(ws_off_, ldt_, drow_, dk_) do { w.ldt = (ldt_); w.dst = (size_t)(ws_off_) / 2 + (size_t)(drow_) * (ldt_) + (dk_) + 8 * kg; } while (0)
    int r = it;
    if (r < I_IN) { const int kb = r / 184, gg = r % 184, g = gg >> 1, bj = gg & 1;
        const int drow = 256 * pg8::p1_ptile(g >> 2) + ((g >= 44) ? adj_row(64 * (g & 3) + 32 * bj + 4 * c4) : 128 * bj + 32 * (g & 3) + 4 * c4);
        WI_LOAD(F.w_in, 5896, 64 * kb, in_srcbase(g) + 32 * bj); WI_DST(WS_WIN, 1024, drow, 64 * kb);
        w.f8 = 2; w.ldt = 1024; w.dst = WS_WIN8 + (size_t)drow * 1024 + 64 * kb + 8 * kg;
        return w; } r -= I_IN;
    if (r < I_KV) { WI_LOAD(F.w_mem_kv, 1024, 64 * (r / 32), 32 * (r % 32)); WI_DST(WS_WKV, 1024, 32 * (r % 32) + 4 * c4, 64 * (r / 32)); return w; } r -= I_KV;
    if (r < I_O1) { WI_LOAD(F.w_o_swa, 1024, 64 * (r / 32), 32 * (r % 32)); WI_DST(WS_WO, 1536, 256 * ((r % 32) >> 3) + adj_row(32 * ((r % 32) & 7) + 4 * c4), 64 * (r / 32)); return w; } r -= I_O1;
    if (r < I_O1) { WI_LOAD(F.w_o_fox, 1024, 64 * (r / 32), 32 * (r % 32)); WI_DST(WS_WO, 1536, 256 * ((r % 32) >> 3) + adj_row(32 * ((r % 32) & 7) + 4 * c4), 512 + 64 * (r / 32)); return w; } r -= I_O1;
    if (r < I_O1) { WI_LOAD(F.w_o_mem, 1024, 64 * (r / 32), 32 * (r % 32)); WI_DST(WS_WO, 1536, 256 * ((r % 32) >> 3) + adj_row(32 * ((r % 32) & 7) + 4 * c4), 1024 + 64 * (r / 32)); return w; } r -= I_O1;
    if (r < I_OUT) { WI_LOAD(F.w_out, 1024, 64 * (r / 32), 32 * (r % 32)); WI_DST(WS_WOUT, 1024, 32 * (r % 32) + 4 * c4, 64 * (r / 32)); return w; } r -= I_OUT;
    if (r < I_UP) { WI_LOAD(F.w_up, 4096, 64 * (r / 128), 32 * (r % 128)); WI_DST(WS_WUP, 1024, 256 * ((r % 128) >> 3) + adj_row(32 * ((r % 128) & 7) + 4 * c4), 64 * (r / 128)); w.ksc = 64 * (r / 128) + 8 * kg; return w; } r -= I_UP;
    WI_LOAD(F.w_dn, 1024, 64 * (r / 32), 32 * (r % 32)); WI_DST(WS_WD, 4096, 32 * (r % 32) + 4 * c4, 64 * (r / 32));
#undef WI_LOAD
#undef WI_DST
    return w;
}
__device__ __forceinline__ void witem_store(const Frame& F, const WItem& w, f32x4 (&r)[8], float qs = 0.f) {
    if (w.f8 == 2) { const f32x4 s0 = {qs, qs, qs, qs}, s1 = s0; unsigned char* d8 = F.ws + w.dst;
#pragma unroll
        for (int e = 0; e < 4; ++e) { const unsigned lo = pki8(r[0][e] * s0[0], r[1][e] * s0[1], r[2][e] * s0[2], r[3][e] * s0[3]), hi = pki8(r[4][e] * s1[0], r[5][e] * s1[1], r[6][e] * s1[2], r[7][e] * s1[3]);
            *(GAS unsigned long long*)(d8 + (size_t)e * w.ldt) = (unsigned long long)lo | ((unsigned long long)hi << 32); }
        return; }
    if (w.f8) { unsigned char* d8 = F.ws + w.dst;
#pragma unroll
        for (int e = 0; e < 4; ++e) { const unsigned lo = pk8(r[0][e] * 64.f, r[1][e] * 64.f, r[2][e] * 64.f, r[3][e] * 64.f), hi = pk8(r[4][e] * 64.f, r[5][e] * 64.f, r[6][e] * 64.f, r[7][e] * 64.f);
            *(GAS unsigned long long*)(d8 + (size_t)e * w.ldt) = (unsigned long long)lo | ((unsigned long long)hi << 32); }
        return; }
    if (w.ksc >= 0) { const f32x4 s0 = *(const GAS f32x4*)(F.g_mlp + w.ksc), s1 = *(const GAS f32x4*)(F.g_mlp + w.ksc + 4);
#pragma unroll
        for (int i = 0; i < 4; ++i) { r[i] = r[i] * s0[i]; r[4 + i] = r[4 + i] * s1[i]; } }
    bf16* dst = (bf16*)F.ws + w.dst;
#pragma unroll
    for (int e = 0; e < 4; ++e) { v4u o; o.x = pkc(r[0][e], r[1][e]); o.y = pkc(r[2][e], r[3][e]); o.z = pkc(r[4][e], r[5][e]); o.w = pkc(r[6][e], r[7][e]); *(GAS v4u*)(dst + (size_t)e * w.ldt) = o; }
}
__device__ __forceinline__ void weight_items_1(Frame& F, int lo, int hi, int widx, int nw) {
    for (int it = lo + widx; it < hi; it += nw) { f32x4 ra[8]; const WItem a = witem_fetch(F, it, ra); witem_store(F, a, ra); }
}
__device__ __forceinline__ void weight_items(Frame& F, int lo, int hi, int widx, int nw) {
    for (int it = lo + widx; it < hi; it += 2 * nw) {
        const int it2 = it + nw; const bool two = it2 < hi;
        f32x4 ra[8], rb[8];
        const WItem a = witem_fetch(F, it, ra), b = witem_fetch(F, two ? it2 : it, rb);
        witem_store(F, a, ra);
        if (two) witem_store(F, b, rb);
    }
}
__device__ __forceinline__ float amax8(const f32x4 (&r)[8]) { float m = 0.f;
#pragma unroll
    for (int i = 0; i < 8; ++i) m = fmaxf(m, fmaxf(fmaxf(fabsf(r[i].x), fabsf(r[i].y)), fmaxf(fabsf(r[i].z), fabsf(r[i].w))));
    return m; }
__device__ __forceinline__ void win_quant(Frame& F) {
    float* SWG = (float*)(F.ws + WS_SWG);
    for (int hg = (int)blockIdx.x; hg < 184; hg += F.G) {
        f32x4 ra[8], rb[8];
        const WItem a = witem_fetch(F, (2 * F.wave) * 184 + hg, ra), b = witem_fetch(F, (2 * F.wave + 1) * 184 + hg, rb);
        const float mx = wave_max(fmaxf(amax8(ra), amax8(rb)));
        if (F.lane == 0) F.MISC[16 + F.wave] = __float_as_uint(mx);
        __syncthreads();
        unsigned m8 = 0u;
#pragma unroll
        for (int w = 0; w < NWAVES; ++w) { const unsigned t8 = F.MISC[16 + w]; m8 = t8 > m8 ? t8 : m8; }
        __syncthreads();
        const float gmax = __uint_as_float(m8), qs = gmax > 0.f ? 127.0f / gmax : 0.f;
        if (F.tid == 0) SWG[hg] = gmax * (1.0f / 127.0f);
        witem_store(F, a, ra, qs); witem_store(F, b, rb, qs);
    }
}
__device__ __forceinline__ float lane_xor(float v, int d) { return __shfl_xor(v, d); }
template <int MODE = 0> __device__ __forceinline__ void p0_trip(const Frame& F, f32x4 (&v)[4][4], const f32x4 (&gn)[4], int m0, int mstep, int msafe, LAS const f32x4* wl, float bsel, bf16* H, float* LOGF, float* RINV, unsigned char* H8, float* HSC) {
    if (MODE == 2) { f32x4 a_ = v[0][0];
#pragma unroll
        for (int q = 0; q < 4; ++q)
#pragma unroll
            for (int j = 0; j < 4; ++j) a_ += v[q][j];
        asm volatile("" :: "v"(a_)); return; }
    int lane_o = F.lane; asm volatile("" : "+v"(lane_o)); const int lane = lane_o;
    const bool h5 = (lane & 32) != 0, h4 = (lane & 16) != 0, h3 = (lane & 8) != 0, h2 = (lane & 4) != 0, h1 = (lane & 2) != 0;
    float r[4];
    {   float s[4];
#pragma unroll
        for (int q = 0; q < 4; ++q) { s[q] = 0.f;
#pragma unroll
            for (int j = 0; j < 4; ++j) s[q] += (v[q][j].x * v[q][j].x + v[q][j].y * v[q][j].y) + (v[q][j].z * v[q][j].z + v[q][j].w * v[q][j].w); }
        float k0 = (h5 ? s[2] : s[0]) + lane_xor(h5 ? s[0] : s[2], 32), k1 = (h5 ? s[3] : s[1]) + lane_xor(h5 ? s[1] : s[3], 32);
        float k = (h4 ? k1 : k0) + lane_xor(h4 ? k0 : k1, 16);
        k += lane_xor(k, 8); k += lane_xor(k, 4); k += lane_xor(k, 2); k += lane_xor(k, 1);
#pragma unroll
        for (int q = 0; q < 4; ++q) { const float tot = __int_as_float(__builtin_amdgcn_readlane(__float_as_int(k), 16 * q)); const float rt2 = sqrtf(tot * (1.f / 1024.f) + 1e-6f); r[q] = 1.f / rt2;
            const int mq = m0 + q * mstep; const bool ok = mq < MTOK;
            if (MODE == 0 && ok && lane == 0) RINV[mq] = rt2;
            GAS unsigned long long* o8 = (GAS unsigned long long*)(H + (size_t)(ok ? mq : msafe) * 1024) + lane;
            GAS unsigned* o4 = (GAS unsigned*)(H8 + (size_t)(ok ? mq : msafe) * 1024) + lane;
            float mloc = 0.f;
#pragma unroll
            for (int j = 0; j < 4; ++j) { v[q][j] = v[q][j] * gn[j]; mloc = fmaxf(mloc, fmaxf(fmaxf(fabsf(v[q][j].x), fabsf(v[q][j].y)), fmaxf(fabsf(v[q][j].z), fabsf(v[q][j].w)))); }
            const float mrow = wave_max(mloc), iq = mrow > 0.f ? 127.0f / mrow : 0.f;
            if (MODE == 0 && ok && lane == 0) HSC[mq] = mrow * r[q] * (1.0f / 127.0f);
#pragma unroll
            for (int j = 0; j < 4; ++j) { const f32x4 y = v[q][j] * r[q]; const unsigned long long pk_ = (unsigned long long)pkc(y.x, y.y) | ((unsigned long long)pkc(y.z, y.w) << 32); if (MODE == 0) { if (ok) { o8[64 * j] = pk_; o4[64 * j] = pki8(v[q][j].x * iq, v[q][j].y * iq, v[q][j].z * iq, v[q][j].w * iq); } } else asm volatile("" :: "v"(pk_)); } }
    }
    float val[32];
    {   f32x2_t acc2[16];
#pragma unroll
        for (int i = 0; i < 16; ++i) acc2[i] = (f32x2_t){0.f, 0.f};
        LAS const f32x4* wl_ = wl + lane; asm volatile("" : "+v"(wl_));
#pragma unroll
        for (int j = 0; j < 4; ++j) {
#pragma unroll
            for (int e = 0; e < 4; ++e) { const f32x4 wa = wl_[(j * 4 + e) * 64], wb = wl_[1024 + (j * 4 + e) * 64];
                const f32x2_t w0 = {wa[0], wa[1]}, w1 = {wa[2], wa[3]}, w2 = {wb[0], wb[1]}, w3 = {wb[2], wb[3]};
#pragma unroll
                for (int q = 0; q < 4; ++q) { const f32x2_t xx = {v[q][j][e], v[q][j][e]};
                    acc2[4 * q + 0] += w0 * xx; acc2[4 * q + 1] += w1 * xx; acc2[4 * q + 2] += w2 * xx; acc2[4 * q + 3] += w3 * xx; } }
            asm volatile("" ::: "memory");
        }
#pragma unroll
        for (int i = 0; i < 16; ++i) { val[2 * i] = acc2[i][0]; val[2 * i + 1] = acc2[i][1]; }
    }
#define P0_RS(n_, h_, d_) do { _Pragma("unroll") for (int i = 0; i < (n_); ++i) val[i] = ((h_) ? val[i + (n_)] : val[i]) + lane_xor((h_) ? val[i] : val[i + (n_)], (d_)); } while (0)
    P0_RS(16, h5, 32); P0_RS(8, h4, 16); P0_RS(4, h3, 8); P0_RS(2, h2, 4); P0_RS(1, h1, 2);
#undef P0_RS
    float z = val[0] + lane_xor(val[0], 1);
    const float rsel = h5 ? (h4 ? r[3] : r[2]) : (h4 ? r[1] : r[0]);
    z = z * rsel + bsel;
    z = fminf(z, 0.f) - log1pf(expf(-fabsf(z)));
    const int mq = m0 + (lane >> 4) * mstep;
    if (MODE == 0) { if (mq < MTOK && (lane & 1) == 0) LOGF[(size_t)mq * 8 + ((lane >> 1) & 7)] = z; } else asm volatile("" :: "v"(z));
}
__device__ __forceinline__ void p0_prologue(Frame& F) {
    const float* x = F.x; const float* mem = F.mem; const float* w_in = F.w_in;
    const int gw = F.vcu * NWAVES + F.wave, NGW = F.G * NWAVES;
    bf16* H = (bf16*)(F.ws + WS_H); float* LOGF = (float*)(F.ws + WS_LOGF); float* RINV = (float*)(F.ws + WS_RINV); bf16* MEMN = (bf16*)(F.ws + WS_MEMN); unsigned char* H8 = F.ws + WS_H8; float* HSC = (float*)(F.ws + WS_HS);
    LAS f32x4* wl = (LAS f32x4*)(F.lds + RING_OFF);
    f32x4 wreg[4];
#pragma unroll
    for (int q = 0; q < 4; ++q) { const int i = F.tid + NWAVES * 64 * q, h = i >> 10, je = (i >> 6) & 15, l = i & 63, k = 4 * l + 256 * (je >> 2) + (je & 3); wreg[q] = *(const GAS f32x4*)(w_in + (size_t)k * 5896 + 2304 + 4 * h); }
    f32x4 va[4][4], vb[4][4];
#if !defined(EXPER_NO_NTLOAD)
#define P0_XLOAD(p_) __builtin_nontemporal_load(p_)
#else
#define P0_XLOAD(p_) (*(p_))
#endif
#define P0_LOAD(v_, m0_) do { _Pragma("unroll") for (int q = 0; q < 4; ++q) { const int mq_ = (m0_) + q * NGW; const GAS f32x4* xp_ = (const GAS f32x4*)(x + (size_t)(mq_ < MTOK ? mq_ : gw) * 1024) + F.lane; \
        _Pragma("unroll") for (int j = 0; j < 4; ++j) v_[q][j] = P0_XLOAD(xp_ + 64 * j); } } while (0)
    P0_LOAD(va, gw);
#pragma unroll
    for (int q = 0; q < 4; ++q) wl[F.tid + NWAVES * 64 * q] = wreg[q];
    __syncthreads();
    { f32x4 gm[4], vg[4];
#pragma unroll
      for (int j = 0; j < 4; ++j) gm[j] = ((const GAS f32x4*)F.g_mem)[F.lane + 64 * j];
      for (int m = gw; m < MMEM; m += NGW) { f32x4 v[4];
#pragma unroll
          for (int j = 0; j < 4; ++j) v[j] = __builtin_nontemporal_load((const GAS f32x4*)(mem + (size_t)m * 1024) + F.lane + 64 * j);
          (void)rms_row_to_bf16(v, gm, MEMN + (size_t)m * 1024, F.lane, vg, nullptr); } }
    win_quant(F);
    if (F.G == 256) { if (blockIdx.x >= 184) weight_items(F, I_IN, I_EARLY, ((int)blockIdx.x - 184) * NWAVES + F.wave, 72 * NWAVES); }
    else weight_items(F, I_IN, NITEMS, gw, NGW);
    P0_LOAD(vb, gw + 4 * NGW);
    f32x4 gn[4];
#pragma unroll
    for (int j = 0; j < 4; ++j) gn[j] = ((const GAS f32x4*)F.g_mix)[F.lane + 64 * j];
    const float bsel = F.b_forget[(F.lane >> 1) & 7];
#if defined(TSPROBE)
    if (threadIdx.x == 0) atomicMax((unsigned long long*)(F.ws + 65536) + 8, rt());
#endif
    for (int m = gw; m < MTOK; m += 8 * NGW) {
        p0_trip(F, va, gn, m, NGW, gw, wl, bsel, H, LOGF, RINV, H8, HSC);
        if (m + 8 * NGW < MTOK) P0_LOAD(va, m + 8 * NGW);
        const int m2 = m + 4 * NGW;
        if (m2 >= MTOK) break;
        p0_trip(F, vb, gn, m2, NGW, gw, wl, bsel, H, LOGF, RINV, H8, HSC);
        if (m2 + 8 * NGW < MTOK) P0_LOAD(vb, m2 + 8 * NGW);
    }
#undef P0_LOAD
#if defined(TSPROBE)
    if (threadIdx.x == 0) atomicMax((unsigned long long*)(F.ws + 65536) + 9, rt());
#endif
    __syncthreads();
}
__device__ __forceinline__ void p1_scan(Frame& F) {
    if (F.vcu >= 64) return;
    const int seq = F.vcu;
    const float* LOGF = (const float*)(F.ws + WS_LOGF); float* G2 = (float*)(F.ws + WS_G2);
    const int b = seq >> 3, h = seq & 7, s0 = 8 * F.tid;
    float a[8]; float run = 0.f;
#pragma unroll
    for (int i = 0; i < 8; ++i) { run += LOGF[((size_t)(b * SEQ + s0 + i)) * 8 + h]; a[i] = run; }
    float sc = run;
#pragma unroll
    for (int o = 1; o < 64; o <<= 1) { const float y = __shfl_up(sc, o); if (F.lane >= o) sc += y; }
    volatile LAS float* wt = (volatile LAS float*)(F.MISC + 16);
    if (F.lane == 63) wt[F.wave] = sc;
    __syncthreads();
    float woff = 0.f;
#pragma unroll
    for (int w = 0; w < NWAVES; ++w) woff += (w < F.wave) ? wt[w] : 0.f;
    const float off = woff + (sc - run);
    f32x4 o0, o1;
#pragma unroll
    for (int i = 0; i < 4; ++i) { o0[i] = -(a[i] + off) * 1.4426950408889634f; o1[i] = -(a[4 + i] + off) * 1.4426950408889634f; }
    GAS f32x4* gp = (GAS f32x4*)(G2 + (size_t)seq * SEQ + s0); gp[0] = o0; gp[1] = o1;
    __syncthreads();
}

#ifndef P1BAL
#define P1BAL 1
#endif
#ifndef P6_A_AUX
#define P6_A_AUX 0
#endif
#ifndef P5_A_AUX
#define P5_A_AUX 0
#endif
struct Args { const float* in[NIN_ARGS]; float* out; unsigned char* ws; int ph_lo, ph_hi; };
__global__ void __launch_bounds__(NWAVES * 64, 2) mega_fwd(Args args) {
    extern __shared__ __attribute__((aligned(16))) unsigned char lds[];
    Frame F;
    F.lds = (LAS unsigned char*)lds;
    F.MISC = (volatile LAS unsigned*)(F.lds + MISC_OFF);
    F.tid = threadIdx.x; F.lane = F.tid & 63; F.wave = __builtin_amdgcn_readfirstlane(F.tid >> 6);
    F.G = gridDim.x; { const int bx = blockIdx.x; F.vcu = (F.G % 8 == 0) ? (bx % 8) * (F.G / 8) + bx / 8 : bx; }
    unsigned char* ws = args.ws; F.ws = ws; F.out = args.out;
    F.x = args.in[I_X]; F.mem = args.in[I_MEM]; F.w_in = args.in[I_WIN]; F.w_mem_kv = args.in[I_WMEMKV]; F.w_o_swa = args.in[I_WOSWA]; F.w_o_fox = args.in[I_WOFOX]; F.w_o_mem = args.in[I_WOMEM];
    F.w_out = args.in[I_WOUT]; F.w_up = args.in[I_WUP]; F.w_dn = args.in[I_WDN]; F.g_mix = args.in[I_GMIX]; F.g_mlp = args.in[I_GMLP]; F.g_mem = args.in[I_GMEM]; F.b_forget = args.in[I_BFORGET];
    F.ctl = (gu32*)(ws + WS_CTL);
    for (int u = F.tid; u < (LDS_BYTES - LDSCTL_OFF) / 4; u += NWAVES * 64) ((LAS unsigned*)(F.lds + LDSCTL_OFF))[u] = 0u;
    __syncthreads();
    const int lo = args.ph_lo, hi = args.ph_hi;
    const bool use_bar = (hi - lo) > 1;
    XcdBarrier bar; bar.bar = (unsigned*)(F.ctl + CW_BAR); bar.x = 0; bar.st = nullptr;
    if (use_bar) bar = xcd_barrier_post((unsigned*)(F.ctl + CW_BAR), F.MISC + 8);
#if defined(TSPROBE)
#ifndef KL_PHASE
#define KL_PHASE 99
#endif
#if defined(EXPER_P3NOHOOK)
#define KL_CAPTURE_AT_STAMP 0
#else
#define KL_CAPTURE_AT_STAMP 1
#endif
#define STAMP(k) do { if (blockIdx.x == 0 && threadIdx.x == 0) { unsigned long long* tq_ = (unsigned long long*)(args.ws + 65536); tq_[k] = rt(); tq_[32 + (k)] = __builtin_amdgcn_s_memtime(); \
        if ((k) == KL_PHASE) { tq_[42] = 0; tq_[44] = 0; } if ((k) == KL_PHASE + 1 && KL_CAPTURE_AT_STAMP) { tq_[47] = tq_[42]; tq_[43] = 0; } } } while (0)
#else
#define STAMP(k) do {} while (0)
#endif
#ifndef TS_XCDSPREAD
#define TS_XCDSPREAD 999
#endif
#if defined(TSPROBE)
#define SPREAD(k) do { if (threadIdx.x == 0) { atomicMax((unsigned long long*)(args.ws + 65536) + (k), rt()); atomicMax((unsigned long long*)(args.ws + 65536) + (k) + 1, ~rt()); \
        if ((k) == TS_XCDSPREAD) atomicMax((unsigned long long*)(args.ws + 65536) + 56 + (F.vcu >> 5), rt()); } } while (0)
#else
#define SPREAD(k) do {} while (0)
#endif
    STAMP(0);
#define IN(k) (lo <= (k) && (k) < hi)
#define BOTH(k) (IN(k) && IN((k) + 1))
#define GRID_BAR() xcd_barrier(bar)

    bf16* Win_t = (bf16*)(ws + WS_WIN); bf16* Wkv_t = (bf16*)(ws + WS_WKV); bf16* Wo_t = (bf16*)(ws + WS_WO); bf16* Wout_t = (bf16*)(ws + WS_WOUT); bf16* Wup_t = (bf16*)(ws + WS_WUP); bf16* Wd_t = (bf16*)(ws + WS_WD);
    bf16* H = (bf16*)(ws + WS_H); bf16* GT = (bf16*)(ws + WS_GT); bf16* U = (bf16*)(ws + WS_U); bf16* X1B = (bf16*)(ws + WS_X1B); bf16* MEMN = (bf16*)(ws + WS_MEMN);
    bf16* QCAT = (bf16*)(ws + WS_QCAT); bf16* QA = QCAT; bf16* QF = QCAT + 512; bf16* QM = QCAT + 1024; bf16* MRG = (bf16*)(ws + WS_MRG);
    bf16* KA = (bf16*)(ws + WS_KA); bf16* VA = (bf16*)(ws + WS_VA); bf16* KF = (bf16*)(ws + WS_KF); bf16* VF = (bf16*)(ws + WS_VF);
    unsigned char* MIMG = ws + WS_MKV; float* SSQ = (float*)(ws + WS_SSQ); float* G2 = (float*)(ws + WS_G2);

#define P1_TABLE_FILL() do { LAS float* tab = (LAS float*)(F.lds + ATT_EXTRA_OFF); \
          for (int i = F.tid; i < 92 * 64; i += NWAVES * 64) { const int g = i >> 6, c = i & 63; float v = 0.f; \
              if (g < 8) v = args.in[I_QNSWA][c] * pg8::kC2_64; else if (g < 10) v = args.in[I_KNSWA][c]; else if (g >= 12 && g < 20) v = args.in[I_QNFOX][c] * pg8::kC2_64; else if (g >= 20 && g < 28) v = args.in[I_KNFOX][c]; \
              else if (g == 28 || g == 29) v = args.in[I_KNMEM][i - 28 * 64] * args.in[I_QNMEM][i - 28 * 64] * (0.08838834764831845f * 1.4426950408889634f); \
              else if (g >= 44) v = args.in[I_BGATE][i - 44 * 64] * -1.4426950408889634f; \
              tab[i] = v; } } while (0)
#define P4_TABLE_FILL() do { LAS float* tab = (LAS float*)(F.lds + ATT_EXTRA_OFF); int i0_ = threadIdx.x; asm volatile("" : "+v"(i0_)); for (int i = i0_; i < 1024; i += NWAVES * 64) tab[i] = 1.0f / F.g_mix[i]; } while (0)
    if (IN(0)) { p0_prologue(F); if (BOTH(0)) { P1_TABLE_FILL(); GRID_BAR(); } STAMP(1); }

    if (IN(1)) {
        p1_scan(F);
        pg8::Sched S; S.init(MTOK, 5888, 512, F.G, (int)blockIdx.x, ws + WS_H8, ws + WS_WIN8); S.tsbase = (void*)(ws + 65536);
        S.p1bal = (F.G == 256) ? P1BAL : 0;
        if (!IN(0)) { P1_TABLE_FILL(); __syncthreads(); }
        pg8::EpiInProjT<0, 2> E{QA, KA, VA, QF, KF, VF, QM, (unsigned char*)GT, (const float*)(ws + WS_HS), (const float*)(ws + WS_SWG), (LAS const float*)(F.lds + ATT_EXTRA_OFF)};
        pg8::gemm_phase<pg8::EpiInProjT<0, 2>, pg8::Sched, true, true, 0, 2>(F.lds + RING_OFF, 512, S, E);
        { pg8::Sched S2; S2.init(MMEM, 1024, 1024, F.G, (blockIdx.x >= 128) ? (int)blockIdx.x - 128 : (1 << 20), MEMN, Wkv_t); S2.tsbase = (void*)(ws + 65536);
          if (F.G <= 128) S2.c = (int)blockIdx.x;
          pg8::EpiMemKV E2{MIMG, (LAS const float*)(F.lds + ATT_EXTRA_OFF), (LAS float*)(F.lds + ATT_EXTRA_OFF + 92 * 64 * 4)};
          pg8::gemm_phase<pg8::EpiMemKV, pg8::Sched, true, true>(F.lds + RING_OFF, 1024, S2, E2); }
        if (F.G == 256 && blockIdx.x >= 160) weight_items(F, I_EARLY, NITEMS, ((int)blockIdx.x - 160) * NWAVES + F.wave, 96 * NWAVES);
        SPREAD(20);
        if (BOTH(1)) GRID_BAR();
        STAMP(2);
    }

    if (IN(2)) {
        using ab = attn_body::bf16;
        char* shm = (char*)lds + RING_OFF;
        float fox_margin;
        { const float gq = fabsf(args.in[I_QNFOX][F.lane]), gk = fabsf(args.in[I_KNFOX][F.lane]); float mq = gq, mk = gk;
#pragma unroll
          for (int o = 1; o < 64; o <<= 1) { mq = fmaxf(mq, __shfl_xor(mq, o)); mk = fmaxf(mk, __shfl_xor(mk, o)); }
          fox_margin = 2.0f * (8.0f * mq * mk * 1.4426950408889634f * 1.02f) + 40.0f; }
        unsigned nid = 0u; if (F.tid == 0) nid = atomicAdd((unsigned*)(F.ctl + CW_FOXQ), 1u);
        for (;;) {
            if (F.tid == 0) F.MISC[24] = nid;
            __syncthreads();
            const int id = (int)F.MISC[24];
            __syncthreads();
            if (id >= 1024) break;
            if (F.tid == 0) nid = atomicAdd((unsigned*)(F.ctl + CW_FOXQ), 1u);
            const int bh = id & 63, qb = 15 - (id >> 6);
            const int b = bh >> 3, h = bh & 7; const size_t rb = (size_t)b * SEQ; const float* g2 = G2 + (size_t)bh * SEQ; const int NT = 4 * qb + 4;
            const float thr = g2[qb * 256] - fox_margin;
            const bool far = (F.lane < NT - 4) && (g2[64 * F.lane + 63] <= thr);
            const int t0 = __builtin_amdgcn_readfirstlane(__popcll(__ballot(far))) & ~1;
            attn_body::attn_unit<0, 512, 8>((const ab*)QF + (rb + qb * 256) * 1536 + h * 64, (const ab*)KF + (rb + 64 * t0) * 512 + h * 64, (const ab*)VF + (rb + 64 * t0) * 512 + h * 64, (ab*)QF + (rb + qb * 256) * 1536 + h * 64,
                                              NT - t0, qb * 256 - 64 * t0, 0, 0.f, g2 + 64 * t0, nullptr, shm); }
#if defined(TSPROBE)
        if (threadIdx.x == 0) { atomicMax((unsigned long long*)(ws + 65536) + 10, rt()); atomicMin((unsigned long long*)(ws + 65536) + 13, rt() ^ 0xffffffffffffffffull); }
#endif
        for (int id = F.vcu; id < 256; id += F.G)
            attn_body::swa_unit(id >> 5, (id >> 4) & 1, id & 15, (ab*)QA, (const ab*)KA, (const ab*)VA, args.in[I_SINK], args.in[I_RELBIAS], shm);
#if defined(TSPROBE)
        if (threadIdx.x == 0) atomicMax((unsigned long long*)(ws + 65536) + 11, rt());
#endif
        for (int i = 0, prev_bh = -1;; ++i) { const int id = (F.G == 256) ? F.vcu * 2 + i : i * F.G + F.vcu; if (id >= 512 || (F.G == 256 && i >= 2)) break;
            const bool prep = (id >> 4) != prev_bh; prev_bh = id >> 4;
            attn_body::mem_unit(id >> 6, (id >> 4) & 3, id & 15, prep, MIMG, (const ab*)QM, (ab*)QM, shm, (char*)lds + MEMWS_OFF, (char*)lds + ATT_EXTRA_OFF, (void*)(ws + 65536)); }
#if defined(TSPROBE)
        if (threadIdx.x == 0) atomicMax((unsigned long long*)(ws + 65536) + 12, rt());
#endif
        if (BOTH(2)) GRID_BAR();
        STAMP(3);
    }

    if (IN(3)) {
        pg8::Sched S; S.init(MTOK, 1024, 1536, F.G, (int)blockIdx.x, QCAT, Wo_t); S.tsbase = (void*)(ws + 65536);
#if defined(EXPER_P3NOHOOK)
        { pg8::EpiMergeT<false> E0{(const unsigned char*)GT, MRG, (void*)(ws + 65536)}; pg8::gemm_phase<pg8::EpiMergeT<false>, pg8::Sched, true, true>(F.lds + RING_OFF, 1536, S, E0); GRID_BAR();
          if (blockIdx.x == 0 && threadIdx.x == 0) { unsigned long long* tq_ = (unsigned long long*)(args.ws + 65536); tq_[47] = tq_[42]; tq_[43] = 0; tq_[18] = rt(); } }
#endif
        pg8::EpiMerge E{(const unsigned char*)GT, MRG, (void*)(ws + 65536)};
        pg8::gemm_phase<pg8::EpiMerge, pg8::Sched, true, true>(F.lds + RING_OFF, 1536, S, E);
        if (BOTH(3)) { P4_TABLE_FILL(); GRID_BAR(); }
        STAMP(4);
    }

    if (IN(4)) {
        pg8::Sched S; S.init(MTOK, 1024, 1024, F.G, (int)blockIdx.x, MRG, Wout_t); S.tsbase = (void*)(ws + 65536);
#if MRG_BLOCKED
        S.a_pitch = 64; S.a_kstep = (size_t)256 * 64 * 2;
#endif
        if (!IN(3)) { P4_TABLE_FILL(); __syncthreads(); }
        pg8::EpiOutProj E{H, (const float*)(ws + WS_RINV), (LAS const float*)(F.lds + ATT_EXTRA_OFF), X1B, SSQ};
        pg8::gemm_phase<pg8::EpiOutProj, pg8::Sched, true, true>(F.lds + RING_OFF, 1024, S, E);
        if (BOTH(4)) GRID_BAR();
        STAMP(5);
    }

    if (IN(5)) {
        pg8::Sched S; S.init(MTOK, 4096, 1024, F.G, (int)blockIdx.x, X1B, Wup_t); S.tsbase = (void*)(ws + 65536);
#if defined(EXPER_NOSTORE)
        { pg8::EpiUpT<true> E0{SSQ, U, (PG8_LAS float*)(F.lds + ATT_EXTRA_OFF)}; pg8::gemm_phase<pg8::EpiUpT<true>, pg8::Sched, true, true>(F.lds + RING_OFF, 1024, S, E0); GRID_BAR(); STAMP(18); }
#endif
#if defined(EXPER_VARIANT)
        { pg8::EpiUp E0{SSQ, U, (PG8_LAS float*)(F.lds + ATT_EXTRA_OFF)}; pg8::gemm_phase<pg8::EpiUp, pg8::Sched, EXPER_ALIGN, EXPER_SP2>(F.lds + RING_OFF, 1024, S, E0); GRID_BAR(); STAMP(18); }
#endif
        pg8::EpiUp E{SSQ, U, (PG8_LAS float*)(F.lds + ATT_EXTRA_OFF)};
        pg8::gemm_phase<pg8::EpiUp, pg8::Sched, true, true, P5_A_AUX>(F.lds + RING_OFF, 1024, S, E);
        SPREAD(22);
        if (BOTH(5)) GRID_BAR();
        STAMP(6);
    }

    if (IN(6)) {
        pg8::Sched S; S.init(MTOK, 1024, 4096, F.G, (int)blockIdx.x, U, Wd_t); S.tsbase = (void*)(ws + 65536);
        S.a_pitch = 64; S.a_kstep = (size_t)256 * 64 * 2;
        pg8::EpiDown E{X1B, F.out};
        pg8::gemm_phase<pg8::EpiDown, pg8::Sched, true, true, P6_A_AUX>(F.lds + RING_OFF, 4096, S, E);
        SPREAD(24);
        STAMP(7);
    }
#if defined(TSPROBE)
    if (blockIdx.x == 0 && threadIdx.x == 0) { const unsigned long long* tsb = (const unsigned long long*)(args.ws + 65536);
#if defined(TS_CYCLES)
        const unsigned long long span = (tsb[32 + TS_B] - tsb[32 + TS_A]) / 25ull, t0 = rt();
#else
#if TS_XCDSPREAD != 999
        unsigned long long xmx_ = 0, xmn_ = ~0ull; for (int x_ = 0; x_ < 8; ++x_) { const unsigned long long v_ = tsb[56 + x_]; xmx_ = v_ > xmx_ ? v_ : xmx_; xmn_ = v_ < xmn_ ? v_ : xmn_; }
        const unsigned long long span = (xmx_ - xmn_) * 8ull, t0 = rt();
#elif defined(TS_SPREAD)
        const unsigned long long span = (tsb[TS_SPREAD] - ~tsb[TS_SPREAD + 1]) * 8ull, t0 = rt();
#else
        const unsigned long long span = (tsb[TS_B] - tsb[TS_A]) * 8ull, t0 = rt();
#endif
#endif
        while (span < 2000000ull && rt() - t0 < span) __builtin_amdgcn_s_sleep(32); }
#endif
#undef IN
#undef BOTH
#undef GRID_BAR
}

extern "C" void kernel_launch(void* const* d_in, const int* in_sizes, int n_in, void* d_out, int out_size, void* d_ws, size_t ws_size, hipStream_t stream) {
    static int grid = 0;
    if (grid == 0) {
        if (n_in != NIN_ARGS || in_sizes[0] != MTOK * 1024 || out_size != MTOK * 1024 || ws_size < WS_END) { fprintf(stderr, "kernel_launch: unexpected shapes (n_in %d, in0 %d, out %d, ws %zu < %zu); nothing launched\n", n_in, n_in > 0 ? in_sizes[0] : -1, out_size, ws_size, (size_t)WS_END); grid = -1; return; }
        int dev = 0, cus = 0, per_cu = 0;
        if (hipGetDevice(&dev) != hipSuccess || hipDeviceGetAttribute(&cus, hipDeviceAttributeMultiprocessorCount, dev) != hipSuccess) { fprintf(stderr, "kernel_launch: hipGetDevice / hipDeviceGetAttribute failed\n"); grid = -1; return; }
        if (hipFuncSetAttribute((const void*)mega_fwd, hipFuncAttributeMaxDynamicSharedMemorySize, LDS_BYTES) != hipSuccess) { fprintf(stderr, "kernel_launch: hipFuncSetAttribute failed\n"); grid = -1; return; }
        if (hipOccupancyMaxActiveBlocksPerMultiprocessor(&per_cu, (const void*)mega_fwd, NWAVES * 64, LDS_BYTES) != hipSuccess || per_cu < 1) { fprintf(stderr, "kernel_launch: occupancy query says %d workgroups per CU\n", per_cu); per_cu = 1; }
        (void)hipGetLastError();
        if (per_cu > 1) per_cu = 1;
        grid = cus * per_cu;
    }
    if (grid < 0) return;
    if (hipMemsetAsync((char*)d_ws + WS_CTL, 0, CTL_ZERO_BYTES, stream) != hipSuccess) { fprintf(stderr, "kernel_launch: hipMemsetAsync failed\n"); return; }
    Args a{};
    for (int i = 0; i < NIN_ARGS; ++i) a.in[i] = (const float*)d_in[i];
    a.out = (float*)d_out; a.ws = (unsigned char*)d_ws;
#if defined(DETPROBE) && DETPROBE
    {   unsigned char* w = (unsigned char*)d_ws; unsigned long long* chk = (unsigned long long*)(w + WS_CHK);
        (void)hipMemsetAsync(chk, 0, 2 * 64 * 8, stream);
        struct Slot { int phase; size_t off; size_t bytes; bool in_out; };
        const Slot slots[] = { {0, WS_WIN, 39 * MiB, false}, {0, WS_LOGF, 1 * MiB, false}, {0, WS_MEMN, 4 * MiB, false}, {0, WS_H, 64 * MiB, false},
            {1, WS_G2, 1 * MiB, false}, {1, WS_MKV, 4 * MiB, false}, {1, WS_GT, 192 * MiB, false}, {1, WS_QCAT, 96 * MiB, false}, {1, WS_KA, 8 * MiB, false}, {1, WS_VA, 8 * MiB, false}, {1, WS_KF, 32 * MiB, false}, {1, WS_VF, 32 * MiB, false},
            {2, WS_QCAT, 96 * MiB, false},
            {3, WS_MRG, 64 * MiB, false}, {4, WS_X1B, 64 * MiB, false}, {4, WS_SSQ, 2 * MiB, false}, {5, WS_U, 256 * MiB, false}, {6, 0, 128 * MiB, true} };
        const int nslots = (int)(sizeof(slots) / sizeof(slots[0]));
        for (int run = 0; run < 2; ++run)
            for (int p = 0; p < 7; ++p) { a.ph_lo = p; a.ph_hi = p + 1; if (p == 1) (void)hipMemsetAsync(w + WS_GT, 0, 192 * MiB, stream); if (p == 1) (void)hipMemsetAsync(w + WS_QCAT, 0, 176 * MiB, stream);
                hipLaunchKernelGGL(mega_fwd, dim3(grid), dim3(NWAVES * 64), LDS_BYTES, stream, a);
                for (int s = 0; s < nslots; ++s) if (slots[s].phase == p) { const unsigned* src = slots[s].in_out ? (const unsigned*)d_out : (const unsigned*)(w + slots[s].off);
                    hipLaunchKernelGGL(chk_sum, dim3(2048), dim3(256), 0, stream, src, slots[s].bytes / 4, chk + run * 64 + s); } }
        hipLaunchKernelGGL(chk_report, dim3(2048), dim3(256), 0, stream, (const unsigned long long*)chk, (float*)d_out, nslots, (size_t)out_size);
    }
#elif N_LAUNCHES == 1
#if defined(EXPER_P0TWICE)
    a.ph_lo = 0; a.ph_hi = 1; hipLaunchKernelGGL(mega_fwd, dim3(grid), dim3(NWAVES * 64), LDS_BYTES, stream, a);
    (void)hipMemsetAsync((char*)d_ws + WS_CTL, 0, CTL_ZERO_BYTES, stream);
#endif
    a.ph_lo = 0; a.ph_hi = 7;
    hipLaunchKernelGGL(mega_fwd, dim3(grid), dim3(NWAVES * 64), LDS_BYTES, stream, a);
#else
    for (int p = 0; p < 7; ++p) { a.ph_lo = p; a.ph_hi = p + 1; hipLaunchKernelGGL(mega_fwd, dim3(grid), dim3(NWAVES * 64), LDS_BYTES, stream, a); }
#endif
    const hipError_t le = hipPeekAtLastError();
    if (le != hipSuccess) fprintf(stderr, "kernel_launch: launch failed: %s\n", hipGetErrorName(le));
}
```
